# Optimizing an MI355X kernel written in HIP

```python
import math
import jax, jax.numpy as jnp
from jax import lax
import numpy as np

D_MODEL = 1024
BATCH = 32
SEQ = 2048
DEPTH = 2
DEC_BATCH = 1
DEC_SEQ = 16384
PAST_LEN = 128

GRID_W = 64
BLOCK_Q = 128
N_MIXERS = 2
N_A_LAYERS = (DEPTH + 1) // 2
N_B_LAYERS = DEPTH // 2

A_HEADS = 16
A_KV_HEADS = 4
A_GROUP = A_HEADS // A_KV_HEADS
A_HEAD_DIM = D_MODEL // A_HEADS
A_Q_W = A_HEADS * A_HEAD_DIM
A_KV_W = A_KV_HEADS * A_HEAD_DIM
ROPE_AXIS_DIM = A_HEAD_DIM // 2
ROPE_THETA = 10000.0

B_HEADS = 8
B_HEAD_DIM = D_MODEL // (2 * B_HEADS)
B_V_DIM = 2 * B_HEAD_DIM
B_QK_W = B_HEADS * 2 * B_HEAD_DIM
B_V_W = B_HEADS * B_V_DIM

NUM_BUCKETS = 32
MAX_DISTANCE = 128

D_FF = int(math.ceil(8 * D_MODEL / 3 / 256) * 256)
N_MOD = 6
EPS = 1e-6

kernel_name = "hybrid_gqa_axialrope_diffattn_t5bias_adaln_encoder"


def rms_norm(x, gain):
    x32 = x.astype(jnp.float32)
    y = x32 * lax.rsqrt(jnp.mean(x32 * x32, axis=-1, keepdims=True) + EPS)
    return (y * gain.astype(jnp.float32)).astype(x.dtype)


def axial_rope(length):
    n_rows = length // GRID_W
    rr, cc = jnp.meshgrid(jnp.arange(n_rows), jnp.arange(GRID_W), indexing="ij")
    rows = rr.reshape(-1).astype(jnp.float32)
    cols = cc.reshape(-1).astype(jnp.float32)
    n_pairs = ROPE_AXIS_DIM // 2
    inv_freq = ROPE_THETA ** (-jnp.arange(n_pairs, dtype=jnp.float32) / n_pairs)
    ang = jnp.concatenate([rows[:, None] * inv_freq[None], cols[:, None] * inv_freq[None]], axis=-1)
    return jnp.cos(ang), jnp.sin(ang)


def apply_rope(x, cos, sin):
    x32 = x.astype(jnp.float32).reshape(x.shape[:-1] + (x.shape[-1] // 2, 2))
    x0, x1 = x32[..., 0], x32[..., 1]
    c = cos[None, :, None, :]
    s = sin[None, :, None, :]
    out = jnp.stack([x0 * c - x1 * s, x0 * s + x1 * c], axis=-1)
    return out.reshape(x.shape).astype(x.dtype)


def t5_bucket(rel):
    nb = NUM_BUCKETS // 2
    max_exact = nb // 2
    ret = (rel > 0).astype(jnp.int32) * nb
    n = jnp.abs(rel)
    large = max_exact + (jnp.log(jnp.maximum(n, 1).astype(jnp.float32) / max_exact)
                         / math.log(MAX_DISTANCE / max_exact) * (nb - max_exact)).astype(jnp.int32)
    large = jnp.minimum(large, nb - 1)
    return ret + jnp.where(n < max_exact, n, large)


def gqa_mixer(h, w_qkv, w_o, q_gain, k_gain):
    B, L, _ = h.shape
    qkv = h @ w_qkv
    q, k, v = jnp.split(qkv, [A_Q_W, A_Q_W + A_KV_W], axis=-1)
    q = rms_norm(q.reshape(B, L, A_HEADS, A_HEAD_DIM), q_gain)
    k = rms_norm(k.reshape(B, L, A_KV_HEADS, A_HEAD_DIM), k_gain)
    v = v.reshape(B, L, A_KV_HEADS, A_HEAD_DIM)
    cos, sin = axial_rope(L)
    q = apply_rope(q, cos, sin)
    k = apply_rope(k, cos, sin)
    nb = L // BLOCK_Q
    qb = q.reshape(B, nb, BLOCK_Q, A_KV_HEADS, A_GROUP, A_HEAD_DIM).transpose(1, 0, 2, 3, 4, 5)
    scale = A_HEAD_DIM ** -0.5

    def block(q_blk):
        s = jnp.einsum("bqkgd,bskd->bkgqs", q_blk, k).astype(jnp.float32) * scale
        p = jax.nn.softmax(s, axis=-1).astype(v.dtype)
        return jnp.einsum("bkgqs,bskd->bqkgd", p, v)

    out = lax.map(block, qb)
    out = out.transpose(1, 0, 2, 3, 4, 5).reshape(B, L, A_Q_W)
    return out @ w_o


def diff_mixer(h, w_qkv, w_o, q_gain, k_gain, lq1, lk1, lq2, lk2, subln_gain, rel_bias, lambda_init):
    B, L, _ = h.shape
    qkv = h @ w_qkv
    q, k, v = jnp.split(qkv, [B_QK_W, 2 * B_QK_W], axis=-1)
    q = rms_norm(q.reshape(B, L, B_HEADS, 2, B_HEAD_DIM), q_gain)
    k = rms_norm(k.reshape(B, L, B_HEADS, 2, B_HEAD_DIM), k_gain)
    v = v.reshape(B, L, B_HEADS, B_V_DIM)
    lam = (jnp.exp(jnp.sum(lq1.astype(jnp.float32) * lk1.astype(jnp.float32)))
           - jnp.exp(jnp.sum(lq2.astype(jnp.float32) * lk2.astype(jnp.float32))) + lambda_init)
    nb = L // BLOCK_Q
    qb = q.reshape(B, nb, BLOCK_Q, B_HEADS, 2, B_HEAD_DIM).transpose(1, 0, 2, 3, 4, 5)
    starts = jnp.arange(nb, dtype=jnp.int32) * BLOCK_Q
    kpos = jnp.arange(L, dtype=jnp.int32)
    scale = B_HEAD_DIM ** -0.5
    table = rel_bias.astype(jnp.float32)

    def block(args):
        q_blk, start = args
        qpos = start + jnp.arange(BLOCK_Q, dtype=jnp.int32)
        bias = table[t5_bucket(kpos[None, :] - qpos[:, None])]
        bias = jnp.transpose(bias, (2, 0, 1))
        s = jnp.einsum("bqhcd,bshcd->bhcqs", q_blk, k).astype(jnp.float32) * scale + bias[None, :, None]
        p = jax.nn.softmax(s, axis=-1)
        wgt = p[:, :, 0] - lam * p[:, :, 1]
        return jnp.einsum("bhqs,bshe->bqhe", wgt.astype(v.dtype), v)

    out = lax.map(block, (qb, starts))
    out = out.transpose(1, 0, 2, 3, 4).reshape(B, L, B_HEADS, B_V_DIM)
    out = rms_norm(out, subln_gain) * (1.0 - lambda_init)
    return out.reshape(B, L, B_V_W) @ w_o


def swiglu(h, w_gate_up, w_down):
    g, u = jnp.split(h @ w_gate_up, 2, axis=-1)
    return (jax.nn.silu(g) * u) @ w_down


def _trunk(x, c, norm1_gain, norm2_gain, w_ada, b_ada, w_gate_up, w_down, rel_bias,
           a_w_qkv, a_w_o, a_q_gain, a_k_gain,
           b_w_qkv, b_w_o, b_q_gain, b_k_gain, b_lq1, b_lk1, b_lq2, b_lk2, b_subln_gain):
    c_act = jax.nn.silu(c)
    for i in range(DEPTH):
        mod = c_act @ w_ada[i] + b_ada[i]
        sh1, sc1, g1, sh2, sc2, g2 = jnp.split(mod[:, None, :], N_MOD, axis=-1)
        h = rms_norm(x, norm1_gain[i]) * (1 + sc1) + sh1
        if i % N_MIXERS == 0:
            j = i // N_MIXERS
            h = gqa_mixer(h, a_w_qkv[j], a_w_o[j], a_q_gain[j], a_k_gain[j])
        else:
            j = i // N_MIXERS
            lambda_init = 0.8 - 0.6 * math.exp(-0.3 * i)
            h = diff_mixer(h, b_w_qkv[j], b_w_o[j], b_q_gain[j], b_k_gain[j],
                           b_lq1[j], b_lk1[j], b_lq2[j], b_lk2[j], b_subln_gain[j], rel_bias, lambda_init)
        x = x + g1 * h
        h = rms_norm(x, norm2_gain[i]) * (1 + sc2) + sh2
        x = x + g2 * swiglu(h, w_gate_up[i], w_down[i])
    return x


def setup_inputs(seed: int = 0) -> dict:
    key = jax.random.key(seed)
    ks = jax.random.split(key, 32)
    f32 = jnp.float32
    n = lambda k, shape, s: jax.random.normal(k, shape, f32) * s
    D = D_MODEL
    return {
        "x_prompt": n(ks[0], (BATCH, SEQ, D), 1.0),
        "x_sample": n(ks[1], (DEC_BATCH, DEC_SEQ, D), 1.0),
        "c_prompt": n(ks[2], (BATCH, D), 1.0),
        "c_sample": n(ks[3], (DEC_BATCH, D), 1.0),
        "norm1_gain": 1.0 + n(ks[4], (DEPTH, D), 0.02),
        "norm2_gain": 1.0 + n(ks[5], (DEPTH, D), 0.02),
        "w_ada": n(ks[6], (DEPTH, D, N_MOD * D), 0.5 * D ** -0.5),
        "b_ada": n(ks[7], (DEPTH, N_MOD * D), 0.02),
        "w_gate_up": n(ks[8], (DEPTH, D, 2 * D_FF), D ** -0.5),
        "w_down": n(ks[9], (DEPTH, D_FF, D), D_FF ** -0.5),
        "rel_bias": n(ks[10], (NUM_BUCKETS, B_HEADS), 0.5),
        "a_w_qkv": n(ks[11], (N_A_LAYERS, D, A_Q_W + 2 * A_KV_W), D ** -0.5),
        "a_w_o": n(ks[12], (N_A_LAYERS, A_Q_W, D), A_Q_W ** -0.5),
        "a_q_gain": 1.0 + n(ks[13], (N_A_LAYERS, A_HEAD_DIM), 0.02),
        "a_k_gain": 1.0 + n(ks[14], (N_A_LAYERS, A_HEAD_DIM), 0.02),
        "b_w_qkv": n(ks[15], (N_B_LAYERS, D, 2 * B_QK_W + B_V_W), D ** -0.5),
        "b_w_o": n(ks[16], (N_B_LAYERS, B_V_W, D), B_V_W ** -0.5),
        "b_q_gain": 1.0 + n(ks[17], (N_B_LAYERS, B_HEAD_DIM), 0.02),
        "b_k_gain": 1.0 + n(ks[18], (N_B_LAYERS, B_HEAD_DIM), 0.02),
        "b_lq1": n(ks[19], (N_B_LAYERS, B_HEAD_DIM), 0.1),
        "b_lk1": n(ks[20], (N_B_LAYERS, B_HEAD_DIM), 0.1),
        "b_lq2": n(ks[21], (N_B_LAYERS, B_HEAD_DIM), 0.1),
        "b_lk2": n(ks[22], (N_B_LAYERS, B_HEAD_DIM), 0.1),
        "b_subln_gain": 1.0 + n(ks[23], (N_B_LAYERS, B_V_DIM), 0.02),
    }


def reference(x_prompt, x_sample, c_prompt, c_sample, norm1_gain, norm2_gain, w_ada, b_ada,
              w_gate_up, w_down, rel_bias, a_w_qkv, a_w_o, a_q_gain, a_k_gain,
              b_w_qkv, b_w_o, b_q_gain, b_k_gain, b_lq1, b_lk1, b_lq2, b_lk2, b_subln_gain):
    y_prompt = _trunk(x_prompt, c_prompt, norm1_gain, norm2_gain, w_ada, b_ada, w_gate_up, w_down, rel_bias,
                      a_w_qkv, a_w_o, a_q_gain, a_k_gain,
                      b_w_qkv, b_w_o, b_q_gain, b_k_gain, b_lq1, b_lk1, b_lq2, b_lk2, b_subln_gain)
    y_sample = _trunk(x_sample, c_sample, norm1_gain, norm2_gain, w_ada, b_ada, w_gate_up, w_down, rel_bias,
                      a_w_qkv, a_w_o, a_q_gain, a_k_gain,
                      b_w_qkv, b_w_o, b_q_gain, b_k_gain, b_lq1, b_lk1, b_lq2, b_lk2, b_subln_gain)
    return (y_prompt, y_sample)
```

```cpp
#include <hip/hip_runtime.h>
#include <hip/hip_cooperative_groups.h>
#include <hip/hip_bf16.h>
#include <cstdio>
#include <cstdint>
#include <cmath>
#include <type_traits>
namespace cg = cooperative_groups;
namespace pg8 {
#define PG8_LAS __attribute__((address_space(3)))
typedef unsigned short bf16_t;
typedef short bf16x8 __attribute__((ext_vector_type(8)));
typedef float f32x4 __attribute__((ext_vector_type(4)));
typedef unsigned u32x4 __attribute__((ext_vector_type(4)));
constexpr int BM = 256, BK = 64, HALF = 128, HTB = HALF * BK * 2  , STAGE_BYTES = 8 * HTB, NXCD = 8, WGM = 4;

__host__ __device__ __forceinline__ int lds_byte(int r, int c) { const int st = (r >> 4) * 2 + (c >> 5), rr = r & 15, cc = c & 31, ob = rr * 64 + cc * 2; return st * 1024 + (ob ^ (((ob >> 9) & 1) << 5)); }
__host__ __device__ __forceinline__ void stage_rc(int b, int& R, int& C) { const int st = b / 1024, sb = b % 1024, swz = sb ^ (((sb >> 9) & 1) << 5); R = (st >> 1) * 16 + swz / 64; C = (st & 1) * 32 + (swz % 64) / 2; }
__host__ __device__ __forceinline__ int perm32(int rho) { const int n = rho >> 4, i = rho & 15; return 8 * (i >> 2) + 4 * n + (i & 3); }

struct Unit { int pm, pn; };
struct Gemm { const bf16_t* A; const bf16_t* Bt; int M, N, K; };

struct StaticOrder {
    int nM, nN, nwg, G, c;
    __host__ __device__ void init(int M, int N, int G_, int c_) { nM = M / BM; nN = N / BM; nwg = nM * nN; G = G_; c = c_; }
    __host__ __device__ bool next(int i, Unit& u) const {
        const long L = (long)i * G + c; if (L >= nwg) return false;
        int wgid = (int)L; { const int q = nwg / NXCD, r = nwg % NXCD, xcd = wgid % NXCD, off = wgid / NXCD; wgid = (xcd < r ? xcd * (q + 1) : r * (q + 1) + (xcd - r) * q) + off; }
        const int nig = WGM * nN, gid = wgid / nig, fm = gid * WGM, gsz = (nM - fm) < WGM ? (nM - fm) : WGM;
        u.pm = fm + ((wgid % nig) % gsz); u.pn = (wgid % nig) / gsz; return true;
    }
    __device__ __forceinline__ void a_ready(const Unit&) const {}
    __device__ __forceinline__ void done(const Unit&) const {}
};

__device__ __forceinline__ unsigned cvt_pk_bf16(float lo, float hi) { unsigned r; asm volatile("v_cvt_pk_bf16_f32 %0, %1, %2" : "=v"(r) : "v"(lo), "v"(hi)); return r; }
typedef float f32x2 __attribute__((ext_vector_type(2)));
__device__ __forceinline__ float silu_mul(float g, float uu) { const float e = __builtin_amdgcn_exp2f(g * -1.4426950408889634f); return g * __builtin_amdgcn_rcpf(1.0f + e) * uu; }
constexpr float EPI_EPS = 1e-6f;
template <bool NEXT> struct EpiResid2 {
    static constexpr bool PERM = true, AFTER_DRAIN = false;
    const float* base_p; const float* base_s; float* out; const float* gate;
    const float* ngain; const float* nsc; bf16_t* Hn; float* rowss;
    __device__ __forceinline__ void prefetch(PG8_LAS unsigned char*, const Unit&, int, int) const {}
    __device__ __forceinline__ void operator()(const f32x4 (&acc)[2][2][4][2], const Unit& u, int wr, int wc, int fr, int fq, PG8_LAS unsigned char*) const {
        const int seq = (u.pm < 256) ? (u.pm >> 3) : 32;
        const float* base = (u.pm < 256) ? base_p : base_s;
        const int col0 = u.pn * BM + wc * 32 + 8 * fq;
        u32x4 dl[2][4][2];
        { f32x4 gv[2][2];
#pragma unroll
          for (int bj = 0; bj < 2; ++bj)
#pragma unroll
            for (int n = 0; n < 2; ++n) gv[bj][n] = *(const f32x4*)(gate + (size_t)seq * 6144 + col0 + bj * HALF + 4 * n);
#pragma unroll
          for (int ai = 0; ai < 2; ++ai)
#pragma unroll
            for (int m = 0; m < 4; ++m)
#pragma unroll
                for (int bj = 0; bj < 2; ++bj) { const f32x4 a = gv[bj][0] * acc[ai][bj][m][0], b = gv[bj][1] * acc[ai][bj][m][1];
                    dl[ai][m][bj].x = cvt_pk_bf16(a[0], a[1]); dl[ai][m][bj].y = cvt_pk_bf16(a[2], a[3]); dl[ai][m][bj].z = cvt_pk_bf16(b[0], b[1]); dl[ai][m][bj].w = cvt_pk_bf16(b[2], b[3]); } }
        f32x4 gm[2][2];
        if (NEXT) {
#pragma unroll
          for (int bj = 0; bj < 2; ++bj)
#pragma unroll
            for (int n = 0; n < 2; ++n) { const int c = col0 + bj * HALF + 4 * n; gm[bj][n] = *(const f32x4*)(ngain + c) * (*(const f32x4*)(nsc + (size_t)seq * 6144 + c) + 1.0f); } }
#define BFLO(w) __builtin_bit_cast(float, (w) << 16)
#define BFHI(w) __builtin_bit_cast(float, (w) & 0xffff0000u)
#pragma unroll
        for (int ai = 0; ai < 2; ++ai) {
            f32x4 bs[4][2][2];
#pragma unroll
            for (int m = 0; m < 4; ++m) { const size_t off = (size_t)(u.pm * BM + ai * HALF + wr * 64 + m * 16 + fr) * 1024 + col0;
#pragma unroll
                for (int bj = 0; bj < 2; ++bj) { bs[m][bj][0] = *(const f32x4*)(base + off + bj * HALF); bs[m][bj][1] = *(const f32x4*)(base + off + bj * HALF + 4); } }
#pragma unroll
            for (int m = 0; m < 4; ++m) { const int row = u.pm * BM + ai * HALF + wr * 64 + m * 16 + fr; const size_t off = (size_t)row * 1024 + col0; float ss = 0.f;
#pragma unroll
                for (int bj = 0; bj < 2; ++bj) { const u32x4 d = dl[ai][m][bj];
                    const f32x4 o0 = bs[m][bj][0] + (f32x4){BFLO(d.x), BFHI(d.x), BFLO(d.y), BFHI(d.y)}, o1 = bs[m][bj][1] + (f32x4){BFLO(d.z), BFHI(d.z), BFLO(d.w), BFHI(d.w)};
                    *(f32x4*)(out + off + bj * HALF) = o0; *(f32x4*)(out + off + bj * HALF + 4) = o1;
                    if (NEXT) { ss += (o0[0] * o0[0] + o0[1] * o0[1]) + (o0[2] * o0[2] + o0[3] * o0[3]) + (o1[0] * o1[0] + o1[1] * o1[1]) + (o1[2] * o1[2] + o1[3] * o1[3]);
                        const f32x4 h0 = o0 * gm[bj][0], h1 = o1 * gm[bj][1];
                        u32x4 w; w.x = cvt_pk_bf16(h0[0], h0[1]); w.y = cvt_pk_bf16(h0[2], h0[3]); w.z = cvt_pk_bf16(h1[0], h1[1]); w.w = cvt_pk_bf16(h1[2], h1[3]);
                        *(u32x4*)(Hn + off + bj * HALF) = w; } }
                if (NEXT) { ss += __shfl_xor(ss, 16); ss += __shfl_xor(ss, 32); if (fq == 0) __hip_atomic_fetch_add(rowss + row, ss, __ATOMIC_RELAXED, __HIP_MEMORY_SCOPE_AGENT); } }
            asm volatile("" ::: "memory"); }
#undef BFLO
#undef BFHI
    }
};
struct EpiSwiGLU2 {
    static constexpr bool PERM = true, AFTER_DRAIN = false;
    bf16_t* O; int ldc; const float* rowss; const float* bias;
    __device__ __forceinline__ void prefetch(PG8_LAS unsigned char* sp, const Unit& u, int wid, int lane) const {
        const int seq = (u.pm < 256) ? (u.pm >> 3) : 32;
        const float* src = (wid < 4) ? rowss + u.pm * BM + wid * 64 : bias + (size_t)seq * 5632 + u.pn * HALF + (wid < 6 ? (wid - 4) * 64 : 2816 + (wid - 6) * 64);
        __builtin_amdgcn_global_load_lds((const unsigned*)(src + lane), (PG8_LAS unsigned*)(sp + wid * 256), 4, 0, 0);
    }
    __device__ __forceinline__ void operator()(const f32x4 (&acc)[2][2][4][2], const Unit& u, int wr, int wc, int fr, int fq, PG8_LAS unsigned char* sp) const {
        const int row0 = u.pm * BM + wr * 64 + fr; const int col0 = u.pn * HALF + wc * 32 + 8 * fq;
        const PG8_LAS float* spf = (const PG8_LAS float*)sp;
        const f32x4 bg0 = *(const PG8_LAS f32x4*)(spf + 256 + wc * 32 + 8 * fq), bg1 = *(const PG8_LAS f32x4*)(spf + 256 + wc * 32 + 8 * fq + 4);
        const f32x4 bu0 = *(const PG8_LAS f32x4*)(spf + 384 + wc * 32 + 8 * fq), bu1 = *(const PG8_LAS f32x4*)(spf + 384 + wc * 32 + 8 * fq + 4);
#pragma unroll
        for (int ai = 0; ai < 2; ++ai)
#pragma unroll
            for (int m = 0; m < 4; ++m) { const int row = row0 + ai * HALF + m * 16; const float rr = 1.0f / sqrtf(spf[ai * HALF + wr * 64 + m * 16 + fr] * (1.0f / 1024.0f) + EPI_EPS);
                const f32x4 g0 = acc[ai][0][m][0] * rr + bg0, g1 = acc[ai][0][m][1] * rr + bg1, u0 = acc[ai][1][m][0] * rr + bu0, u1 = acc[ai][1][m][1] * rr + bu1;
                u32x4 w; w.x = cvt_pk_bf16(silu_mul(g0[0], u0[0]), silu_mul(g0[1], u0[1])); w.y = cvt_pk_bf16(silu_mul(g0[2], u0[2]), silu_mul(g0[3], u0[3]));
                w.z = cvt_pk_bf16(silu_mul(g1[0], u1[0]), silu_mul(g1[1], u1[1])); w.w = cvt_pk_bf16(silu_mul(g1[2], u1[2]), silu_mul(g1[3], u1[3]));
                *(u32x4*)(O + (size_t)row * ldc + col0) = w; }
    }
};
template <bool PRE, bool ROPE> struct EpiSplit2 {
    static constexpr bool PERM = true, AFTER_DRAIN = false;
    bf16_t* p0; bf16_t* p1; bf16_t* p2; int ld0, ld1, ld2, n0, n1;
    const float* rowss; const float* bias; int N;
    const float* qgain; const float* kgain; float qscale; const float* ropetab; PG8_LAS float* xch;
    __device__ __forceinline__ void prefetch(PG8_LAS unsigned char* sp, const Unit& u, int wid, int lane) const {
        if (PRE) { const int seq = (u.pm < 256) ? (u.pm >> 3) : 32;
            const float* src = (wid < 4) ? rowss + u.pm * BM + wid * 64 : bias + (size_t)seq * N + u.pn * BM + (wid - 4) * 64;
            __builtin_amdgcn_global_load_lds((const unsigned*)(src + lane), (PG8_LAS unsigned*)(sp + wid * 256), 4, 0, 0); }
    }
    __device__ __forceinline__ void operator()(f32x4 (&acc)[2][2][4][2], const Unit& u, int wr, int wc, int fr, int fq, PG8_LAS unsigned char* sp) const {
        bf16_t* base; int ldc, colt;
        if (u.pn < n0) { base = p0; ldc = ld0; colt = u.pn * BM; }
        else if (u.pn < n1) { base = p1; ldc = ld1; colt = (u.pn - n0) * BM; }
        else { base = p2; ldc = ld2; colt = (u.pn - n1) * BM; }
        const bool isv = (u.pn >= n1), isq = (u.pn < n0);
        const int wid = wr * 4 + wc;
        const int row0 = u.pm * BM + wr * 64 + fr; const int col0 = colt + wc * 32 + 8 * fq;
        if (PRE) { const PG8_LAS float* spf = (const PG8_LAS float*)sp; const PG8_LAS float* bp = spf + 256 + wc * 32 + 8 * fq;
            const f32x4 b00 = *(const PG8_LAS f32x4*)(bp), b01 = *(const PG8_LAS f32x4*)(bp + 4), b10 = *(const PG8_LAS f32x4*)(bp + HALF), b11 = *(const PG8_LAS f32x4*)(bp + HALF + 4);
#pragma unroll
            for (int ai = 0; ai < 2; ++ai)
#pragma unroll
                for (int m = 0; m < 4; ++m) { const float rr = 1.0f / sqrtf(spf[ai * HALF + wr * 64 + m * 16 + fr] * (1.0f / 1024.0f) + EPI_EPS);
                    acc[ai][0][m][0] = acc[ai][0][m][0] * rr + b00; acc[ai][0][m][1] = acc[ai][0][m][1] * rr + b01; acc[ai][1][m][0] = acc[ai][1][m][0] * rr + b10; acc[ai][1][m][1] = acc[ai][1][m][1] * rr + b11; } }
        float part[16];
        if (!isv) {
#pragma unroll
            for (int ai = 0; ai < 2; ++ai)
#pragma unroll
                for (int m = 0; m < 4; ++m)
#pragma unroll
                    for (int bj = 0; bj < 2; ++bj) { const f32x4 a = acc[ai][bj][m][0], b = acc[ai][bj][m][1];
                        float s = (a[0] * a[0] + a[1] * a[1]) + (a[2] * a[2] + a[3] * a[3]) + (b[0] * b[0] + b[1] * b[1]) + (b[2] * b[2] + b[3] * b[3]);
                        s += __shfl_xor(s, 16); s += __shfl_xor(s, 32); const int idx = (ai * 4 + m) * 2 + bj; part[idx] = s;
                        if (fq == 0) xch[wid * 256 + idx * 16 + fr] = s; }
        }
        asm volatile("s_waitcnt lgkmcnt(0)" ::: "memory"); __builtin_amdgcn_s_barrier(); asm volatile("" ::: "memory");
        if (!isv) {
            const float* gp = (isq ? qgain : kgain) + 32 * (wc & 1) + 8 * fq; const float gs = isq ? qscale : 1.0f;
            const f32x4 gl0 = *(const f32x4*)(gp) * gs, gl1 = *(const f32x4*)(gp + 4) * gs;
#pragma unroll
            for (int ai = 0; ai < 2; ++ai)
#pragma unroll
                for (int m = 0; m < 4; ++m) { const int row = row0 + ai * HALF + m * 16;
                    f32x4 cs0 = {1.f, 0.f, 1.f, 0.f}, cs1 = {1.f, 0.f, 1.f, 0.f};
                    if (ROPE) { const int t = (row < 65536) ? (row & 2047) : (row - 65536); const int pos = (wc & 1) ? (t & 63) : (t >> 6);
                        const float* tp = ropetab + (size_t)(pos * 16 + 4 * fq) * 2; cs0 = *(const f32x4*)(tp); cs1 = *(const f32x4*)(tp + 4); }
                    bf16_t* rowp = base + (size_t)row * ldc + col0;
#pragma unroll
                    for (int bj = 0; bj < 2; ++bj) { const int idx = (ai * 4 + m) * 2 + bj;
                        const float tot = part[idx] + xch[(wid ^ 1) * 256 + idx * 16 + fr]; const float rinv = 1.0f / sqrtf(tot * (1.0f / 64.0f) + EPI_EPS);
                        f32x4 v0 = acc[ai][bj][m][0] * rinv * gl0, v1 = acc[ai][bj][m][1] * rinv * gl1;
                        if (ROPE) { const f32x4 a = v0, b = v1;
                            v0[0] = a[0] * cs0[0] - a[1] * cs0[1]; v0[1] = a[0] * cs0[1] + a[1] * cs0[0]; v0[2] = a[2] * cs0[2] - a[3] * cs0[3]; v0[3] = a[2] * cs0[3] + a[3] * cs0[2];
                            v1[0] = b[0] * cs1[0] - b[1] * cs1[1]; v1[1] = b[0] * cs1[1] + b[1] * cs1[0]; v1[2] = b[2] * cs1[2] - b[3] * cs1[3]; v1[3] = b[2] * cs1[3] + b[3] * cs1[2]; }
                        u32x4 w; w.x = cvt_pk_bf16(v0[0], v0[1]); w.y = cvt_pk_bf16(v0[2], v0[3]); w.z = cvt_pk_bf16(v1[0], v1[1]); w.w = cvt_pk_bf16(v1[2], v1[3]);
                        *(u32x4*)(rowp + bj * HALF) = w; } }
        } else {
#pragma unroll
            for (int ai = 0; ai < 2; ++ai)
#pragma unroll
                for (int m = 0; m < 4; ++m) { bf16_t* rowp = base + (size_t)(row0 + ai * HALF + m * 16) * ldc + col0;
#pragma unroll
                    for (int bj = 0; bj < 2; ++bj) { const f32x4 v0 = acc[ai][bj][m][0], v1 = acc[ai][bj][m][1];
                        u32x4 w; w.x = cvt_pk_bf16(v0[0], v0[1]); w.y = cvt_pk_bf16(v0[2], v0[3]); w.z = cvt_pk_bf16(v1[0], v1[1]); w.w = cvt_pk_bf16(v1[2], v1[3]);
                        *(u32x4*)(rowp + bj * HALF) = w; } }
        }
    }
};
template <class Epi, class Sched, bool ALIGN_EPI = false, bool SP2 = false>
__device__ __forceinline__ void gemm_phase(PG8_LAS unsigned char* lds, const Gemm g, const Sched& S, const Epi& E) {
    int tid_ = threadIdx.x; asm volatile("" : "+v"(tid_));
    const int tid = tid_, wid = __builtin_amdgcn_readfirstlane(tid >> 6), lane = tid & 63, wr = wid >> 2, wc = wid & 3, fr = lane & 15, fq = lane >> 4;
    const int K = g.K, nt = K / BK;
    unsigned voffA[2], voffB[2];
#pragma unroll
    for (int i = 0; i < 2; ++i) { int R, C; stage_rc(tid * 16 + i * 8192, R, C); const int Rb = Epi::PERM ? ((R & ~31) + perm32(R & 31)) : R;
        voffA[i] = (unsigned)(R * K + C) * 2u; voffB[i] = (unsigned)(Rb * K + C) * 2u; }
    const size_t kstep = (size_t)(BK * 2);
    const size_t hstep = (size_t)HALF * K * 2;
    const size_t tstep = 2 * hstep;
    const unsigned ldsw = (unsigned)wid * 1024u;
    const int aoff = lds_byte(wr * 64 + fr, fq * 8), boff = lds_byte(wc * 32 + fr, fq * 8);
#define PG8_SA(b, h) (((b) * 2 + (h)) * HTB)
#define PG8_SB(b, h) ((4 + (b) * 2 + (h)) * HTB)
#define PG8_STAGE(bufoff, gbase, voff) do { _Pragma("unroll") for (int _i = 0; _i < 2; ++_i) \
        __builtin_amdgcn_global_load_lds((const unsigned*)((const char*)(gbase) + (voff)[_i]), (PG8_LAS unsigned*)(lds + (bufoff) + ldsw + _i * 8192), 16, 0, 0); } while (0)
#define PG8_LDA(dst, b, h) do { _Pragma("unroll") for (int m = 0; m < 4; ++m) _Pragma("unroll") for (int k = 0; k < 2; ++k) dst[m][k] = *(const PG8_LAS bf16x8*)(lds + PG8_SA(b, h) + aoff + m * 2048 + k * 1024); } while (0)
#define PG8_LDB(dst, b, h) do { _Pragma("unroll") for (int n = 0; n < 2; ++n) _Pragma("unroll") for (int k = 0; k < 2; ++k) dst[n][k] = *(const PG8_LAS bf16x8*)(lds + PG8_SB(b, h) + boff + n * 2048 + k * 1024); } while (0)
#define PG8_MMA(ai, bj, At, Bt) do { __builtin_amdgcn_s_setprio(1); _Pragma("unroll") for (int m = 0; m < 4; ++m) _Pragma("unroll") for (int n = 0; n < 2; ++n) _Pragma("unroll") for (int k = 0; k < 2; ++k) \
        acc[ai][bj][m][n] = __builtin_amdgcn_mfma_f32_16x16x32_bf16(Bt[n][k], At[m][k], acc[ai][bj][m][n], 0, 0, 0); __builtin_amdgcn_s_setprio(0); } while (0)
#define PG8_WAIT_V(n) asm volatile("s_waitcnt vmcnt(" #n ")" ::: "memory")
#define PG8_WAIT_L(n) asm volatile("s_waitcnt lgkmcnt(" #n ")" ::: "memory")
#define PG8_BAR __builtin_amdgcn_s_barrier()
#define PG8_SCHED __builtin_amdgcn_sched_barrier(0)
    Unit cur, nxt; int ui = 0;
    if (!S.next(0, cur)) return;
    f32x4 acc[2][2][4][2];
#pragma unroll
    for (int a = 0; a < 2; ++a)
#pragma unroll
        for (int b = 0; b < 2; ++b)
#pragma unroll
            for (int m = 0; m < 4; ++m)
#pragma unroll
                for (int n = 0; n < 2; ++n) acc[a][b][m][n] = (f32x4){0.f, 0.f, 0.f, 0.f};
    bf16x8 At[4][2], B0[2][2], B1[2][2];
    const char* cA = (const char*)g.A + (size_t)cur.pm * tstep; const char* cB = (const char*)g.Bt + (size_t)cur.pn * tstep;
    S.a_ready(cur);
    if constexpr (SP2) {
        PG8_STAGE(PG8_SB(0, 0), cB, voffB); PG8_STAGE(PG8_SB(0, 1), cB + hstep, voffB); PG8_STAGE(PG8_SA(0, 0), cA, voffA); PG8_STAGE(PG8_SA(0, 1), cA + hstep, voffA);
        if (wr == 1) PG8_BAR;
        PG8_WAIT_V(2); PG8_BAR;
        PG8_STAGE(PG8_SB(1, 0), cB + kstep, voffB); PG8_STAGE(PG8_SA(1, 0), cA + kstep, voffA); PG8_STAGE(PG8_SB(1, 1), cB + hstep + kstep, voffB);
        PG8_WAIT_V(6); PG8_BAR;
    } else {
        PG8_STAGE(PG8_SB(0, 0), cB, voffB); PG8_STAGE(PG8_SA(0, 0), cA, voffA); PG8_STAGE(PG8_SB(0, 1), cB + hstep, voffB); PG8_STAGE(PG8_SA(0, 1), cA + hstep, voffA);
        if (wr == 1) PG8_BAR;
        PG8_WAIT_V(4); PG8_BAR;
        PG8_STAGE(PG8_SB(1, 0), cB + kstep, voffB); PG8_STAGE(PG8_SA(1, 0), cA + kstep, voffA); PG8_STAGE(PG8_SB(1, 1), cB + hstep + kstep, voffB);
        PG8_WAIT_V(6); PG8_BAR;
    }
    for (;;) {
        const bool has_next = S.next(ui + 1, nxt);
        const char* nA = has_next ? (const char*)g.A + (size_t)nxt.pm * tstep : cA; const char* nB = has_next ? (const char*)g.Bt + (size_t)nxt.pn * tstep : cB;
        for (int t = 0; t < nt; t += 2) {
            const bool last = (t == nt - 2);
            const char* a1 = cA + (size_t)(t + 1) * kstep;
            const char* a2 = last ? nA : cA + (size_t)(t + 2) * kstep; const char* b2 = last ? nB : cB + (size_t)(t + 2) * kstep;
            const char* a3 = a2 + kstep; const char* b3 = b2 + kstep;
            if (last && has_next) S.a_ready(nxt);
            if (last) E.prefetch(lds + 139264, cur, wid, lane);
            if constexpr (SP2) {
            PG8_LDB(B0, 0, 0); PG8_LDB(B1, 0, 1); PG8_SCHED; PG8_LDA(At, 0, 0); PG8_STAGE(PG8_SA(1, 1), a1 + hstep, voffA);
            PG8_WAIT_V(8); PG8_WAIT_L(0); PG8_BAR; PG8_MMA(0, 0, At, B0); PG8_MMA(0, 1, At, B1); PG8_BAR; PG8_SCHED;
            PG8_LDA(At, 0, 1); PG8_STAGE(PG8_SB(0, 0), b2, voffB); PG8_STAGE(PG8_SB(0, 1), b2 + hstep, voffB); PG8_STAGE(PG8_SA(0, 0), a2, voffA);
            PG8_WAIT_V(8); PG8_WAIT_L(0); PG8_BAR; PG8_MMA(1, 0, At, B0); PG8_MMA(1, 1, At, B1); PG8_BAR; PG8_SCHED;
            PG8_LDB(B0, 1, 0); PG8_LDB(B1, 1, 1); PG8_SCHED; PG8_LDA(At, 1, 0); PG8_STAGE(PG8_SA(0, 1), a2 + hstep, voffA);
            PG8_WAIT_V(8); PG8_WAIT_L(0); PG8_BAR; PG8_MMA(0, 0, At, B0); PG8_MMA(0, 1, At, B1); PG8_BAR; PG8_SCHED;
            PG8_LDA(At, 1, 1); PG8_STAGE(PG8_SB(1, 0), b3, voffB); PG8_STAGE(PG8_SB(1, 1), b3 + hstep, voffB); PG8_STAGE(PG8_SA(1, 0), a3, voffA);
            PG8_WAIT_V(8); PG8_WAIT_L(0); PG8_BAR; PG8_MMA(1, 0, At, B0); PG8_MMA(1, 1, At, B1); PG8_BAR; PG8_SCHED;
            } else {
            PG8_LDB(B0, 0, 0); PG8_SCHED; PG8_LDA(At, 0, 0); PG8_STAGE(PG8_SA(1, 1), a1 + hstep, voffA);
            PG8_WAIT_L(8); PG8_BAR; PG8_WAIT_L(0); PG8_MMA(0, 0, At, B0); PG8_BAR; PG8_SCHED;
            PG8_LDB(B1, 0, 1); PG8_STAGE(PG8_SB(0, 0), b2, voffB);
            PG8_BAR; PG8_WAIT_L(0); PG8_MMA(0, 1, At, B1); PG8_BAR;
            PG8_LDA(At, 0, 1); PG8_STAGE(PG8_SA(0, 0), a2, voffA);
            PG8_BAR; PG8_WAIT_L(0); PG8_MMA(1, 0, At, B0); PG8_BAR; PG8_SCHED;
            PG8_STAGE(PG8_SB(0, 1), b2 + hstep, voffB);
            PG8_WAIT_V(6); PG8_BAR; PG8_MMA(1, 1, At, B1); PG8_BAR;
            PG8_LDB(B0, 1, 0); PG8_SCHED; PG8_LDA(At, 1, 0); PG8_STAGE(PG8_SA(0, 1), a2 + hstep, voffA);
            PG8_WAIT_L(8); PG8_BAR; PG8_WAIT_L(0); PG8_MMA(0, 0, At, B0); PG8_BAR; PG8_SCHED;
            PG8_LDB(B1, 1, 1); PG8_STAGE(PG8_SB(1, 0), b3, voffB);
            PG8_BAR; PG8_WAIT_L(0); PG8_MMA(0, 1, At, B1); PG8_BAR;
            PG8_LDA(At, 1, 1); PG8_STAGE(PG8_SA(1, 0), a3, voffA);
            PG8_BAR; PG8_WAIT_L(0); PG8_MMA(1, 0, At, B0); PG8_BAR; PG8_SCHED;
            PG8_STAGE(PG8_SB(1, 1), b3 + hstep, voffB);
            PG8_WAIT_V(6); PG8_BAR; PG8_MMA(1, 1, At, B1); PG8_BAR;
            }
        }
        if constexpr (ALIGN_EPI) { if (wr == 0) PG8_BAR; }
        if constexpr (!Epi::AFTER_DRAIN) { E(acc, cur, wr, wc, fr, fq, lds + 139264); S.done(cur); }
        if (!has_next) break;
#pragma unroll
        for (int a = 0; a < 2; ++a)
#pragma unroll
            for (int b = 0; b < 2; ++b)
#pragma unroll
                for (int m = 0; m < 4; ++m)
#pragma unroll
                    for (int n = 0; n < 2; ++n) acc[a][b][m][n] = (f32x4){0.f, 0.f, 0.f, 0.f};
        cur = nxt; cA = nA; cB = nB; ++ui;
        if constexpr (ALIGN_EPI) { if (wr == 1) PG8_BAR; }
    }
    PG8_WAIT_V(0);
    if constexpr (!ALIGN_EPI) { if (wr == 0) PG8_BAR; }
    PG8_BAR;
    if constexpr (Epi::AFTER_DRAIN) { E.fused(acc, cur, wr, wc, fr, fq, lds, wid, lane); S.done(cur); }
#undef PG8_SA
#undef PG8_SB
#undef PG8_STAGE
#undef PG8_LDA
#undef PG8_LDB
#undef PG8_MMA
#undef PG8_WAIT_V
#undef PG8_WAIT_L
#undef PG8_BAR
#undef PG8_SCHED
}
}
#ifndef PG8_SP2
#define PG8_SP2 true
#endif
#ifndef PG8_ALIGN
#define PG8_ALIGN true
#endif
#include <hip/hip_bf16.h>
#include <cmath>
namespace attn_body {
using bf16=__hip_bfloat16;
using bf16x8=__attribute__((ext_vector_type(8)))short;
using s16x4=__attribute__((ext_vector_type(4)))short;
using f32x16=__attribute__((ext_vector_type(16)))float;
using u32x4=__attribute__((ext_vector_type(4)))unsigned;
constexpr int D=64;
constexpr int NW=8,QBLK=32,QB=QBLK*NW,KVBLK=64;
constexpr int ATTN_UNIT_ROWS=QB;
__device__ __forceinline__ int crow(int r,int hi){return (r&3)+8*(r>>2)+4*hi;}
#define SBAR() __builtin_amdgcn_sched_barrier(0)
constexpr int NSLOT=3, SLOTB=8192;
constexpr int LDS_K=0, LDS_V=NSLOT*SLOTB, LDS_WS=2*NSLOT*SLOTB, LDS_OST=LDS_WS+NW*64*4, LDS_BT=LDS_OST+NW*4096, LDS_BYTES=LDS_BT+768*4;
constexpr float C2=0.125f*1.4426950408889634f;
__device__ __forceinline__ void glds16(const void*gsrc,unsigned lds_dst){unsigned keep;
  asm volatile("s_mov_b32 %0, m0\n\ts_mov_b32 m0, %2\n\ts_nop 0\n\tglobal_load_lds_dwordx4 %1, off\n\ts_mov_b32 m0, %0":"=&s"(keep):"v"(gsrc),"s"(lds_dst):"memory");}
__device__ __forceinline__ void glds16s(const void*sbase,unsigned voff,unsigned lds_dst){unsigned keep;
  asm volatile("s_mov_b32 %0, m0\n\ts_mov_b32 m0, %3\n\ts_nop 0\n\tglobal_load_lds_dwordx4 %1, %2\n\ts_mov_b32 m0, %0":"=&s"(keep):"v"(voff),"s"(sbase),"s"(lds_dst):"memory");}
__device__ __forceinline__ float max3f(float a,float b,float c){float r;asm("v_max3_f32 %0, %1, %2, %3":"=v"(r):"v"(a),"v"(b),"v"(c));return r;}
__device__ __forceinline__ float max2f(float a,float b){float r;asm("v_max_f32_e32 %0, %1, %2":"=v"(r):"v"(a),"v"(b));return r;}
__device__ __forceinline__ float fadd_s(float a,float b){float r;asm("v_add_f32_e32 %0, %1, %2":"=v"(r):"v"(a),"v"(b));return r;}
__device__ __forceinline__ float fsub_s(float a,float b){float r;asm("v_sub_f32_e32 %0, %1, %2":"=v"(r):"v"(a),"v"(b));return r;}
typedef float f32x2_t __attribute__((ext_vector_type(2))); typedef __bf16 bf16x2_t __attribute__((ext_vector_type(2)));
__device__ __forceinline__ unsigned cvtpk_s(float lo,float hi){f32x2_t v={lo,hi};bf16x2_t b=__builtin_convertvector(v,bf16x2_t);return __builtin_bit_cast(unsigned,b);}
#define WAIT_BAR(N) asm volatile("s_waitcnt vmcnt(" #N ") lgkmcnt(0)\n\ts_barrier":::"memory")

__device__ __forceinline__ void qkt(f32x16&p0,f32x16&p1,const char*Kslot,const bf16x8*qr,const f32x16&negm,int r32,int hi){
  const char*kb=Kslot+hi*1024+r32*16;
  #pragma unroll
  for(int d0=0;d0<4;++d0){
    const bf16x8 b0=*reinterpret_cast<const bf16x8*>(kb+d0*2048);
    const bf16x8 b1=*reinterpret_cast<const bf16x8*>(kb+d0*2048+512);
    if(d0==0){p0=__builtin_amdgcn_mfma_f32_32x32x16_bf16(b0,qr[0],negm,0,0,0);p1=__builtin_amdgcn_mfma_f32_32x32x16_bf16(b1,qr[0],negm,0,0,0);}
    else{p0=__builtin_amdgcn_mfma_f32_32x32x16_bf16(b0,qr[d0],p0,0,0,0);p1=__builtin_amdgcn_mfma_f32_32x32x16_bf16(b1,qr[d0],p1,0,0,0);}}
}
typedef __attribute__((address_space(3))) const char* lds_cptr;
typedef short v4i16_t __attribute__((ext_vector_type(4)));
__device__ __forceinline__ void kload8(bf16x8*kf,lds_cptr kp){
  kf[0]=*(const __attribute__((address_space(3))) bf16x8*)(kp);      kf[1]=*(const __attribute__((address_space(3))) bf16x8*)(kp+512);
  kf[2]=*(const __attribute__((address_space(3))) bf16x8*)(kp+2048); kf[3]=*(const __attribute__((address_space(3))) bf16x8*)(kp+2560);
  kf[4]=*(const __attribute__((address_space(3))) bf16x8*)(kp+4096); kf[5]=*(const __attribute__((address_space(3))) bf16x8*)(kp+4608);
  kf[6]=*(const __attribute__((address_space(3))) bf16x8*)(kp+6144); kf[7]=*(const __attribute__((address_space(3))) bf16x8*)(kp+6656);
}
__device__ __forceinline__ void kload2(bf16x8*kf,lds_cptr kp,int j){ kf[2*j]=*(const __attribute__((address_space(3))) bf16x8*)(kp+j*2048); kf[2*j+1]=*(const __attribute__((address_space(3))) bf16x8*)(kp+j*2048+512); }
__device__ __forceinline__ s16x4 vtr(lds_cptr p){ return __builtin_bit_cast(s16x4,__builtin_amdgcn_ds_read_tr16_b64_v4i16((__attribute__((address_space(3))) v4i16_t*)p)); }
__device__ __forceinline__ float rowmax(const f32x16&p0,const f32x16&p1){
  float a=max3f(p0[0],p0[1],p1[0]),b=max3f(p0[2],p0[3],p1[1]);a=max3f(a,p1[2],p1[3]);
  #pragma unroll
  for(int r=4;r<16;r+=4){a=max3f(a,p0[r],p0[r+1]);b=max3f(b,p0[r+2],p0[r+3]);a=max3f(a,p1[r],p1[r+1]);b=max3f(b,p1[r+2],p1[r+3]);}
  const float m=max2f(a,b);
  auto rr=__builtin_amdgcn_permlane32_swap(__float_as_uint(m),__float_as_uint(m),false,false);
  return max2f(__uint_as_float(rr[0]),__uint_as_float(rr[1]));
}
__device__ __forceinline__ void pv(f32x16*o,int vb,bf16x8 pa0,bf16x8 pa1,bf16x8 pa2,bf16x8 pa3){
  #pragma unroll
  for(int d0=0;d0<2;++d0){s16x4 lo[4],hi[4];
    #pragma unroll
    for(int ks=0;ks<4;++ks){
      asm volatile("ds_read_b64_tr_b16 %0,%1 offset:%c2":"=&v"(lo[ks]):"v"(vb),"i"(d0*4096+ks*1024):"memory");
      asm volatile("ds_read_b64_tr_b16 %0,%1 offset:%c2":"=&v"(hi[ks]):"v"(vb),"i"(d0*4096+ks*1024+512):"memory");}
    asm volatile("s_waitcnt lgkmcnt(0)":::"memory");SBAR();
    #define PK(k) (bf16x8){lo[k][0],lo[k][1],lo[k][2],lo[k][3],hi[k][0],hi[k][1],hi[k][2],hi[k][3]}
    o[d0]=__builtin_amdgcn_mfma_f32_32x32x16_bf16(pa0,PK(0),o[d0],0,0,0);
    o[d0]=__builtin_amdgcn_mfma_f32_32x32x16_bf16(pa1,PK(1),o[d0],0,0,0);
    o[d0]=__builtin_amdgcn_mfma_f32_32x32x16_bf16(pa2,PK(2),o[d0],0,0,0);
    o[d0]=__builtin_amdgcn_mfma_f32_32x32x16_bf16(pa3,PK(3),o[d0],0,0,0);
    #undef PK
  }
}

#ifndef ATTN_STORE16
#define ATTN_STORE16(p,v) (*(u32x4*)(p)=(v))
#endif
template<int VH> struct AttnLds { static constexpr int KSL=8192, VSL=8192*VH, L_K=0, L_V=4*KSL, L_WS=L_V+3*VSL, L_BT=L_WS+NW*64*4, BYTES=L_BT+768*4; };
template<int VH,bool HAS_BIAS,int MODE> __device__ __forceinline__ void attn_unit2(const bf16*Qb,int qp,const bf16*__restrict__ Kb,int kp,const bf16*__restrict__ Vb,int vp,bf16*Ob,int op,int q0,int NT,const float*relb,char*shm,float lam,const float*subg,float gmul){
  typedef AttnLds<VH> LM; constexpr int KSL=LM::KSL, VSL=LM::VSL;
  int tid_=threadIdx.x; asm volatile("":"+v"(tid_));
  const int tid=tid_,lane=tid&63,r32=lane&31,hi=lane>>5; const int wid=__builtin_amdgcn_readfirstlane(tid>>6);
  const bf16*Qw=Qb+(long)(q0+wid*QBLK)*qp;
  const unsigned lds0=(unsigned)(uintptr_t)shm;
  const lds_cptr shm3=(lds_cptr)shm;
  float*wsf=(float*)(shm+LM::L_WS)+wid*64;
  const unsigned ksrc=(unsigned)(lane*kp+wid*8)*2u;
  const unsigned vsrc=(unsigned)((16*(wid&3)+(lane>>2))*vp+(wid>>2)*32+(lane&3)*8)*2u;
  const unsigned kdst=lds0+LM::L_K+wid*1024, vdst=lds0+LM::L_V+wid*1024;
  #define DMA_K(t,slot) glds16s(Kb+(long)(t)*KVBLK*kp,ksrc,(unsigned)__builtin_amdgcn_readfirstlane(kdst+(slot)))
  #define DMA_V(t,slot) do{ glds16s(Vb+(long)(t)*KVBLK*vp,vsrc,(unsigned)__builtin_amdgcn_readfirstlane(vdst+(slot))); \
      if(VH==2) glds16s(Vb+(long)(t)*KVBLK*vp+64,vsrc,(unsigned)__builtin_amdgcn_readfirstlane(vdst+(slot)+8192)); }while(0)
  const int vb0=(int)(lds0+LM::L_V)+((lane>>4)&1)*32+(lane&3)*8+(4*hi+((lane&15)>>2))*64;
  const lds_cptr kp0=shm3+LM::L_K+hi*1024+r32*16;
  const lds_cptr vp0=shm3+LM::L_V+((lane>>4)&1)*32+(lane&3)*8+(4*hi+((lane&15)>>2))*64;
  const int qw_=q0+32*wid; const int tn0=HAS_BIAS?(qw_>=90?((qw_-90)>>6):0):0, tn1=HAS_BIAS?(((qw_+185)>>6)<NT?((qw_+185)>>6):NT):0;
  float cb=0.f,ca=0.f;
  typedef __attribute__((address_space(3))) float lds_f32;
  typedef __attribute__((address_space(3))) char* lds_ptr_;
  lds_f32* btab=(lds_f32*)((lds_ptr_)shm)+LM::L_BT/4;
  if(HAS_BIAS){ const float L2E=1.4426950408889634f; cb=L2E*relb[15*8]; ca=L2E*relb[31*8];
    for(int i=tid;i<768;i+=512){ const int rel=i-384; const int n=rel<0?-rel:rel; int bk=n<8?n:(8+(31-__builtin_clz((unsigned)(n*n)))-6); if(n>=8&&bk>15)bk=15; if(rel>0)bk+=16; btab[i]=L2E*relb[bk*8]; } }
  const int lanebias=-q0-32*wid-r32+4*hi+384;
  #define CREG(tt) (HAS_BIAS?(((tt)<tn0)?cb:(((tt)<tn1)?0.f:ca)):0.f)
  #define BIASADD(P0,P1,t) do{ if(HAS_BIAS&&(t)>=tn0&&(t)<tn1){ const lds_f32*bp_=btab+(64*(t)+lanebias); \
    _Pragma("unroll") for(int r=0;r<16;++r){ P0[r]+=bp_[(r&3)+8*(r>>2)]; P1[r]+=bp_[(r&3)+8*(r>>2)+32]; } } }while(0)
  #define RSCALE(t) do{ if(HAS_BIAS&&((t)==tn0||(t)==tn1)){ const float f_=__builtin_amdgcn_exp2f(CREG((t)-1)-CREG(t)); l_reg*=f_; \
    _Pragma("unroll") for(int d_=0;d_<2*VH;++d_) _Pragma("unroll") for(int r=0;r<16;++r)o[d_][r]*=f_; } }while(0)
  DMA_K(0,0);DMA_V(0,0);DMA_K(1,KSL);
  bf16x8 qr[4];
  #pragma unroll
  for(int d0=0;d0<4;++d0)qr[d0]=*reinterpret_cast<const bf16x8*>(&Qw[(long)r32*qp+d0*16+hi*8]);
  DMA_K(2,2*KSL);
  float l_reg=0.f;f32x16 o[2*VH];
  #pragma unroll
  for(int d_=0;d_<2*VH;++d_)o[d_]=f32x16{};
  const f32x16 zero16=f32x16{};
  f32x16 pA0,pA1,pB0,pB1; bf16x8 kf[4];
  int sv_prev=0,sv_cur=0,sv_next=VSL;
  #define ROT() do{sv_prev=sv_cur;sv_cur=sv_next;sv_next=(sv_next==2*VSL)?0:sv_next+VSL;}while(0)
  #define KLD(p) (*(const __attribute__((address_space(3))) bf16x8*)(p))
  #define KPRE(tn) do{ const lds_cptr kn_=kp0+(((tn)&3)*KSL); kf[0]=KLD(kn_); kf[1]=KLD(kn_+512); kf[2]=KLD(kn_+2048); kf[3]=KLD(kn_+2560); }while(0)
  if(VH==1){WAIT_BAR(3);}else{WAIT_BAR(4);}
  qkt(pA0,pA1,shm+LM::L_K,qr,zero16,r32,hi);
  BIASADD(pA0,pA1,0);
  _Pragma("unroll") for(int r=0;r<16;++r){pA0[r]=__builtin_amdgcn_exp2f(pA0[r]);pA1[r]=__builtin_amdgcn_exp2f(pA1[r]);}
  WAIT_BAR(0);
  DMA_K(3,3*KSL);DMA_V(1,VSL);
  ROT();
  KPRE(1);
  s16x4 vlo[8],vhi[8]; u32x4 pw0,pw1,pw2,pw3;
  #define PKW(P,B) cvtpk_s(P[B],P[B+1])
  #define PAF(k) __builtin_bit_cast(bf16x8,pw##k)
  #define VFR(i) (bf16x8){vlo[i][0],vlo[i][1],vlo[i][2],vlo[i][3],vhi[i][0],vhi[i][1],vhi[i][2],vhi[i][3]}
  #define PIN(x) asm volatile("":"+v"(x))
  #define MF(a,b,c) __builtin_amdgcn_mfma_f32_32x32x16_bf16(a,b,c,0,0,0)
  #define GAPA(MFX,A0,A1,A2,A3,W0,W1,PW) do{ MFX; sacc+=A0; sacc+=A1; sacc+=A2; sacc+=A3; PIN(sacc); W0; W1; PIN(PW); SBAR(); }while(0)
  #define EX(v) __builtin_amdgcn_exp2f(v)
  #define GAPB4(MFX,X,B) do{ MFX; X[B]=EX(X[B]); X[B+1]=EX(X[B+1]); X[B+2]=EX(X[B+2]); X[B+3]=EX(X[B+3]); PIN(X); SBAR(); }while(0)
  #define GAPB2(MFX,X,B) do{ MFX; X[B]=EX(X[B]); X[B+1]=EX(X[B+1]); PIN(X); SBAR(); }while(0)
  #define VRD(i,hv) do{ vlo[i]=vtr(vp_+((hv)*8192+((i)>>2)*4096+((i)&3)*1024)); vhi[i]=vtr(vp_+((hv)*8192+((i)>>2)*4096+((i)&3)*1024+512)); }while(0)
  #define STEP(C0,C1,P0,P1,t,GK,GV,GL) do{ SBAR(); \
    const lds_cptr vp_=vp0+sv_prev; const lds_cptr kq_=kp0+(((t)&3)*KSL); \
    VRD(0,0); SBAR(); float sacc=(P0[0]+P0[1]); \
    GAPA(C0=MF(kf[0],qr[0],zero16), P0[2],P0[3],P0[4],P0[5],     pw0[0]=PKW(P0,0), pw0[1]=PKW(P0,2), pw0); \
    VRD(4,0); SBAR(); GAPA(C1=MF(kf[1],qr[0],zero16), P0[6],P0[7],P0[8],P0[9],     pw0[2]=PKW(P0,4), pw0[3]=PKW(P0,6), pw0); \
    kf[0]=KLD(kq_+4096); kf[1]=KLD(kq_+4608); SBAR(); \
    VRD(1,0); SBAR(); GAPA(C0=MF(kf[2],qr[1],C0),   P0[10],P0[11],P0[12],P0[13], pw1[0]=PKW(P0,8), pw1[1]=PKW(P0,10), pw1); \
    VRD(5,0); SBAR(); GAPA(C1=MF(kf[3],qr[1],C1),   P0[14],P0[15],P1[0],P1[1],   pw1[2]=PKW(P0,12),pw1[3]=PKW(P0,14), pw1); \
    kf[2]=KLD(kq_+6144); kf[3]=KLD(kq_+6656); SBAR(); \
    VRD(2,0); SBAR(); GAPA(C0=MF(kf[0],qr[2],C0),   P1[2],P1[3],P1[4],P1[5],     pw2[0]=PKW(P1,0), pw2[1]=PKW(P1,2), pw2); \
    VRD(6,0); SBAR(); GAPA(C1=MF(kf[1],qr[2],C1),   P1[6],P1[7],P1[8],P1[9],     pw2[2]=PKW(P1,4), pw2[3]=PKW(P1,6), pw2); \
    VRD(3,0); SBAR(); GAPA(C0=MF(kf[2],qr[3],C0),   P1[10],P1[11],P1[12],P1[13], pw3[0]=PKW(P1,8), pw3[1]=PKW(P1,10), pw3); \
    VRD(7,0); SBAR(); GAPA(C1=MF(kf[3],qr[3],C1),   P1[14],P1[15],0.f,0.f,       pw3[2]=PKW(P1,12),pw3[3]=PKW(P1,14), pw3); \
    l_reg+=sacc; \
    if(GK){DMA_K((t)+3,(((t)+3)&3)*KSL);} if(GV){DMA_V((t)+1,sv_next);} \
    BIASADD(C0,C1,t); SBAR(); \
    if(VH==1){ \
      GAPB4(o[0]=MF(PAF(0),VFR(0),o[0]), C0,0); \
      GAPB4(o[1]=MF(PAF(0),VFR(4),o[1]), C0,4); \
      GAPB4(o[0]=MF(PAF(1),VFR(1),o[0]), C0,8); \
      GAPB4(o[1]=MF(PAF(1),VFR(5),o[1]), C0,12); \
      if(GL){ KPRE((t)+1); SBAR(); } \
      GAPB4(o[0]=MF(PAF(2),VFR(2),o[0]), C1,0); \
      GAPB4(o[1]=MF(PAF(2),VFR(6),o[1]), C1,4); \
      GAPB4(o[0]=MF(PAF(3),VFR(3),o[0]), C1,8); \
      GAPB4(o[1]=MF(PAF(3),VFR(7),o[1]), C1,12); \
    } else { \
      GAPB2(o[0]=MF(PAF(0),VFR(0),o[0]), C0,0);  VRD(0,1); SBAR(); \
      GAPB2(o[1]=MF(PAF(0),VFR(4),o[1]), C0,2);  VRD(4,1); SBAR(); \
      GAPB2(o[0]=MF(PAF(1),VFR(1),o[0]), C0,4);  VRD(1,1); SBAR(); \
      GAPB2(o[1]=MF(PAF(1),VFR(5),o[1]), C0,6);  VRD(5,1); SBAR(); \
      GAPB2(o[0]=MF(PAF(2),VFR(2),o[0]), C0,8);  VRD(2,1); SBAR(); \
      GAPB2(o[1]=MF(PAF(2),VFR(6),o[1]), C0,10); VRD(6,1); SBAR(); \
      GAPB2(o[0]=MF(PAF(3),VFR(3),o[0]), C0,12); VRD(3,1); SBAR(); \
      GAPB2(o[1]=MF(PAF(3),VFR(7),o[1]), C0,14); VRD(7,1); SBAR(); \
      if(GL){ KPRE((t)+1); SBAR(); } \
      GAPB2(o[2*(VH-1)]=MF(PAF(0),VFR(0),o[2*(VH-1)]), C1,0); \
      GAPB2(o[2*(VH-1)+1]=MF(PAF(0),VFR(4),o[2*(VH-1)+1]), C1,2); \
      GAPB2(o[2*(VH-1)]=MF(PAF(1),VFR(1),o[2*(VH-1)]), C1,4); \
      GAPB2(o[2*(VH-1)+1]=MF(PAF(1),VFR(5),o[2*(VH-1)+1]), C1,6); \
      GAPB2(o[2*(VH-1)]=MF(PAF(2),VFR(2),o[2*(VH-1)]), C1,8); \
      GAPB2(o[2*(VH-1)+1]=MF(PAF(2),VFR(6),o[2*(VH-1)+1]), C1,10); \
      GAPB2(o[2*(VH-1)]=MF(PAF(3),VFR(3),o[2*(VH-1)]), C1,12); \
      GAPB2(o[2*(VH-1)+1]=MF(PAF(3),VFR(7),o[2*(VH-1)+1]), C1,14); \
    } \
    }while(0)
  #define WAITFULL() do{ if(VH==1){WAIT_BAR(2);}else{WAIT_BAR(3);} }while(0)
  #define ENDW(tt) do{ if((tt)+3<NT){WAITFULL();} else if((tt)+2<NT){ if(VH==1){WAIT_BAR(1);}else{WAIT_BAR(2);} } else {WAIT_BAR(0);} }while(0)
  int t=1;
  for(;t+5<NT;t+=2){
    STEP(pB0,pB1,pA0,pA1,t,true,true,true);     WAITFULL(); RSCALE(t);   ROT();
    STEP(pA0,pA1,pB0,pB1,t+1,true,true,true);   WAITFULL(); RSCALE(t+1); ROT();
  }
  for(;t+1<NT;t+=2){
    STEP(pB0,pB1,pA0,pA1,t,(t+3<NT),(t+1<NT),(t+1<NT));       ENDW(t);   RSCALE(t);   ROT();
    STEP(pA0,pA1,pB0,pB1,t+1,(t+4<NT),(t+2<NT),(t+2<NT));     ENDW(t+1); RSCALE(t+1); ROT();
  }
  STEP(pB0,pB1,pA0,pA1,NT-1,false,false,false); RSCALE(NT-1);
  { float sacc=pB0[0]+pB0[1]; _Pragma("unroll") for(int r=2;r<16;++r)sacc+=pB0[r]; _Pragma("unroll") for(int r=0;r<16;++r)sacc+=pB1[r]; l_reg+=sacc;
    pw0=(u32x4){PKW(pB0,0),PKW(pB0,2),PKW(pB0,4),PKW(pB0,6)};pw1=(u32x4){PKW(pB0,8),PKW(pB0,10),PKW(pB0,12),PKW(pB0,14)};pw2=(u32x4){PKW(pB1,0),PKW(pB1,2),PKW(pB1,4),PKW(pB1,6)};pw3=(u32x4){PKW(pB1,8),PKW(pB1,10),PKW(pB1,12),PKW(pB1,14)};
    SBAR(); pv(o,vb0+sv_cur,PAF(0),PAF(1),PAF(2),PAF(3)); if(VH==2){ SBAR(); pv(o+2*(VH-1),vb0+sv_cur+8192,PAF(0),PAF(1),PAF(2),PAF(3)); } }
  #undef PKW
  #undef PAF
  #undef VFR
  #undef PIN
  #undef MF
  #undef GAPA
  #undef GAPB4
  #undef GAPB2
  #undef EX
  #undef VRD
  #undef STEP
  #undef ENDW
  #undef WAITFULL
  #undef KLD
  #undef KPRE
  {auto rr=__builtin_amdgcn_permlane32_swap(__float_as_uint(l_reg),__float_as_uint(l_reg),false,false);l_reg=__uint_as_float(rr[0])+__uint_as_float(rr[1]);}
  if(hi==0)wsf[32+r32]=l_reg;
  asm volatile("s_waitcnt lgkmcnt(0)\n\ts_barrier":::"memory");
  float rli[16];
  #pragma unroll
  for(int r=0;r<16;++r)rli[r]=__builtin_amdgcn_rcpf(wsf[32+crow(r,hi)]);
  bf16*Ow=Ob+(long)(q0+wid*QBLK)*op;
  typedef __attribute__((address_space(3))) unsigned lds_u32;
  lds_u32* park=(lds_u32*)((lds_ptr_)shm+LM::BYTES)+tid;
  if(MODE==1){
    #pragma unroll
    for(int d0=0;d0<2*VH;++d0)
      #pragma unroll
      for(int r=0;r<16;r+=2)park[(d0*8+(r>>1))*512]=cvtpk_s(o[d0][r]*rli[r],o[d0][r+1]*rli[r+1]);
  } else {
    if(MODE==2){
      #pragma unroll
      for(int d0=0;d0<2*VH;++d0)
        #pragma unroll
        for(int r=0;r<16;r+=2){ const unsigned w_=park[(d0*8+(r>>1))*512];
          o[d0][r]=__uint_as_float(w_<<16)-lam*(o[d0][r]*rli[r]); o[d0][r+1]=__uint_as_float(w_&0xffff0000u)-lam*(o[d0][r+1]*rli[r+1]); }
      float gsub[2*VH];
      #pragma unroll
      for(int d0=0;d0<2*VH;++d0)gsub[d0]=subg[d0*32+r32]*gmul;
      #pragma unroll
      for(int r=0;r<16;++r){ float ss=0.f;
        #pragma unroll
        for(int d0=0;d0<2*VH;++d0)ss+=o[d0][r]*o[d0][r];
        ss+=__shfl_xor(ss,1);ss+=__shfl_xor(ss,2);ss+=__shfl_xor(ss,4);ss+=__shfl_xor(ss,8);ss+=__shfl_xor(ss,16);
        const float rs=1.0f/sqrtf(ss*(1.0f/(64.f*VH))+1e-6f);
        #pragma unroll
        for(int d0=0;d0<2*VH;++d0)o[d0][r]=o[d0][r]*rs*gsub[d0];
        rli[r]=1.0f; }
    }
    { bf16*stg=(bf16*)(shm)+wid*(2048*VH);
      #pragma unroll
      for(int r=0;r<16;++r){const int orow=crow(r,hi);
        #pragma unroll
        for(int d0=0;d0<2*VH;++d0)stg[orow*(64*VH)+d0*32+r32]=__float2bfloat16(o[d0][r]*rli[r]);}
      asm volatile("s_waitcnt lgkmcnt(0)":::"memory");
      #pragma unroll
      for(int i=0;i<4*VH;++i){const int row=(VH==1)?(i*8+(lane>>3)):(i*4+(lane>>4)),ch=(VH==1)?(lane&7):(lane&15); const u32x4 v=*(const u32x4*)(stg+row*(64*VH)+ch*8); ATTN_STORE16(Ow+(long)row*op+ch*8,v);} }
  }
  asm volatile("s_waitcnt lgkmcnt(0)\n\ts_barrier":::"memory");
  #undef DMA_K
  #undef DMA_V
  #undef BIASADD
  #undef CREG
  #undef RSCALE
  #undef ROT
}
#undef SBAR
#undef WAIT_BAR
}
constexpr int NWAVES = 8;
constexpr int DM = 1024, MP = 65536, MS = 16384, MT = MP + MS, NSEQ = 33, LP = 2048, LS = 16384, DFF = 2816, NMOD = 6144;
constexpr float EPS = 1e-6f;
constexpr float LAMBDA_INIT1 = 0.35550907f;
constexpr float QSCALE = 0.125f * 1.4426950408889634f;
constexpr size_t MiB = 1u << 20;
constexpr size_t WS_BAR = 0, BAR_BYTES = 16384;
constexpr size_t WS_MOD = 1 * MiB;
constexpr size_t WS_ROPE = 3 * MiB;
constexpr size_t WS_WQKVA = 4 * MiB, WS_WOA = 7 * MiB, WS_WQKVB = 9 * MiB, WS_WOB = 15 * MiB, WS_WGU = 17 * MiB  , WS_WD = 39 * MiB  ;
constexpr size_t WS_BV = 51 * MiB;
constexpr size_t WS_RSS = 54 * MiB;
constexpr int BV_GU0 = 0, BV_QKV1 = 33 * 5632, BV_GU1 = 33 * 5632 + 33 * 3072;
constexpr size_t WS_H = 64 * MiB, WS_Q = 224 * MiB, WS_K = 384 * MiB, WS_V = 544 * MiB, WS_O = 704 * MiB, WS_END = 864 * MiB;
constexpr size_t WS_ACT = WS_Q;
constexpr size_t WS_OC0 = WS_H, WS_OC1 = WS_O;
static_assert(WS_WD + 2 * (size_t)DM * DFF * 2 <= WS_H && WS_ACT + (size_t)MT * DFF * 2 <= WS_O, "ws map");
constexpr int RING_OFF = 0;
constexpr int LDS_BYTES = 155648;

#define GAS __attribute__((address_space(1)))
#define LAS __attribute__((address_space(3)))
typedef unsigned short bf16;
typedef unsigned v4u __attribute__((ext_vector_type(4)));
typedef float f32x4 __attribute__((ext_vector_type(4)));
#define LDS_WAIT() asm volatile("s_waitcnt lgkmcnt(0)" ::: "memory")
__device__ __forceinline__ unsigned f2bf(float f) { unsigned u = __builtin_bit_cast(unsigned, f); return (u + 0x7fffu + ((u >> 16) & 1u)) >> 16; }
__device__ __forceinline__ unsigned pk2(float lo, float hi) { return f2bf(lo) | (f2bf(hi) << 16); }
__device__ __forceinline__ float bf_lo(unsigned w) { return __builtin_bit_cast(float, w << 16); }
__device__ __forceinline__ float bf_hi(unsigned w) { return __builtin_bit_cast(float, w & 0xffff0000u); }
__device__ __forceinline__ float wave_sum(float v) {
#pragma unroll
    for (int o = 1; o < 64; o <<= 1) v += __shfl_xor(v, o);
    return v;
}
#define XB_TMO      128
#define XB_XCNT(j)  (256  + 64 * (j))
#define XB_XSUB(j)  (1280 + 64 * (j))
#define XB_XGEN(j)  (2304 + 64 * (j))
#define XB_TOP      3328
#define XB_TOPGEN   3392
#define XCD_BAR_WORDS 3456
#define XB_SPIN_CAP (1u << 18)

__device__ __forceinline__ unsigned xb_ld(unsigned* p)              { return __hip_atomic_load(p, __ATOMIC_RELAXED, __HIP_MEMORY_SCOPE_AGENT); }
__device__ __forceinline__ unsigned xb_add(unsigned* p, unsigned v) { return __hip_atomic_fetch_add(p, v, __ATOMIC_RELAXED, __HIP_MEMORY_SCOPE_AGENT); }
__device__ __forceinline__ unsigned xb_xcc_id() { return (unsigned)__builtin_amdgcn_s_getreg((3 << 11) | 20) & 0xFu; }
#define XB_SPIN(cond, bar) do { unsigned _sp = 0; while (cond) { __builtin_amdgcn_s_sleep(1); \
    if ((++_sp & 255u) == 0u) { if (xb_ld(&(bar)[XB_TMO])) break; if (_sp > XB_SPIN_CAP) { atomicAdd(&(bar)[XB_TMO], 1u); break; } } } } while (0)

struct XcdBarrier {
    unsigned* bar; unsigned x;
    volatile LAS unsigned* st;
};

__device__ __forceinline__ XcdBarrier xcd_barrier_post(unsigned* bar, volatile LAS unsigned* st) {
    XcdBarrier b; b.bar = bar; b.x = xb_xcc_id(); b.st = st;
    if (threadIdx.x == 0) (void)xb_add(&bar[XB_XCNT(b.x)], 1u);
    return b;
}
__device__ __forceinline__ void xcd_barrier_complete(unsigned* bar, unsigned x, unsigned& nloc, unsigned& nx) {
    const unsigned G = gridDim.x * gridDim.y * gridDim.z;
    unsigned sum, cnt, mine, sp = 0u;
    for (;;) {
        sum = 0u; cnt = 0u; mine = 0u;
#pragma unroll
        for (unsigned j = 0; j < 16; ++j) { const unsigned c = xb_ld(&bar[XB_XCNT(j)]); sum += c; cnt += (c > 0u) ? 1u : 0u; mine = (j == x) ? c : mine; }
        if (sum == G) break;
        __builtin_amdgcn_s_sleep(1);
        if ((++sp & 255u) == 0u) { if (xb_ld(&bar[XB_TMO])) break; if (sp > XB_SPIN_CAP) { atomicAdd(&bar[XB_TMO], 1u); break; } }
    }
    nloc = mine > 0u ? mine : 1u; nx = cnt > 0u ? cnt : 1u;
}

__device__ __forceinline__ void xcd_barrier(const XcdBarrier& b) {
    asm volatile("s_waitcnt vmcnt(0)" ::: "memory");
    __syncthreads();
    if (threadIdx.x == 0) {
        unsigned* bar = b.bar;
        __builtin_amdgcn_s_waitcnt(0);
        unsigned nloc = b.st[0], nx = b.st[1];
        if (nloc == 0u) { xcd_barrier_complete(bar, b.x, nloc, nx); b.st[0] = nloc; b.st[1] = nx; }
        const unsigned old = xb_add(&bar[XB_XSUB(b.x)], 1u);
        const unsigned gen = old / nloc;
        if (old + 1u == (gen + 1u) * nloc) {
            __builtin_amdgcn_fence(__ATOMIC_RELEASE, "agent");
            asm volatile("s_waitcnt vmcnt(0)" ::: "memory");
            const unsigned og = xb_add(&bar[XB_TOP], 1u);
            const unsigned tg = og / nx;
            if (og + 1u == (tg + 1u) * nx) xb_add(&bar[XB_TOPGEN], 1u);
            else XB_SPIN(xb_ld(&bar[XB_TOPGEN]) == tg, bar);
            __builtin_amdgcn_fence(__ATOMIC_ACQUIRE, "agent");
            xb_add(&bar[XB_XGEN(b.x)], 1u);
            asm volatile("s_waitcnt vmcnt(0)" ::: "memory");
        } else {
            XB_SPIN(xb_ld(&bar[XB_XGEN(b.x)]) == gen, bar);
            __builtin_amdgcn_fence(__ATOMIC_ACQUIRE, "agent");
            asm volatile("s_waitcnt vmcnt(0)" ::: "memory");
        }
    }
    __syncthreads();
}

__device__ __forceinline__ void p0_transpose_item(const float* W, int K, int N, bf16* WT, LAS float* scr, int k0, int n0, int drow0, int lane) {
    float tv[32];
#pragma unroll
    for (int i = 0; i < 32; ++i) { const int kk = 2 * i + (lane >> 5); tv[i] = W[(size_t)(k0 + kk) * N + n0 + (lane & 31)]; }
#pragma unroll
    for (int i = 0; i < 32; ++i) { const int kk = 2 * i + (lane >> 5); scr[kk * 33 + (lane & 31)] = tv[i]; }
    LDS_WAIT(); asm volatile("" ::: "memory");
    const int c = lane & 7;
#pragma unroll
    for (int j = 0; j < 4; ++j) { const int n = (lane >> 3) + 8 * j; const LAS float* s = scr + (8 * c) * 33 + n;
        v4u o; o.x = pk2(s[0 * 33], s[1 * 33]); o.y = pk2(s[2 * 33], s[3 * 33]); o.z = pk2(s[4 * 33], s[5 * 33]); o.w = pk2(s[6 * 33], s[7 * 33]);
        *(GAS v4u*)(WT + (size_t)(drow0 + n) * K + k0 + 8 * c) = o; }
    LDS_WAIT(); asm volatile("" ::: "memory");
}
__device__ __forceinline__ void gemv33c(int bidx, int bstride, int tid, const LAS float* vec, LAS float* red, const float* W, int N, float* outp, int ostride, const float* addb) {
    const int lane = tid & 63, wave = tid >> 6, kq = lane >> 4, nn = lane & 15, kbase = wave * 128 + 4 * kq;
    typedef float f4 __attribute__((ext_vector_type(4)));
    for (int cb = bidx; cb < N / 16; cb += bstride) {
        const float* Wn = W + 16 * cb + nn;
        float w[8][4];
#pragma unroll
        for (int u = 0; u < 8; ++u)
#pragma unroll
            for (int j = 0; j < 4; ++j) w[u][j] = Wn[(size_t)(kbase + 16 * u + j) * N];
        float acc[33];
#pragma unroll
        for (int s = 0; s < 33; ++s) acc[s] = 0.f;
#pragma unroll
        for (int s = 0; s < 33; ++s) {
#pragma unroll
            for (int u = 0; u < 8; ++u) { const f4 v = *(const LAS f4*)(vec + s * 1024 + kbase + 16 * u); acc[s] += (v.x * w[u][0] + v.y * w[u][1]) + (v.z * w[u][2] + v.w * w[u][3]); }
            asm volatile("" : "+v"(acc[s]) :: "memory"); }
#pragma unroll
        for (int s = 0; s < 33; ++s) { float a = acc[s]; a += __shfl_xor(a, 16); a += __shfl_xor(a, 32); if (kq == 0) red[(wave * 33 + s) * 16 + nn] = a; }
        __syncthreads();
        for (int o = tid; o < 528; o += 512) { const int s = o >> 4, n2 = o & 15; float a = 0.f;
#pragma unroll
            for (int ww = 0; ww < 8; ++ww) a += red[(ww * 33 + s) * 16 + n2];
            outp[(size_t)s * ostride + 16 * cb + n2] = a + (addb ? addb[16 * cb + n2] : 0.f); }
        __syncthreads();
    }
}
struct Args { const float* in[24]; float* out; unsigned char* ws; };

__device__ __forceinline__ void norm_rows(int gw, int NGW, int lane, const float* src_p, const float* src_s, const float* gain, const float* modl, int sh_off, int sc_off, bf16* H) {
    for (int m0 = gw; m0 < MT; m0 += 2 * NGW) {
        const int m1 = m0 + NGW; const bool has1 = m1 < MT; const int m1c = has1 ? m1 : m0;
        const float* s0 = (m0 < MP) ? src_p + (size_t)m0 * DM : src_s + (size_t)(m0 - MP) * DM;
        const float* s1 = (m1c < MP) ? src_p + (size_t)m1c * DM : src_s + (size_t)(m1c - MP) * DM;
        const GAS f32x4* x0 = (const GAS f32x4*)s0 + lane; const GAS f32x4* x1 = (const GAS f32x4*)s1 + lane;
        f32x4 v0[4], v1[4]; float q0 = 0.f, q1 = 0.f;
#pragma unroll
        for (int j = 0; j < 4; ++j) { v0[j] = x0[64 * j]; v1[j] = x1[64 * j]; }
#pragma unroll
        for (int j = 0; j < 4; ++j) { q0 += (v0[j].x * v0[j].x + v0[j].y * v0[j].y) + (v0[j].z * v0[j].z + v0[j].w * v0[j].w); q1 += (v1[j].x * v1[j].x + v1[j].y * v1[j].y) + (v1[j].z * v1[j].z + v1[j].w * v1[j].w); }
        const float r0 = 1.0f / sqrtf(wave_sum(q0) * (1.f / DM) + EPS), r1 = 1.0f / sqrtf(wave_sum(q1) * (1.f / DM) + EPS);
        const float* mr0 = modl + (size_t)((m0 < MP) ? (m0 >> 11) : 32) * NMOD; const float* mr1 = modl + (size_t)((m1c < MP) ? (m1c >> 11) : 32) * NMOD;
        GAS unsigned long long* o0 = (GAS unsigned long long*)(H + (size_t)m0 * DM) + lane; GAS unsigned long long* o1 = (GAS unsigned long long*)(H + (size_t)m1c * DM) + lane;
#pragma unroll
        for (int j = 0; j < 4; ++j) { const int col = 4 * lane + 256 * j; const f32x4 g = *(const f32x4*)(gain + col);
            const f32x4 y0 = (v0[j] * r0) * g * (*(const f32x4*)(mr0 + sc_off + col) + 1.0f) + *(const f32x4*)(mr0 + sh_off + col);
            o0[64 * j] = (unsigned long long)pk2(y0.x, y0.y) | ((unsigned long long)pk2(y0.z, y0.w) << 32);
            if (has1) { const f32x4 y1 = (v1[j] * r1) * g * (*(const f32x4*)(mr1 + sc_off + col) + 1.0f) + *(const f32x4*)(mr1 + sh_off + col);
                o1[64 * j] = (unsigned long long)pk2(y1.x, y1.y) | ((unsigned long long)pk2(y1.z, y1.w) << 32); } }
    }
}
__device__ __forceinline__ void qknorm_chunks(int gw, int NGW, int lane, bf16* buf, int nchunks, int row_width_log2, const float* gain, float qscale, bool rope, const float* ropetab) {
    const int d0 = 16 * (lane & 3);
    float g[16];
#pragma unroll
    for (int i = 0; i < 16; ++i) g[i] = gain[d0 + i] * qscale;
    for (int ci = gw; ci < nchunks; ci += NGW) {
        GAS v4u* p = (GAS v4u*)(buf + (size_t)ci * 1024 + 16 * lane);
        const v4u a = p[0], b = p[1];
        float x[16];
        x[0] = bf_lo(a.x); x[1] = bf_hi(a.x); x[2] = bf_lo(a.y); x[3] = bf_hi(a.y); x[4] = bf_lo(a.z); x[5] = bf_hi(a.z); x[6] = bf_lo(a.w); x[7] = bf_hi(a.w);
        x[8] = bf_lo(b.x); x[9] = bf_hi(b.x); x[10] = bf_lo(b.y); x[11] = bf_hi(b.y); x[12] = bf_lo(b.z); x[13] = bf_hi(b.z); x[14] = bf_lo(b.w); x[15] = bf_hi(b.w);
        float ss = 0.f;
#pragma unroll
        for (int i = 0; i < 16; ++i) ss += x[i] * x[i];
        ss += __shfl_xor(ss, 1); ss += __shfl_xor(ss, 2);
        const float r = 1.0f / sqrtf(ss * (1.f / 64.f) + EPS);
#pragma unroll
        for (int i = 0; i < 16; ++i) x[i] = x[i] * r * g[i];
        if (rope) {
            const int m = (int)((((size_t)ci * 1024 + 16 * lane)) >> row_width_log2);
            const int t = (m < MP) ? (m & (LP - 1)) : (m - MP);
            const int qd = lane & 3; const int pos = (qd < 2) ? (t >> 6) : (t & 63);
            const f32x4* tb = (const f32x4*)(ropetab + (size_t)(pos * 16 + 8 * (qd & 1)) * 2);
#pragma unroll
            for (int j = 0; j < 4; ++j) { const f32x4 cs = tb[j];
                const float a0 = x[4 * j], a1 = x[4 * j + 1], b0 = x[4 * j + 2], b1 = x[4 * j + 3];
                x[4 * j] = a0 * cs.x - a1 * cs.y; x[4 * j + 1] = a0 * cs.y + a1 * cs.x; x[4 * j + 2] = b0 * cs.z - b1 * cs.w; x[4 * j + 3] = b0 * cs.w + b1 * cs.z; }
        }
        v4u oa, ob;
        oa.x = pk2(x[0], x[1]); oa.y = pk2(x[2], x[3]); oa.z = pk2(x[4], x[5]); oa.w = pk2(x[6], x[7]);
        ob.x = pk2(x[8], x[9]); ob.y = pk2(x[10], x[11]); ob.z = pk2(x[12], x[13]); ob.w = pk2(x[14], x[15]);
        p[0] = oa; p[1] = ob;
    }
}
__device__ __forceinline__ void diff_combine(int gw, int NGW, int lane, const bf16* O0, bf16* O1, const float* subg, float lam) {
    const int d0 = 16 * (lane & 7);
    float g[16];
#pragma unroll
    for (int i = 0; i < 16; ++i) g[i] = subg[d0 + i] * (1.0f - LAMBDA_INIT1);
    for (int m = gw; m < MT; m += NGW) {
        const GAS v4u* p0 = (const GAS v4u*)(O0 + (size_t)m * 1024 + 16 * lane);
        GAS v4u* p1 = (GAS v4u*)(O1 + (size_t)m * 1024 + 16 * lane);
        const v4u a0 = p0[0], b0 = p0[1], a1 = p1[0], b1 = p1[1];
        float x[16];
#define DC(i, w0, w1) x[2 * (i)] = bf_lo(w0) - lam * bf_lo(w1); x[2 * (i) + 1] = bf_hi(w0) - lam * bf_hi(w1);
        DC(0, a0.x, a1.x) DC(1, a0.y, a1.y) DC(2, a0.z, a1.z) DC(3, a0.w, a1.w) DC(4, b0.x, b1.x) DC(5, b0.y, b1.y) DC(6, b0.z, b1.z) DC(7, b0.w, b1.w)
#undef DC
        float ss = 0.f;
#pragma unroll
        for (int i = 0; i < 16; ++i) ss += x[i] * x[i];
        ss += __shfl_xor(ss, 1); ss += __shfl_xor(ss, 2); ss += __shfl_xor(ss, 4);
        const float r = 1.0f / sqrtf(ss * (1.f / 128.f) + EPS);
#pragma unroll
        for (int i = 0; i < 16; ++i) x[i] = x[i] * r * g[i];
        v4u oa, ob;
        oa.x = pk2(x[0], x[1]); oa.y = pk2(x[2], x[3]); oa.z = pk2(x[4], x[5]); oa.w = pk2(x[6], x[7]);
        ob.x = pk2(x[8], x[9]); ob.y = pk2(x[10], x[11]); ob.z = pk2(x[12], x[13]); ob.w = pk2(x[14], x[15]);
        p1[0] = oa; p1[1] = ob;
    }
}

__global__ void __launch_bounds__(NWAVES * 64, 2) mega_fwd(Args args) {
    extern __shared__ __attribute__((aligned(16))) unsigned char lds[];
    cg::grid_group grid = cg::this_grid();
    LAS unsigned char* ldsl = (LAS unsigned char*)lds;
    const int tid = threadIdx.x, lane = tid & 63, wave = __builtin_amdgcn_readfirstlane(tid >> 6);
    const int G = gridDim.x, bx = blockIdx.x;
    const int vcu = (G % 8 == 0) ? (bx % 8) * (G / 8) + bx / 8 : bx;
    const int gw = vcu * NWAVES + wave, NGW = G * NWAVES;
    volatile LAS unsigned* bst = (volatile LAS unsigned*)(ldsl + 155584);
    if (tid < 16) bst[tid] = 0u;
    __syncthreads();
    const XcdBarrier xbar = xcd_barrier_post((unsigned*)(args.ws + WS_BAR), bst);
    typedef __attribute__((address_space(4))) const Args* cargs_t;
    const cargs_t ap0 = (cargs_t)__builtin_amdgcn_kernarg_segment_ptr();
#define AP() cargs_t ap = ap0; asm volatile("" : "+s"(ap))
#define WSP(T, off) ((T*)(ap->ws + (off)))
#define mod WSP(float, WS_MOD)
#define ropetab WSP(float, WS_ROPE)
#define Wqkv_a WSP(bf16, WS_WQKVA)
#define Wo_a WSP(bf16, WS_WOA)
#define Wqkv_b WSP(bf16, WS_WQKVB)
#define Wo_b WSP(bf16, WS_WOB)
#define Wgu WSP(bf16, WS_WGU)
#define Wd WSP(bf16, WS_WD)
#define H WSP(bf16, WS_H)
#define Qb WSP(bf16, WS_Q)
#define Kb WSP(bf16, WS_K)
#define Vb WSP(bf16, WS_V)
#define Ob WSP(bf16, WS_O)
#define ACT WSP(bf16, WS_ACT)
#define OC0 WSP(bf16, WS_OC0)
#define OC1 WSP(bf16, WS_OC1)
#define out (ap->out)
#define x_p (ap->in[0])
#define x_s (ap->in[1])
    {
        AP();
        LAS float* scr = (LAS float*)(ldsl + RING_OFF + wave * 16384);
        constexpr int I_QA = 16 * 48, I_OA = 16 * 32, I_QB = 16 * 96, I_OB = 16 * 32, I_GU = 16 * 176, I_D = 44 * 32;
        constexpr int NITEMS = I_QA + I_OA + I_QB + I_OB + 2 * I_GU + 2 * I_D;
        for (int it = gw; it < NITEMS; it += NGW) {
            int r = it;
            if (r < I_QA) { const int nb = r % 48, kb = r / 48; p0_transpose_item(ap->in[11], 1024, 1536, Wqkv_a, scr, 64 * kb, 32 * nb, 32 * nb, lane); continue; } r -= I_QA;
            if (r < I_OA) { const int nb = r % 32, kb = r / 32; p0_transpose_item(ap->in[12], 1024, 1024, Wo_a, scr, 64 * kb, 32 * nb, 32 * nb, lane); continue; } r -= I_OA;
            if (r < I_QB) { const int nb = r % 96, kb = r / 96; p0_transpose_item(ap->in[15], 1024, 3072, Wqkv_b, scr, 64 * kb, 32 * nb, 32 * nb, lane); continue; } r -= I_QB;
            if (r < I_OB) { const int nb = r % 32, kb = r / 32; p0_transpose_item(ap->in[16], 1024, 1024, Wo_b, scr, 64 * kb, 32 * nb, 32 * nb, lane); continue; } r -= I_OB;
            if (r < 2 * I_GU) { const int l = r / I_GU; r -= l * I_GU; const int nb = r % 176, kb = r / 176; const int n0 = 32 * nb;
                const int drow0 = (n0 < DFF) ? (n0 / 128) * 256 + (n0 % 128) : ((n0 - DFF) / 128) * 256 + 128 + ((n0 - DFF) % 128);
                p0_transpose_item(ap->in[8] + (size_t)l * 1024 * 5632, 1024, 5632, Wgu + (size_t)l * 5632 * 1024, scr, 64 * kb, n0, drow0, lane); continue; } r -= 2 * I_GU;
            { const int l = r / I_D; r -= l * I_D; const int nb = r % 32, kb = r / 32;
                p0_transpose_item(ap->in[9] + (size_t)l * DFF * 1024, DFF, 1024, Wd + (size_t)l * 1024 * DFF, scr, 64 * kb, 32 * nb, 32 * nb, lane); }
        }
        { const int gt = vcu * 512 + tid;
          if (gt < 4096) { const int pos = gt >> 4, f = gt & 15; const float inv = exp2f(-(float)f * (13.287712379549449f / 16.0f)); const float ang = (float)pos * inv;
              const float rev = ang * 0.15915494309189535f; ropetab[2 * gt] = __builtin_amdgcn_cosf(rev); ropetab[2 * gt + 1] = __builtin_amdgcn_sinf(rev); } }
        __syncthreads();
        LAS float* cact = (LAS float*)ldsl;
        for (int i = tid; i < NSEQ * 1024; i += 512) { const int s = i >> 10, k = i & 1023; const float c = (s < 32) ? ap->in[2][s * 1024 + k] : ap->in[3][k];
            cact[i] = c / (1.0f + __expf(-c)); }
        __syncthreads();
        { const int half = G / 2; const int l = (vcu >= half) ? 1 : 0;
          gemv33c(vcu - l * half, half > 0 ? half : 1, tid, cact, (LAS float*)(ldsl + 135168), ap->in[6] + (size_t)l * 1024 * NMOD, NMOD, mod + (size_t)l * NSEQ * NMOD, NMOD, ap->in[7] + l * NMOD); }
        { float* rss = WSP(float, WS_RSS); for (int i = vcu * 512 + tid; i < 3 * MT; i += G * 512) rss[i] = 0.f; }
        __syncthreads();
    }
    grid.sync();

    auto layer_body = [&](auto LC) __attribute__((always_inline)) {
        constexpr int layer = decltype(LC)::value;
        AP();
#define modl (mod + (size_t)layer * NSEQ * NMOD)
        if (layer == 0) {
            norm_rows(gw, NGW, lane, x_p, x_s, ap->in[4], modl, 0, 1024, H);
            LAS float* shv = (LAS float*)ldsl; float* bv = WSP(float, WS_BV);
#pragma unroll 1
            for (int which = 0; which < 3; ++which) {
                const float* shsrc = mod + (size_t)(which == 0 ? 0 : 1) * NSEQ * NMOD + (which == 1 ? 0 : 3072);
                for (int i = tid; i < NSEQ * 1024; i += 512) shv[i] = shsrc[(size_t)(i >> 10) * NMOD + (i & 1023)];
                __syncthreads();
                if (which == 0) gemv33c(vcu, G, tid, shv, (LAS float*)(ldsl + 135168), ap->in[8], 5632, bv + BV_GU0, 5632, nullptr);
                else if (which == 1) gemv33c(vcu, G, tid, shv, (LAS float*)(ldsl + 135168), ap->in[15], 3072, bv + BV_QKV1, 3072, nullptr);
                else gemv33c(vcu, G, tid, shv, (LAS float*)(ldsl + 135168), ap->in[8] + (size_t)1024 * 5632, 5632, bv + BV_GU1, 5632, nullptr);
                __syncthreads();
            }
            xcd_barrier(xbar);
        }
        if (layer == 0) {
            pg8::Gemm g{H, Wqkv_a, MT, 1536, 1024}; pg8::StaticOrder S; S.init(MT, 1536, G, bx);
            pg8::EpiSplit2<false, true> E{Qb, Kb, Vb, 1024, 256, 256, 4, 5, nullptr, nullptr, 0, ap->in[13], ap->in[14], QSCALE, ropetab, (LAS float*)(ldsl + 131072)};
            pg8::gemm_phase<pg8::EpiSplit2<false, true>, pg8::StaticOrder, true, PG8_SP2>(ldsl + RING_OFF, g, S, E);
        } else {
            pg8::Gemm g{H, Wqkv_b, MT, 3072, 1024}; pg8::StaticOrder S; S.init(MT, 3072, G, bx);
            pg8::EpiSplit2<true, false> E{Qb, Kb, Vb, 1024, 1024, 1024, 4, 8, WSP(float, WS_RSS) + MT, WSP(float, WS_BV) + BV_QKV1, 3072, ap->in[17], ap->in[18], QSCALE, ropetab, (LAS float*)(ldsl + 131072)};
            pg8::gemm_phase<pg8::EpiSplit2<true, false>, pg8::StaticOrder, true, PG8_SP2>(ldsl + RING_OFF, g, S, E);
        }
        xcd_barrier(xbar);
        if (layer == 0) {
            for (int idx = vcu; idx < 1024 + 4096; idx += G) {
                size_t tok0; int head, kvh, qb, NT;
                if (idx < 1024) { const int xcd = (idx >> 5) & 7, j = idx & 31, i = idx >> 8; kvh = xcd & 3; const int w = (((xcd >> 2) * 4 + i) << 5) + j; head = kvh * 4 + (w >> 6); qb = w & 63; tok0 = MP; NT = LS / 64; }
                else { const int id2 = idx - 1024; const int xcd = (id2 >> 5) & 7, j = id2 & 31, i = id2 >> 8; const int gq = xcd * 16 + i; kvh = gq & 3; head = kvh * 4 + (j >> 3); qb = j & 7; tok0 = (size_t)(gq >> 2) * LP; NT = LP / 64; }
                attn_body::attn_unit2<1, false, 0>((const attn_body::bf16*)(Qb + tok0 * 1024 + head * 64), 1024, (const attn_body::bf16*)(Kb + tok0 * 256 + kvh * 64), 256,
                    (const attn_body::bf16*)(Vb + tok0 * 256 + kvh * 64), 256, (attn_body::bf16*)(Ob + tok0 * 1024 + head * 64), 1024, qb * 256, NT, nullptr, (char*)lds + RING_OFF, 0.f, nullptr, 0.f); }
        } else {
            const float s1 = wave_sum(ap->in[19][lane] * ap->in[20][lane]), s2 = wave_sum(ap->in[21][lane] * ap->in[22][lane]);
            const float lam = expf(s1) - expf(s2) + LAMBDA_INIT1;
            for (int idx = vcu; idx < 512 + 2048; idx += G) {
                size_t tok0; int h, qb, NT;
                if (idx < 512) { const int xcd = (idx >> 5) & 7, j = idx & 31, i = idx >> 8; h = xcd; qb = (i << 5) + j; tok0 = MP; NT = LS / 64; }
                else { const int id2 = idx - 512; const int xcd = (id2 >> 5) & 7, j = id2 & 31, i = id2 >> 8; const int gq = ((xcd * 8 + i) << 2) + (j >> 3); h = gq & 7; qb = j & 7; tok0 = (size_t)(gq >> 3) * LP; NT = LP / 64; }
                attn_body::attn_unit2<2, true, 1>((const attn_body::bf16*)(Qb + tok0 * 1024 + (2 * h) * 64), 1024, (const attn_body::bf16*)(Kb + tok0 * 1024 + (2 * h) * 64), 1024,
                    (const attn_body::bf16*)(Vb + tok0 * 1024 + h * 128), 1024, (attn_body::bf16*)(Ob + tok0 * 1024 + h * 128), 1024, qb * 256, NT, ap->in[10] + h, (char*)lds + RING_OFF, lam, ap->in[23], 1.0f - LAMBDA_INIT1);
                attn_body::attn_unit2<2, true, 2>((const attn_body::bf16*)(Qb + tok0 * 1024 + (2 * h + 1) * 64), 1024, (const attn_body::bf16*)(Kb + tok0 * 1024 + (2 * h + 1) * 64), 1024,
                    (const attn_body::bf16*)(Vb + tok0 * 1024 + h * 128), 1024, (attn_body::bf16*)(Ob + tok0 * 1024 + h * 128), 1024, qb * 256, NT, ap->in[10] + h, (char*)lds + RING_OFF, lam, ap->in[23], 1.0f - LAMBDA_INIT1); }
        }
        xcd_barrier(xbar);
        {
            pg8::Gemm g{Ob, layer == 0 ? Wo_a : Wo_b, MT, 1024, 1024}; pg8::StaticOrder S; S.init(MT, 1024, G, bx);
            pg8::EpiResid2<true> E{layer == 0 ? x_p : out, layer == 0 ? (x_s - (size_t)MP * DM) : out, out, modl + 2048, ap->in[5] + layer * 1024, modl + 4096, H, WSP(float, WS_RSS) + (layer == 0 ? 0 : 2 * MT)};
            pg8::gemm_phase<pg8::EpiResid2<true>, pg8::StaticOrder, PG8_ALIGN, PG8_SP2>(ldsl + RING_OFF, g, S, E);
        }
        xcd_barrier(xbar);
        {
            pg8::Gemm g{H, Wgu + (size_t)layer * 5632 * 1024, MT, 5632, 1024}; pg8::StaticOrder S; S.init(MT, 5632, G, bx);
            pg8::EpiSwiGLU2 E{ACT, DFF, WSP(float, WS_RSS) + (layer == 0 ? 0 : 2 * MT), WSP(float, WS_BV) + (layer == 0 ? BV_GU0 : BV_GU1)};
            pg8::gemm_phase<pg8::EpiSwiGLU2, pg8::StaticOrder, PG8_ALIGN, PG8_SP2>(ldsl + RING_OFF, g, S, E);
        }
        xcd_barrier(xbar);
        {
            pg8::Gemm g{ACT, Wd + (size_t)layer * 1024 * DFF, MT, 1024, DFF}; pg8::StaticOrder S; S.init(MT, 1024, G, bx);
            if (layer == 0) {
                pg8::EpiResid2<true> E{out, out, out, modl + 5120, ap->in[4] + 1024, mod + (size_t)NSEQ * NMOD + 1024, H, WSP(float, WS_RSS) + MT};
                pg8::gemm_phase<pg8::EpiResid2<true>, pg8::StaticOrder, PG8_ALIGN, PG8_SP2>(ldsl + RING_OFF, g, S, E);
            } else {
                pg8::EpiResid2<false> E{out, out, out, modl + 5120, nullptr, nullptr, nullptr, nullptr};
                pg8::gemm_phase<pg8::EpiResid2<false>, pg8::StaticOrder, PG8_ALIGN, PG8_SP2>(ldsl + RING_OFF, g, S, E);
            }
        }
        if (layer == 0) xcd_barrier(xbar);
    };
    layer_body(std::integral_constant<int, 0>{});
    layer_body(std::integral_constant<int, 1>{});
}

#undef out
#undef H
#undef mod
#undef modl
#undef ACT
#undef Qb
#undef Kb
#undef Vb
#undef Ob
extern "C" void kernel_launch(void* const* d_in, const int* in_sizes, int n_in, void* d_out, int out_size, void* d_ws, size_t ws_size, hipStream_t stream) {
    static int grid = 0;
    if (grid == 0) {
        if (n_in != 24 || out_size != MT * DM || ws_size < WS_END) { fprintf(stderr, "kernel_launch: unexpected shapes (n_in %d, out %d, ws %zu)\n", n_in, out_size, ws_size); grid = -1; return; }
        int dev = 0, cus = 0, per_cu = 0;
        hipGetDevice(&dev); hipDeviceGetAttribute(&cus, hipDeviceAttributeMultiprocessorCount, dev);
        if (hipFuncSetAttribute((const void*)mega_fwd, hipFuncAttributeMaxDynamicSharedMemorySize, LDS_BYTES) != hipSuccess) { fprintf(stderr, "hipFuncSetAttribute failed\n"); grid = -1; return; }
        if (hipOccupancyMaxActiveBlocksPerMultiprocessor(&per_cu, (const void*)mega_fwd, NWAVES * 64, LDS_BYTES) != hipSuccess || per_cu < 1) per_cu = 1;
        (void)hipGetLastError();
        grid = cus;
        if (grid > 256) grid = 256;
    }
    if (grid < 0) return;
    if (hipMemsetAsync((char*)d_ws + WS_BAR, 0, BAR_BYTES, stream) != hipSuccess) { fprintf(stderr, "hipMemsetAsync of the barrier words failed\n"); return; }
    Args a{};
    for (int i = 0; i < 24; ++i) a.in[i] = (const float*)d_in[i];
    a.out = (float*)d_out; a.ws = (unsigned char*)d_ws;
    void* kargs[] = {&a};
    hipError_t e = hipLaunchCooperativeKernel((const void*)mega_fwd, dim3(grid), dim3(NWAVES * 64), kargs, LDS_BYTES, stream);
    if (e != hipSuccess) fprintf(stderr, "cooperative launch failed: %s (grid %d)\n", hipGetErrorString(e), grid);
}
```

```cpp
#include <hip/hip_runtime.h>
#include <hip/hip_cooperative_groups.h>
#include <hip/hip_bf16.h>
#include <cstdio>
#include <cstdint>
#include <cmath>
#include <type_traits>
namespace cg = cooperative_groups;
namespace pg8 {
#define PG8_LAS __attribute__((address_space(3)))
typedef unsigned short bf16_t;
typedef short bf16x8 __attribute__((ext_vector_type(8)));
typedef float f32x4 __attribute__((ext_vector_type(4)));
typedef unsigned u32x4 __attribute__((ext_vector_type(4)));
constexpr int BM = 256, BK = 64, HALF = 128, HTB = HALF * BK * 2  , STAGE_BYTES = 8 * HTB, NXCD = 8, WGM = 8;

__host__ __device__ __forceinline__ int lds_byte(int r, int c) { const int st = (r >> 4) * 2 + (c >> 5), rr = r & 15, cc = c & 31, ob = rr * 64 + cc * 2; return st * 1024 + (ob ^ (((ob >> 9) & 1) << 5)); }
__host__ __device__ __forceinline__ void stage_rc(int b, int& R, int& C) { const int st = b / 1024, sb = b % 1024, swz = sb ^ (((sb >> 9) & 1) << 5); R = (st >> 1) * 16 + swz / 64; C = (st & 1) * 32 + (swz % 64) / 2; }
__host__ __device__ __forceinline__ int perm32(int rho) { const int n = rho >> 4, i = rho & 15; return 8 * (i >> 2) + 4 * n + (i & 3); }

struct Unit { int pm, pn; };
struct Gemm { const bf16_t* A; const bf16_t* Bt; int M, N, K; };

struct StaticOrder {
    int nM, nN, nwg, G, c;
    __host__ __device__ void init(int M, int N, int G_, int c_) { nM = M / BM; nN = N / BM; nwg = nM * nN; G = G_; c = c_; }
    __host__ __device__ bool next(int i, Unit& u) const {
        const long L = (long)i * G + c; if (L >= nwg) return false;
        int wgid = (int)L; { const int q = nwg / NXCD, r = nwg % NXCD, xcd = wgid % NXCD, off = wgid / NXCD; wgid = (xcd < r ? xcd * (q + 1) : r * (q + 1) + (xcd - r) * q) + off; }
        const int nig = WGM * nN, gid = wgid / nig, fm = gid * WGM, gsz = (nM - fm) < WGM ? (nM - fm) : WGM;
        u.pm = fm + ((wgid % nig) % gsz); u.pn = (wgid % nig) / gsz; return true;
    }
    __device__ __forceinline__ void a_ready(const Unit&) const {}
    __device__ __forceinline__ void done(const Unit&) const {}
};

__device__ __forceinline__ unsigned cvt_pk_bf16(float lo, float hi) { unsigned r; asm volatile("v_cvt_pk_bf16_f32 %0, %1, %2" : "=v"(r) : "v"(lo), "v"(hi)); return r; }
typedef float f32x2 __attribute__((ext_vector_type(2)));
__device__ __forceinline__ float silu_mul(float g, float uu) { const float e = __builtin_amdgcn_exp2f(g * -1.4426950408889634f); return g * __builtin_amdgcn_rcpf(1.0f + e) * uu; }
constexpr float EPI_EPS = 1e-6f;
template <bool NEXT> struct EpiResid2 {
    static constexpr bool PERM = true, AFTER_DRAIN = false;
    const float* base_p; const float* base_s; float* out; const float* gate;
    const float* ngain; const float* nsc; bf16_t* Hn; float* rowss;
    __device__ __forceinline__ void prefetch(PG8_LAS unsigned char*, const Unit&, int, int) const {}
    __device__ __forceinline__ void operator()(const f32x4 (&acc)[2][2][4][2], const Unit& u, int wr, int wc, int fr, int fq, PG8_LAS unsigned char*) const {
        const int seq = (u.pm < 256) ? (u.pm >> 3) : 32;
        const float* base = (u.pm < 256) ? base_p : base_s;
        const int col0 = u.pn * BM + wc * 32 + 8 * fq;
        u32x4 dl[2][4][2];
        { f32x4 gv[2][2];
#pragma unroll
          for (int bj = 0; bj < 2; ++bj)
#pragma unroll
            for (int n = 0; n < 2; ++n) gv[bj][n] = *(const f32x4*)(gate + (size_t)seq * 6144 + col0 + bj * HALF + 4 * n);
#pragma unroll
          for (int ai = 0; ai < 2; ++ai)
#pragma unroll
            for (int m = 0; m < 4; ++m)
#pragma unroll
                for (int bj = 0; bj < 2; ++bj) { const f32x4 a = gv[bj][0] * acc[ai][bj][m][0], b = gv[bj][1] * acc[ai][bj][m][1];
                    dl[ai][m][bj].x = cvt_pk_bf16(a[0], a[1]); dl[ai][m][bj].y = cvt_pk_bf16(a[2], a[3]); dl[ai][m][bj].z = cvt_pk_bf16(b[0], b[1]); dl[ai][m][bj].w = cvt_pk_bf16(b[2], b[3]); } }
        f32x4 gm[2][2];
        if (NEXT) {
#pragma unroll
          for (int bj = 0; bj < 2; ++bj)
#pragma unroll
            for (int n = 0; n < 2; ++n) { const int c = col0 + bj * HALF + 4 * n; gm[bj][n] = *(const f32x4*)(ngain + c) * (*(const f32x4*)(nsc + (size_t)seq * 6144 + c) + 1.0f); } }
#define BFLO(w) __builtin_bit_cast(float, (w) << 16)
#define BFHI(w) __builtin_bit_cast(float, (w) & 0xffff0000u)
#pragma unroll
        for (int ai = 0; ai < 2; ++ai) {
            f32x4 bs[4][2][2];
#pragma unroll
            for (int m = 0; m < 4; ++m) { const size_t off = (size_t)(u.pm * BM + ai * HALF + wr * 64 + m * 16 + fr) * 1024 + col0;
#pragma unroll
                for (int bj = 0; bj < 2; ++bj) { bs[m][bj][0] = *(const f32x4*)(base + off + bj * HALF); bs[m][bj][1] = *(const f32x4*)(base + off + bj * HALF + 4); } }
#pragma unroll
            for (int m = 0; m < 4; ++m) { const int row = u.pm * BM + ai * HALF + wr * 64 + m * 16 + fr; const size_t off = (size_t)row * 1024 + col0; float ss = 0.f;
#pragma unroll
                for (int bj = 0; bj < 2; ++bj) { const u32x4 d = dl[ai][m][bj];
                    const f32x4 o0 = bs[m][bj][0] + (f32x4){BFLO(d.x), BFHI(d.x), BFLO(d.y), BFHI(d.y)}, o1 = bs[m][bj][1] + (f32x4){BFLO(d.z), BFHI(d.z), BFLO(d.w), BFHI(d.w)};
                    *(f32x4*)(out + off + bj * HALF) = o0; *(f32x4*)(out + off + bj * HALF + 4) = o1;
                    if (NEXT) { ss += (o0[0] * o0[0] + o0[1] * o0[1]) + (o0[2] * o0[2] + o0[3] * o0[3]) + (o1[0] * o1[0] + o1[1] * o1[1]) + (o1[2] * o1[2] + o1[3] * o1[3]);
                        const f32x4 h0 = o0 * gm[bj][0], h1 = o1 * gm[bj][1];
                        u32x4 w; w.x = cvt_pk_bf16(h0[0], h0[1]); w.y = cvt_pk_bf16(h0[2], h0[3]); w.z = cvt_pk_bf16(h1[0], h1[1]); w.w = cvt_pk_bf16(h1[2], h1[3]);
                        *(u32x4*)(Hn + off + bj * HALF) = w; } }
                if (NEXT) { ss += __shfl_xor(ss, 16); ss += __shfl_xor(ss, 32); if (fq == 0) __hip_atomic_fetch_add(rowss + row, ss, __ATOMIC_RELAXED, __HIP_MEMORY_SCOPE_AGENT); } }
            asm volatile("" ::: "memory"); }
#undef BFLO
#undef BFHI
    }
};
struct EpiSwiGLU2 {
    static constexpr bool PERM = true, AFTER_DRAIN = false;
    bf16_t* O; int ldc; const float* rowss; const float* bias;
    __device__ __forceinline__ void prefetch(PG8_LAS unsigned char* sp, const Unit& u, int wid, int lane) const {
        const int seq = (u.pm < 256) ? (u.pm >> 3) : 32;
        const float* src = (wid < 4) ? rowss + u.pm * BM + wid * 64 : bias + (size_t)seq * 5632 + u.pn * HALF + (wid < 6 ? (wid - 4) * 64 : 2816 + (wid - 6) * 64);
        __builtin_amdgcn_global_load_lds((const unsigned*)(src + lane), (PG8_LAS unsigned*)(sp + wid * 256), 4, 0, 0);
    }
    __device__ __forceinline__ void operator()(const f32x4 (&acc)[2][2][4][2], const Unit& u, int wr, int wc, int fr, int fq, PG8_LAS unsigned char* sp) const {
        const int row0 = u.pm * BM + wr * 64 + fr; const int col0 = u.pn * HALF + wc * 32 + 8 * fq;
        const PG8_LAS float* spf = (const PG8_LAS float*)sp;
        const f32x4 bg0 = *(const PG8_LAS f32x4*)(spf + 256 + wc * 32 + 8 * fq), bg1 = *(const PG8_LAS f32x4*)(spf + 256 + wc * 32 + 8 * fq + 4);
        const f32x4 bu0 = *(const PG8_LAS f32x4*)(spf + 384 + wc * 32 + 8 * fq), bu1 = *(const PG8_LAS f32x4*)(spf + 384 + wc * 32 + 8 * fq + 4);
#pragma unroll
        for (int ai = 0; ai < 2; ++ai)
#pragma unroll
            for (int m = 0; m < 4; ++m) { const int row = row0 + ai * HALF + m * 16; const float rr = 1.0f / sqrtf(spf[ai * HALF + wr * 64 + m * 16 + fr] * (1.0f / 1024.0f) + EPI_EPS);
                const f32x4 g0 = acc[ai][0][m][0] * rr + bg0, g1 = acc[ai][0][m][1] * rr + bg1, u0 = acc[ai][1][m][0] * rr + bu0, u1 = acc[ai][1][m][1] * rr + bu1;
                u32x4 w; w.x = cvt_pk_bf16(silu_mul(g0[0], u0[0]), silu_mul(g0[1], u0[1])); w.y = cvt_pk_bf16(silu_mul(g0[2], u0[2]), silu_mul(g0[3], u0[3]));
                w.z = cvt_pk_bf16(silu_mul(g1[0], u1[0]), silu_mul(g1[1], u1[1])); w.w = cvt_pk_bf16(silu_mul(g1[2], u1[2]), silu_mul(g1[3], u1[3]));
                *(u32x4*)(O + (size_t)row * ldc + col0) = w; }
    }
};
template <bool PRE, bool ROPE> struct EpiSplit2 {
    static constexpr bool PERM = true, AFTER_DRAIN = false;
    bf16_t* p0; bf16_t* p1; bf16_t* p2; int ld0, ld1, ld2, n0, n1;
    const float* rowss; const float* bias; int N;
    const float* qgain; const float* kgain; float qscale; const float* ropetab; PG8_LAS float* xch;
    __device__ __forceinline__ void prefetch(PG8_LAS unsigned char* sp, const Unit& u, int wid, int lane) const {
        if (PRE) { const int seq = (u.pm < 256) ? (u.pm >> 3) : 32;
            const float* src = (wid < 4) ? rowss + u.pm * BM + wid * 64 : bias + (size_t)seq * N + u.pn * BM + (wid - 4) * 64;
            __builtin_amdgcn_global_load_lds((const unsigned*)(src + lane), (PG8_LAS unsigned*)(sp + wid * 256), 4, 0, 0); }
    }
    __device__ __forceinline__ void operator()(f32x4 (&acc)[2][2][4][2], const Unit& u, int wr, int wc, int fr, int fq, PG8_LAS unsigned char* sp) const {
        bf16_t* base; int ldc, colt;
        if (u.pn < n0) { base = p0; ldc = ld0; colt = u.pn * BM; }
        else if (u.pn < n1) { base = p1; ldc = ld1; colt = (u.pn - n0) * BM; }
        else { base = p2; ldc = ld2; colt = (u.pn - n1) * BM; }
        const bool isv = (u.pn >= n1), isq = (u.pn < n0);
        const int wid = wr * 4 + wc;
        const int row0 = u.pm * BM + wr * 64 + fr; const int col0 = colt + wc * 32 + 8 * fq;
        if (PRE) { const PG8_LAS float* spf = (const PG8_LAS float*)sp; const PG8_LAS float* bp = spf + 256 + wc * 32 + 8 * fq;
            const f32x4 b00 = *(const PG8_LAS f32x4*)(bp), b01 = *(const PG8_LAS f32x4*)(bp + 4), b10 = *(const PG8_LAS f32x4*)(bp + HALF), b11 = *(const PG8_LAS f32x4*)(bp + HALF + 4);
#pragma unroll
            for (int ai = 0; ai < 2; ++ai)
#pragma unroll
                for (int m = 0; m < 4; ++m) { const float rr = 1.0f / sqrtf(spf[ai * HALF + wr * 64 + m * 16 + fr] * (1.0f / 1024.0f) + EPI_EPS);
                    acc[ai][0][m][0] = acc[ai][0][m][0] * rr + b00; acc[ai][0][m][1] = acc[ai][0][m][1] * rr + b01; acc[ai][1][m][0] = acc[ai][1][m][0] * rr + b10; acc[ai][1][m][1] = acc[ai][1][m][1] * rr + b11; } }
        float part[16];
        if (!isv) {
#pragma unroll
            for (int ai = 0; ai < 2; ++ai)
#pragma unroll
                for (int m = 0; m < 4; ++m)
#pragma unroll
                    for (int bj = 0; bj < 2; ++bj) { const f32x4 a = acc[ai][bj][m][0], b = acc[ai][bj][m][1];
                        float s = (a[0] * a[0] + a[1] * a[1]) + (a[2] * a[2] + a[3] * a[3]) + (b[0] * b[0] + b[1] * b[1]) + (b[2] * b[2] + b[3] * b[3]);
                        s += __shfl_xor(s, 16); s += __shfl_xor(s, 32); const int idx = (ai * 4 + m) * 2 + bj; part[idx] = s;
                        if (fq == 0) xch[wid * 256 + idx * 16 + fr] = s; }
        }
        asm volatile("s_waitcnt lgkmcnt(0)" ::: "memory"); __builtin_amdgcn_s_barrier(); asm volatile("" ::: "memory");
        if (!isv) {
            const float* gp = (isq ? qgain : kgain) + 32 * (wc & 1) + 8 * fq; const float gs = isq ? qscale : 1.0f;
            const f32x4 gl0 = *(const f32x4*)(gp) * gs, gl1 = *(const f32x4*)(gp + 4) * gs;
#pragma unroll
            for (int ai = 0; ai < 2; ++ai)
#pragma unroll
                for (int m = 0; m < 4; ++m) { const int row = row0 + ai * HALF + m * 16;
                    f32x4 cs0 = {1.f, 0.f, 1.f, 0.f}, cs1 = {1.f, 0.f, 1.f, 0.f};
                    if (ROPE) { const int t = (row < 65536) ? (row & 2047) : (row - 65536); const int pos = (wc & 1) ? (t & 63) : (t >> 6);
                        const float* tp = ropetab + (size_t)(pos * 16 + 4 * fq) * 2; cs0 = *(const f32x4*)(tp); cs1 = *(const f32x4*)(tp + 4); }
                    bf16_t* rowp = base + (size_t)row * ldc + col0;
#pragma unroll
                    for (int bj = 0; bj < 2; ++bj) { const int idx = (ai * 4 + m) * 2 + bj;
                        const float tot = part[idx] + xch[(wid ^ 1) * 256 + idx * 16 + fr]; const float rinv = 1.0f / sqrtf(tot * (1.0f / 64.0f) + EPI_EPS);
                        f32x4 v0 = acc[ai][bj][m][0] * rinv * gl0, v1 = acc[ai][bj][m][1] * rinv * gl1;
                        if (ROPE) { const f32x4 a = v0, b = v1;
                            v0[0] = a[0] * cs0[0] - a[1] * cs0[1]; v0[1] = a[0] * cs0[1] + a[1] * cs0[0]; v0[2] = a[2] * cs0[2] - a[3] * cs0[3]; v0[3] = a[2] * cs0[3] + a[3] * cs0[2];
                            v1[0] = b[0] * cs1[0] - b[1] * cs1[1]; v1[1] = b[0] * cs1[1] + b[1] * cs1[0]; v1[2] = b[2] * cs1[2] - b[3] * cs1[3]; v1[3] = b[2] * cs1[3] + b[3] * cs1[2]; }
                        u32x4 w; w.x = cvt_pk_bf16(v0[0], v0[1]); w.y = cvt_pk_bf16(v0[2], v0[3]); w.z = cvt_pk_bf16(v1[0], v1[1]); w.w = cvt_pk_bf16(v1[2], v1[3]);
                        *(u32x4*)(rowp + bj * HALF) = w; } }
        } else {
#pragma unroll
            for (int ai = 0; ai < 2; ++ai)
#pragma unroll
                for (int m = 0; m < 4; ++m) { bf16_t* rowp = base + (size_t)(row0 + ai * HALF + m * 16) * ldc + col0;
#pragma unroll
                    for (int bj = 0; bj < 2; ++bj) { const f32x4 v0 = acc[ai][bj][m][0], v1 = acc[ai][bj][m][1];
                        u32x4 w; w.x = cvt_pk_bf16(v0[0], v0[1]); w.y = cvt_pk_bf16(v0[2], v0[3]); w.z = cvt_pk_bf16(v1[0], v1[1]); w.w = cvt_pk_bf16(v1[2], v1[3]);
                        *(u32x4*)(rowp + bj * HALF) = w; } }
        }
    }
};
template <class Epi, class Sched, bool ALIGN_EPI = false, bool SP2 = false>
__device__ __forceinline__ void gemm_phase(PG8_LAS unsigned char* lds, const Gemm g, const Sched& S, const Epi& E) {
    int tid_ = threadIdx.x; asm volatile("" : "+v"(tid_));
    const int tid = tid_, wid = __builtin_amdgcn_readfirstlane(tid >> 6), lane = tid & 63, wr = wid >> 2, wc = wid & 3, fr = lane & 15, fq = lane >> 4;
    const int K = g.K, nt = K / BK;
    unsigned voffA[2], voffB[2];
#pragma unroll
    for (int i = 0; i < 2; ++i) { int R, C; stage_rc(tid * 16 + i * 8192, R, C); const int Rb = Epi::PERM ? ((R & ~31) + perm32(R & 31)) : R;
        voffA[i] = (unsigned)(R * K + C) * 2u; voffB[i] = (unsigned)(Rb * K + C) * 2u; }
    const size_t kstep = (size_t)(BK * 2);
    const size_t hstep = (size_t)HALF * K * 2;
    const size_t tstep = 2 * hstep;
    const unsigned ldsw = (unsigned)wid * 1024u;
    const int aoff = lds_byte(wr * 64 + fr, fq * 8), boff = lds_byte(wc * 32 + fr, fq * 8);
#define PG8_SA(b, h) (((b) * 2 + (h)) * HTB)
#define PG8_SB(b, h) ((4 + (b) * 2 + (h)) * HTB)
#define PG8_STAGE(bufoff, gbase, voff) do { _Pragma("unroll") for (int _i = 0; _i < 2; ++_i) \
        __builtin_amdgcn_global_load_lds((const unsigned*)((const char*)(gbase) + (voff)[_i]), (PG8_LAS unsigned*)(lds + (bufoff) + ldsw + _i * 8192), 16, 0, 0); } while (0)
#define PG8_LDA(dst, b, h) do { _Pragma("unroll") for (int m = 0; m < 4; ++m) _Pragma("unroll") for (int k = 0; k < 2; ++k) dst[m][k] = *(const PG8_LAS bf16x8*)(lds + PG8_SA(b, h) + aoff + m * 2048 + k * 1024); } while (0)
#define PG8_LDB(dst, b, h) do { _Pragma("unroll") for (int n = 0; n < 2; ++n) _Pragma("unroll") for (int k = 0; k < 2; ++k) dst[n][k] = *(const PG8_LAS bf16x8*)(lds + PG8_SB(b, h) + boff + n * 2048 + k * 1024); } while (0)
#define PG8_MMA(ai, bj, At, Bt) do { __builtin_amdgcn_s_setprio(1); _Pragma("unroll") for (int m = 0; m < 4; ++m) _Pragma("unroll") for (int n = 0; n < 2; ++n) _Pragma("unroll") for (int k = 0; k < 2; ++k) \
        acc[ai][bj][m][n] = __builtin_amdgcn_mfma_f32_16x16x32_bf16(Bt[n][k], At[m][k], acc[ai][bj][m][n], 0, 0, 0); __builtin_amdgcn_s_setprio(0); } while (0)
#define PG8_WAIT_V(n) asm volatile("s_waitcnt vmcnt(" #n ")" ::: "memory")
#define PG8_WAIT_L(n) asm volatile("s_waitcnt lgkmcnt(" #n ")" ::: "memory")
#define PG8_BAR __builtin_amdgcn_s_barrier()
#define PG8_SCHED __builtin_amdgcn_sched_barrier(0)
    Unit cur, nxt; int ui = 0;
    if (!S.next(0, cur)) return;
    f32x4 acc[2][2][4][2];
#pragma unroll
    for (int a = 0; a < 2; ++a)
#pragma unroll
        for (int b = 0; b < 2; ++b)
#pragma unroll
            for (int m = 0; m < 4; ++m)
#pragma unroll
                for (int n = 0; n < 2; ++n) acc[a][b][m][n] = (f32x4){0.f, 0.f, 0.f, 0.f};
    bf16x8 At[4][2], B0[2][2], B1[2][2];
    const char* cA = (const char*)g.A + (size_t)cur.pm * tstep; const char* cB = (const char*)g.Bt + (size_t)cur.pn * tstep;
    S.a_ready(cur);
    if constexpr (SP2) {
        PG8_STAGE(PG8_SB(0, 0), cB, voffB); PG8_STAGE(PG8_SB(0, 1), cB + hstep, voffB); PG8_STAGE(PG8_SA(0, 0), cA, voffA); PG8_STAGE(PG8_SA(0, 1), cA + hstep, voffA);
        if (wr == 1) PG8_BAR;
        PG8_WAIT_V(2); PG8_BAR;
        PG8_STAGE(PG8_SB(1, 0), cB + kstep, voffB); PG8_STAGE(PG8_SA(1, 0), cA + kstep, voffA); PG8_STAGE(PG8_SB(1, 1), cB + hstep + kstep, voffB);
        PG8_WAIT_V(6); PG8_BAR;
    } else {
        PG8_STAGE(PG8_SB(0, 0), cB, voffB); PG8_STAGE(PG8_SA(0, 0), cA, voffA); PG8_STAGE(PG8_SB(0, 1), cB + hstep, voffB); PG8_STAGE(PG8_SA(0, 1), cA + hstep, voffA);
        if (wr == 1) PG8_BAR;
        PG8_WAIT_V(4); PG8_BAR;
        PG8_STAGE(PG8_SB(1, 0), cB + kstep, voffB); PG8_STAGE(PG8_SA(1, 0), cA + kstep, voffA); PG8_STAGE(PG8_SB(1, 1), cB + hstep + kstep, voffB);
        PG8_WAIT_V(6); PG8_BAR;
    }
    for (;;) {
        const bool has_next = S.next(ui + 1, nxt);
        const char* nA = has_next ? (const char*)g.A + (size_t)nxt.pm * tstep : cA; const char* nB = has_next ? (const char*)g.Bt + (size_t)nxt.pn * tstep : cB;
        for (int t = 0; t < nt; t += 2) {
            const bool last = (t == nt - 2);
            const char* a1 = cA + (size_t)(t + 1) * kstep;
            const char* a2 = last ? nA : cA + (size_t)(t + 2) * kstep; const char* b2 = last ? nB : cB + (size_t)(t + 2) * kstep;
            const char* a3 = a2 + kstep; const char* b3 = b2 + kstep;
            if (last && has_next) S.a_ready(nxt);
            if (last) E.prefetch(lds + 139264, cur, wid, lane);
            if constexpr (SP2) {
            PG8_LDB(B0, 0, 0); PG8_LDB(B1, 0, 1); PG8_SCHED; PG8_LDA(At, 0, 0); PG8_STAGE(PG8_SA(1, 1), a1 + hstep, voffA);
            PG8_WAIT_V(8); PG8_WAIT_L(0); PG8_BAR; PG8_MMA(0, 0, At, B0); PG8_MMA(0, 1, At, B1); PG8_BAR; PG8_SCHED;
            PG8_LDA(At, 0, 1); PG8_STAGE(PG8_SB(0, 0), b2, voffB); PG8_STAGE(PG8_SB(0, 1), b2 + hstep, voffB); PG8_STAGE(PG8_SA(0, 0), a2, voffA);
            PG8_WAIT_V(8); PG8_WAIT_L(0); PG8_BAR; PG8_MMA(1, 0, At, B0); PG8_MMA(1, 1, At, B1); PG8_BAR; PG8_SCHED;
            PG8_LDB(B0, 1, 0); PG8_LDB(B1, 1, 1); PG8_SCHED; PG8_LDA(At, 1, 0); PG8_STAGE(PG8_SA(0, 1), a2 + hstep, voffA);
            PG8_WAIT_V(8); PG8_WAIT_L(0); PG8_BAR; PG8_MMA(0, 0, At, B0); PG8_MMA(0, 1, At, B1); PG8_BAR; PG8_SCHED;
            PG8_LDA(At, 1, 1); PG8_STAGE(PG8_SB(1, 0), b3, voffB); PG8_STAGE(PG8_SB(1, 1), b3 + hstep, voffB); PG8_STAGE(PG8_SA(1, 0), a3, voffA);
            PG8_WAIT_V(8); PG8_WAIT_L(0); PG8_BAR; PG8_MMA(1, 0, At, B0); PG8_MMA(1, 1, At, B1); PG8_BAR; PG8_SCHED;
            } else {
            PG8_LDB(B0, 0, 0); PG8_SCHED; PG8_LDA(At, 0, 0); PG8_STAGE(PG8_SA(1, 1), a1 + hstep, voffA);
            PG8_WAIT_L(8); PG8_BAR; PG8_WAIT_L(0); PG8_MMA(0, 0, At, B0); PG8_BAR; PG8_SCHED;
            PG8_LDB(B1, 0, 1); PG8_STAGE(PG8_SB(0, 0), b2, voffB);
            PG8_BAR; PG8_WAIT_L(0); PG8_MMA(0, 1, At, B1); PG8_BAR;
            PG8_LDA(At, 0, 1); PG8_STAGE(PG8_SA(0, 0), a2, voffA);
            PG8_BAR; PG8_WAIT_L(0); PG8_MMA(1, 0, At, B0); PG8_BAR; PG8_SCHED;
            PG8_STAGE(PG8_SB(0, 1), b2 + hstep, voffB);
            PG8_WAIT_V(6); PG8_BAR; PG8_MMA(1, 1, At, B1); PG8_BAR;
            PG8_LDB(B0, 1, 0); PG8_SCHED; PG8_LDA(At, 1, 0); PG8_STAGE(PG8_SA(0, 1), a2 + hstep, voffA);
            PG8_WAIT_L(8); PG8_BAR; PG8_WAIT_L(0); PG8_MMA(0, 0, At, B0); PG8_BAR; PG8_SCHED;
            PG8_LDB(B1, 1, 1); PG8_STAGE(PG8_SB(1, 0), b3, voffB);
            PG8_BAR; PG8_WAIT_L(0); PG8_MMA(0, 1, At, B1); PG8_BAR;
            PG8_LDA(At, 1, 1); PG8_STAGE(PG8_SA(1, 0), a3, voffA);
            PG8_BAR; PG8_WAIT_L(0); PG8_MMA(1, 0, At, B0); PG8_BAR; PG8_SCHED;
            PG8_STAGE(PG8_SB(1, 1), b3 + hstep, voffB);
            PG8_WAIT_V(6); PG8_BAR; PG8_MMA(1, 1, At, B1); PG8_BAR;
            }
        }
        if constexpr (ALIGN_EPI) { if (wr == 0) PG8_BAR; }
        if constexpr (!Epi::AFTER_DRAIN) { E(acc, cur, wr, wc, fr, fq, lds + 139264); S.done(cur); }
        if (!has_next) break;
#pragma unroll
        for (int a = 0; a < 2; ++a)
#pragma unroll
            for (int b = 0; b < 2; ++b)
#pragma unroll
                for (int m = 0; m < 4; ++m)
#pragma unroll
                    for (int n = 0; n < 2; ++n) acc[a][b][m][n] = (f32x4){0.f, 0.f, 0.f, 0.f};
        cur = nxt; cA = nA; cB = nB; ++ui;
        if constexpr (ALIGN_EPI) { if (wr == 1) PG8_BAR; }
    }
    PG8_WAIT_V(0);
    if constexpr (!ALIGN_EPI) { if (wr == 0) PG8_BAR; }
    PG8_BAR;
    if constexpr (Epi::AFTER_DRAIN) { E.fused(acc, cur, wr, wc, fr, fq, lds, wid, lane); S.done(cur); }
#undef PG8_SA
#undef PG8_SB
#undef PG8_STAGE
#undef PG8_LDA
#undef PG8_LDB
#undef PG8_MMA
#undef PG8_WAIT_V
#undef PG8_WAIT_L
#undef PG8_BAR
#undef PG8_SCHED
}
}
#ifndef PG8_SP2
#define PG8_SP2 true
#endif
#ifndef PG8_ALIGN
#define PG8_ALIGN true
#endif
#include <hip/hip_bf16.h>
#include <cmath>
namespace attn_body {
using bf16=__hip_bfloat16;
using bf16x8=__attribute__((ext_vector_type(8)))short;
using s16x4=__attribute__((ext_vector_type(4)))short;
using f32x16=__attribute__((ext_vector_type(16)))float;
using u32x4=__attribute__((ext_vector_type(4)))unsigned;
constexpr int D=64;
constexpr int NW=8,QBLK=32,QB=QBLK*NW,KVBLK=64;
constexpr int ATTN_UNIT_ROWS=QB;
__device__ __forceinline__ int crow(int r,int hi){return (r&3)+8*(r>>2)+4*hi;}
#define SBAR() __builtin_amdgcn_sched_barrier(0)
constexpr int NSLOT=3, SLOTB=8192;
constexpr int LDS_K=0, LDS_V=NSLOT*SLOTB, LDS_WS=2*NSLOT*SLOTB, LDS_OST=LDS_WS+NW*64*4, LDS_BT=LDS_OST+NW*4096, LDS_BYTES=LDS_BT+768*4;
constexpr float C2=0.125f*1.4426950408889634f;
__device__ __forceinline__ void glds16(const void*gsrc,unsigned lds_dst){unsigned keep;
  asm volatile("s_mov_b32 %0, m0\n\ts_mov_b32 m0, %2\n\ts_nop 0\n\tglobal_load_lds_dwordx4 %1, off\n\ts_mov_b32 m0, %0":"=&s"(keep):"v"(gsrc),"s"(lds_dst):"memory");}
__device__ __forceinline__ void glds16s(const void*sbase,unsigned voff,unsigned lds_dst){unsigned keep;
  asm volatile("s_mov_b32 %0, m0\n\ts_mov_b32 m0, %3\n\ts_nop 0\n\tglobal_load_lds_dwordx4 %1, %2\n\ts_mov_b32 m0, %0":"=&s"(keep):"v"(voff),"s"(sbase),"s"(lds_dst):"memory");}
__device__ __forceinline__ float max3f(float a,float b,float c){float r;asm("v_max3_f32 %0, %1, %2, %3":"=v"(r):"v"(a),"v"(b),"v"(c));return r;}
__device__ __forceinline__ float max2f(float a,float b){float r;asm("v_max_f32_e32 %0, %1, %2":"=v"(r):"v"(a),"v"(b));return r;}
__device__ __forceinline__ float fadd_s(float a,float b){float r;asm("v_add_f32_e32 %0, %1, %2":"=v"(r):"v"(a),"v"(b));return r;}
__device__ __forceinline__ float fsub_s(float a,float b){float r;asm("v_sub_f32_e32 %0, %1, %2":"=v"(r):"v"(a),"v"(b));return r;}
typedef float f32x2_t __attribute__((ext_vector_type(2))); typedef __bf16 bf16x2_t __attribute__((ext_vector_type(2)));
__device__ __forceinline__ unsigned cvtpk_s(float lo,float hi){f32x2_t v={lo,hi};bf16x2_t b=__builtin_convertvector(v,bf16x2_t);return __builtin_bit_cast(unsigned,b);}
#define WAIT_BAR(N) asm volatile("s_waitcnt vmcnt(" #N ") lgkmcnt(0)\n\ts_barrier":::"memory")

__device__ __forceinline__ void qkt(f32x16&p0,f32x16&p1,const char*Kslot,const bf16x8*qr,const f32x16&negm,int r32,int hi){
  const char*kb=Kslot+hi*1024+r32*16;
  #pragma unroll
  for(int d0=0;d0<4;++d0){
    const bf16x8 b0=*reinterpret_cast<const bf16x8*>(kb+d0*2048);
    const bf16x8 b1=*reinterpret_cast<const bf16x8*>(kb+d0*2048+512);
    if(d0==0){p0=__builtin_amdgcn_mfma_f32_32x32x16_bf16(b0,qr[0],negm,0,0,0);p1=__builtin_amdgcn_mfma_f32_32x32x16_bf16(b1,qr[0],negm,0,0,0);}
    else{p0=__builtin_amdgcn_mfma_f32_32x32x16_bf16(b0,qr[d0],p0,0,0,0);p1=__builtin_amdgcn_mfma_f32_32x32x16_bf16(b1,qr[d0],p1,0,0,0);}}
}
typedef __attribute__((address_space(3))) const char* lds_cptr;
typedef short v4i16_t __attribute__((ext_vector_type(4)));
__device__ __forceinline__ void kload8(bf16x8*kf,lds_cptr kp){
  kf[0]=*(const __attribute__((address_space(3))) bf16x8*)(kp);      kf[1]=*(const __attribute__((address_space(3))) bf16x8*)(kp+512);
  kf[2]=*(const __attribute__((address_space(3))) bf16x8*)(kp+2048); kf[3]=*(const __attribute__((address_space(3))) bf16x8*)(kp+2560);
  kf[4]=*(const __attribute__((address_space(3))) bf16x8*)(kp+4096); kf[5]=*(const __attribute__((address_space(3))) bf16x8*)(kp+4608);
  kf[6]=*(const __attribute__((address_space(3))) bf16x8*)(kp+6144); kf[7]=*(const __attribute__((address_space(3))) bf16x8*)(kp+6656);
}
__device__ __forceinline__ void kload2(bf16x8*kf,lds_cptr kp,int j){ kf[2*j]=*(const __attribute__((address_space(3))) bf16x8*)(kp+j*2048); kf[2*j+1]=*(const __attribute__((address_space(3))) bf16x8*)(kp+j*2048+512); }
__device__ __forceinline__ s16x4 vtr(lds_cptr p){ return __builtin_bit_cast(s16x4,__builtin_amdgcn_ds_read_tr16_b64_v4i16((__attribute__((address_space(3))) v4i16_t*)p)); }
__device__ __forceinline__ float rowmax(const f32x16&p0,const f32x16&p1){
  float a=max3f(p0[0],p0[1],p1[0]),b=max3f(p0[2],p0[3],p1[1]);a=max3f(a,p1[2],p1[3]);
  #pragma unroll
  for(int r=4;r<16;r+=4){a=max3f(a,p0[r],p0[r+1]);b=max3f(b,p0[r+2],p0[r+3]);a=max3f(a,p1[r],p1[r+1]);b=max3f(b,p1[r+2],p1[r+3]);}
  const float m=max2f(a,b);
  auto rr=__builtin_amdgcn_permlane32_swap(__float_as_uint(m),__float_as_uint(m),false,false);
  return max2f(__uint_as_float(rr[0]),__uint_as_float(rr[1]));
}
__device__ __forceinline__ void pv(f32x16*o,int vb,bf16x8 pa0,bf16x8 pa1,bf16x8 pa2,bf16x8 pa3){
  #pragma unroll
  for(int d0=0;d0<2;++d0){s16x4 lo[4],hi[4];
    #pragma unroll
    for(int ks=0;ks<4;++ks){
      asm volatile("ds_read_b64_tr_b16 %0,%1 offset:%c2":"=&v"(lo[ks]):"v"(vb),"i"(d0*4096+ks*1024):"memory");
      asm volatile("ds_read_b64_tr_b16 %0,%1 offset:%c2":"=&v"(hi[ks]):"v"(vb),"i"(d0*4096+ks*1024+512):"memory");}
    asm volatile("s_waitcnt lgkmcnt(0)":::"memory");SBAR();
    #define PK(k) (bf16x8){lo[k][0],lo[k][1],lo[k][2],lo[k][3],hi[k][0],hi[k][1],hi[k][2],hi[k][3]}
    o[d0]=__builtin_amdgcn_mfma_f32_32x32x16_bf16(pa0,PK(0),o[d0],0,0,0);
    o[d0]=__builtin_amdgcn_mfma_f32_32x32x16_bf16(pa1,PK(1),o[d0],0,0,0);
    o[d0]=__builtin_amdgcn_mfma_f32_32x32x16_bf16(pa2,PK(2),o[d0],0,0,0);
    o[d0]=__builtin_amdgcn_mfma_f32_32x32x16_bf16(pa3,PK(3),o[d0],0,0,0);
    #undef PK
  }
}

#ifndef ATTN_STORE16
#define ATTN_STORE16(p,v) (*(u32x4*)(p)=(v))
#endif
template<int VH> struct AttnLds { static constexpr int KSL=8192, VSL=8192*VH, L_K=0, L_V=4*KSL, L_WS=L_V+3*VSL, L_BT=L_WS+NW*64*4, BYTES=L_BT+768*4; };
template<int VH,bool HAS_BIAS,int MODE> __device__ __forceinline__ void attn_unit2(const bf16*Qb,int qp,const bf16*__restrict__ Kb,int kp,const bf16*__restrict__ Vb,int vp,bf16*Ob,int op,int q0,int NT,const float*relb,char*shm,float lam,const float*subg,float gmul){
  typedef AttnLds<VH> LM; constexpr int KSL=LM::KSL, VSL=LM::VSL;
  int tid_=threadIdx.x; asm volatile("":"+v"(tid_));
  const int tid=tid_,lane=tid&63,r32=lane&31,hi=lane>>5; const int wid=__builtin_amdgcn_readfirstlane(tid>>6);
  const bf16*Qw=Qb+(long)(q0+wid*QBLK)*qp;
  const unsigned lds0=(unsigned)(uintptr_t)shm;
  const lds_cptr shm3=(lds_cptr)shm;
  float*wsf=(float*)(shm+LM::L_WS)+wid*64;
  const unsigned ksrc=(unsigned)(lane*kp+wid*8)*2u;
  const unsigned vsrc=(unsigned)((16*(wid&3)+(lane>>2))*vp+(wid>>2)*32+(lane&3)*8)*2u;
  const unsigned kdst=lds0+LM::L_K+wid*1024, vdst=lds0+LM::L_V+wid*1024;
  #define DMA_K(t,slot) glds16s(Kb+(long)(t)*KVBLK*kp,ksrc,(unsigned)__builtin_amdgcn_readfirstlane(kdst+(slot)))
  #define DMA_V(t,slot) do{ glds16s(Vb+(long)(t)*KVBLK*vp,vsrc,(unsigned)__builtin_amdgcn_readfirstlane(vdst+(slot))); \
      if(VH==2) glds16s(Vb+(long)(t)*KVBLK*vp+64,vsrc,(unsigned)__builtin_amdgcn_readfirstlane(vdst+(slot)+8192)); }while(0)
  const int vb0=(int)(lds0+LM::L_V)+((lane>>4)&1)*32+(lane&3)*8+(4*hi+((lane&15)>>2))*64;
  const lds_cptr kp0=shm3+LM::L_K+hi*1024+r32*16;
  const lds_cptr vp0=shm3+LM::L_V+((lane>>4)&1)*32+(lane&3)*8+(4*hi+((lane&15)>>2))*64;
  const int qw_=q0+32*wid; const int tn0=HAS_BIAS?(qw_>=90?((qw_-90)>>6):0):0, tn1=HAS_BIAS?(((qw_+185)>>6)<NT?((qw_+185)>>6):NT):0;
  float cb=0.f,ca=0.f;
  typedef __attribute__((address_space(3))) float lds_f32;
  typedef __attribute__((address_space(3))) char* lds_ptr_;
  lds_f32* btab=(lds_f32*)((lds_ptr_)shm)+LM::L_BT/4;
  if(HAS_BIAS){ const float L2E=1.4426950408889634f; cb=L2E*relb[15*8]; ca=L2E*relb[31*8];
    for(int i=tid;i<768;i+=512){ const int rel=i-384; const int n=rel<0?-rel:rel; int bk=n<8?n:(8+(31-__builtin_clz((unsigned)(n*n)))-6); if(n>=8&&bk>15)bk=15; if(rel>0)bk+=16; btab[i]=L2E*relb[bk*8]; } }
  const int lanebias=-q0-32*wid-r32+4*hi+384;
  #define CREG(tt) (HAS_BIAS?(((tt)<tn0)?cb:(((tt)<tn1)?0.f:ca)):0.f)
  #define BIASADD(P0,P1,t) do{ if(HAS_BIAS&&(t)>=tn0&&(t)<tn1){ const lds_f32*bp_=btab+(64*(t)+lanebias); \
    _Pragma("unroll") for(int r=0;r<16;++r){ P0[r]+=bp_[(r&3)+8*(r>>2)]; P1[r]+=bp_[(r&3)+8*(r>>2)+32]; } } }while(0)
  #define RSCALE(t) do{ if(HAS_BIAS&&((t)==tn0||(t)==tn1)){ const float f_=__builtin_amdgcn_exp2f(CREG((t)-1)-CREG(t)); l_reg*=f_; \
    _Pragma("unroll") for(int d_=0;d_<2*VH;++d_) _Pragma("unroll") for(int r=0;r<16;++r)o[d_][r]*=f_; } }while(0)
  DMA_K(0,0);DMA_V(0,0);DMA_K(1,KSL);
  bf16x8 qr[4];
  #pragma unroll
  for(int d0=0;d0<4;++d0)qr[d0]=*reinterpret_cast<const bf16x8*>(&Qw[(long)r32*qp+d0*16+hi*8]);
  DMA_K(2,2*KSL);
  float l_reg=0.f;f32x16 o[2*VH];
  #pragma unroll
  for(int d_=0;d_<2*VH;++d_)o[d_]=f32x16{};
  const f32x16 zero16=f32x16{};
  f32x16 pA0,pA1,pB0,pB1; bf16x8 kf[4];
  int sv_prev=0,sv_cur=0,sv_next=VSL;
  #define ROT() do{sv_prev=sv_cur;sv_cur=sv_next;sv_next=(sv_next==2*VSL)?0:sv_next+VSL;}while(0)
  #define KLD(p) (*(const __attribute__((address_space(3))) bf16x8*)(p))
  #define KPRE(tn) do{ const lds_cptr kn_=kp0+(((tn)&3)*KSL); kf[0]=KLD(kn_); kf[1]=KLD(kn_+512); kf[2]=KLD(kn_+2048); kf[3]=KLD(kn_+2560); }while(0)
  if(VH==1){WAIT_BAR(3);}else{WAIT_BAR(4);}
  qkt(pA0,pA1,shm+LM::L_K,qr,zero16,r32,hi);
  BIASADD(pA0,pA1,0);
  _Pragma("unroll") for(int r=0;r<16;++r){pA0[r]=__builtin_amdgcn_exp2f(pA0[r]);pA1[r]=__builtin_amdgcn_exp2f(pA1[r]);}
  WAIT_BAR(0);
  DMA_K(3,3*KSL);DMA_V(1,VSL);
  ROT();
  KPRE(1);
  s16x4 vlo[8],vhi[8]; u32x4 pw0,pw1,pw2,pw3;
  #define PKW(P,B) cvtpk_s(P[B],P[B+1])
  #define PAF(k) __builtin_bit_cast(bf16x8,pw##k)
  #define VFR(i) (bf16x8){vlo[i][0],vlo[i][1],vlo[i][2],vlo[i][3],vhi[i][0],vhi[i][1],vhi[i][2],vhi[i][3]}
  #define PIN(x) asm volatile("":"+v"(x))
  #define MF(a,b,c) __builtin_amdgcn_mfma_f32_32x32x16_bf16(a,b,c,0,0,0)
  #define GAPA(MFX,A0,A1,A2,A3,W0,W1,PW) do{ MFX; sacc+=A0; sacc+=A1; sacc+=A2; sacc+=A3; PIN(sacc); W0; W1; PIN(PW); SBAR(); }while(0)
  #define EX(v) __builtin_amdgcn_exp2f(v)
  #define GAPB4(MFX,X,B) do{ MFX; X[B]=EX(X[B]); X[B+1]=EX(X[B+1]); X[B+2]=EX(X[B+2]); X[B+3]=EX(X[B+3]); PIN(X); SBAR(); }while(0)
  #define GAPB2(MFX,X,B) do{ MFX; X[B]=EX(X[B]); X[B+1]=EX(X[B+1]); PIN(X); SBAR(); }while(0)
  #define VRD(i,hv) do{ vlo[i]=vtr(vp_+((hv)*8192+((i)>>2)*4096+((i)&3)*1024)); vhi[i]=vtr(vp_+((hv)*8192+((i)>>2)*4096+((i)&3)*1024+512)); }while(0)
  #define STEP(C0,C1,P0,P1,t,GK,GV,GL) do{ SBAR(); \
    const lds_cptr vp_=vp0+sv_prev; const lds_cptr kq_=kp0+(((t)&3)*KSL); \
    VRD(0,0); SBAR(); float sacc=(P0[0]+P0[1]); \
    GAPA(C0=MF(kf[0],qr[0],zero16), P0[2],P0[3],P0[4],P0[5],     pw0[0]=PKW(P0,0), pw0[1]=PKW(P0,2), pw0); \
    VRD(4,0); SBAR(); GAPA(C1=MF(kf[1],qr[0],zero16), P0[6],P0[7],P0[8],P0[9],     pw0[2]=PKW(P0,4), pw0[3]=PKW(P0,6), pw0); \
    kf[0]=KLD(kq_+4096); kf[1]=KLD(kq_+4608); SBAR(); \
    VRD(1,0); SBAR(); GAPA(C0=MF(kf[2],qr[1],C0),   P0[10],P0[11],P0[12],P0[13], pw1[0]=PKW(P0,8), pw1[1]=PKW(P0,10), pw1); \
    VRD(5,0); SBAR(); GAPA(C1=MF(kf[3],qr[1],C1),   P0[14],P0[15],P1[0],P1[1],   pw1[2]=PKW(P0,12),pw1[3]=PKW(P0,14), pw1); \
    kf[2]=KLD(kq_+6144); kf[3]=KLD(kq_+6656); SBAR(); \
    VRD(2,0); SBAR(); GAPA(C0=MF(kf[0],qr[2],C0),   P1[2],P1[3],P1[4],P1[5],     pw2[0]=PKW(P1,0), pw2[1]=PKW(P1,2), pw2); \
    VRD(6,0); SBAR(); GAPA(C1=MF(kf[1],qr[2],C1),   P1[6],P1[7],P1[8],P1[9],     pw2[2]=PKW(P1,4), pw2[3]=PKW(P1,6), pw2); \
    VRD(3,0); SBAR(); GAPA(C0=MF(kf[2],qr[3],C0),   P1[10],P1[11],P1[12],P1[13], pw3[0]=PKW(P1,8), pw3[1]=PKW(P1,10), pw3); \
    VRD(7,0); SBAR(); GAPA(C1=MF(kf[3],qr[3],C1),   P1[14],P1[15],0.f,0.f,       pw3[2]=PKW(P1,12),pw3[3]=PKW(P1,14), pw3); \
    l_reg+=sacc; \
    if(GK){DMA_K((t)+3,(((t)+3)&3)*KSL);} if(GV){DMA_V((t)+1,sv_next);} \
    BIASADD(C0,C1,t); SBAR(); \
    if(VH==1){ \
      GAPB4(o[0]=MF(PAF(0),VFR(0),o[0]), C0,0); \
      GAPB4(o[1]=MF(PAF(0),VFR(4),o[1]), C0,4); \
      GAPB4(o[0]=MF(PAF(1),VFR(1),o[0]), C0,8); \
      GAPB4(o[1]=MF(PAF(1),VFR(5),o[1]), C0,12); \
      if(GL){ KPRE((t)+1); SBAR(); } \
      GAPB4(o[0]=MF(PAF(2),VFR(2),o[0]), C1,0); \
      GAPB4(o[1]=MF(PAF(2),VFR(6),o[1]), C1,4); \
      GAPB4(o[0]=MF(PAF(3),VFR(3),o[0]), C1,8); \
      GAPB4(o[1]=MF(PAF(3),VFR(7),o[1]), C1,12); \
    } else { \
      GAPB2(o[0]=MF(PAF(0),VFR(0),o[0]), C0,0);  VRD(0,1); SBAR(); \
      GAPB2(o[1]=MF(PAF(0),VFR(4),o[1]), C0,2);  VRD(4,1); SBAR(); \
      GAPB2(o[0]=MF(PAF(1),VFR(1),o[0]), C0,4);  VRD(1,1); SBAR(); \
      GAPB2(o[1]=MF(PAF(1),VFR(5),o[1]), C0,6);  VRD(5,1); SBAR(); \
      GAPB2(o[0]=MF(PAF(2),VFR(2),o[0]), C0,8);  VRD(2,1); SBAR(); \
      GAPB2(o[1]=MF(PAF(2),VFR(6),o[1]), C0,10); VRD(6,1); SBAR(); \
      GAPB2(o[0]=MF(PAF(3),VFR(3),o[0]), C0,12); VRD(3,1); SBAR(); \
      GAPB2(o[1]=MF(PAF(3),VFR(7),o[1]), C0,14); VRD(7,1); SBAR(); \
      if(GL){ KPRE((t)+1); SBAR(); } \
      GAPB2(o[2*(VH-1)]=MF(PAF(0),VFR(0),o[2*(VH-1)]), C1,0); \
      GAPB2(o[2*(VH-1)+1]=MF(PAF(0),VFR(4),o[2*(VH-1)+1]), C1,2); \
      GAPB2(o[2*(VH-1)]=MF(PAF(1),VFR(1),o[2*(VH-1)]), C1,4); \
      GAPB2(o[2*(VH-1)+1]=MF(PAF(1),VFR(5),o[2*(VH-1)+1]), C1,6); \
      GAPB2(o[2*(VH-1)]=MF(PAF(2),VFR(2),o[2*(VH-1)]), C1,8); \
      GAPB2(o[2*(VH-1)+1]=MF(PAF(2),VFR(6),o[2*(VH-1)+1]), C1,10); \
      GAPB2(o[2*(VH-1)]=MF(PAF(3),VFR(3),o[2*(VH-1)]), C1,12); \
      GAPB2(o[2*(VH-1)+1]=MF(PAF(3),VFR(7),o[2*(VH-1)+1]), C1,14); \
    } \
    }while(0)
  #define WAITFULL() do{ if(VH==1){WAIT_BAR(2);}else{WAIT_BAR(3);} }while(0)
  #define ENDW(tt) do{ if((tt)+3<NT){WAITFULL();} else if((tt)+2<NT){ if(VH==1){WAIT_BAR(1);}else{WAIT_BAR(2);} } else {WAIT_BAR(0);} }while(0)
  int t=1;
  for(;t+5<NT;t+=2){
    STEP(pB0,pB1,pA0,pA1,t,true,true,true);     WAITFULL(); RSCALE(t);   ROT();
    STEP(pA0,pA1,pB0,pB1,t+1,true,true,true);   WAITFULL(); RSCALE(t+1); ROT();
  }
  for(;t+1<NT;t+=2){
    STEP(pB0,pB1,pA0,pA1,t,(t+3<NT),(t+1<NT),(t+1<NT));       ENDW(t);   RSCALE(t);   ROT();
    STEP(pA0,pA1,pB0,pB1,t+1,(t+4<NT),(t+2<NT),(t+2<NT));     ENDW(t+1); RSCALE(t+1); ROT();
  }
  STEP(pB0,pB1,pA0,pA1,NT-1,false,false,false); RSCALE(NT-1);
  { float sacc=pB0[0]+pB0[1]; _Pragma("unroll") for(int r=2;r<16;++r)sacc+=pB0[r]; _Pragma("unroll") for(int r=0;r<16;++r)sacc+=pB1[r]; l_reg+=sacc;
    pw0=(u32x4){PKW(pB0,0),PKW(pB0,2),PKW(pB0,4),PKW(pB0,6)};pw1=(u32x4){PKW(pB0,8),PKW(pB0,10),PKW(pB0,12),PKW(pB0,14)};pw2=(u32x4){PKW(pB1,0),PKW(pB1,2),PKW(pB1,4),PKW(pB1,6)};pw3=(u32x4){PKW(pB1,8),PKW(pB1,10),PKW(pB1,12),PKW(pB1,14)};
    SBAR(); pv(o,vb0+sv_cur,PAF(0),PAF(1),PAF(2),PAF(3)); if(VH==2){ SBAR(); pv(o+2*(VH-1),vb0+sv_cur+8192,PAF(0),PAF(1),PAF(2),PAF(3)); } }
  #undef PKW
  #undef PAF
  #undef VFR
  #undef PIN
  #undef MF
  #undef GAPA
  #undef GAPB4
  #undef GAPB2
  #undef EX
  #undef VRD
  #undef STEP
  #undef ENDW
  #undef WAITFULL
  #undef KLD
  #undef KPRE
  {auto rr=__builtin_amdgcn_permlane32_swap(__float_as_uint(l_reg),__float_as_uint(l_reg),false,false);l_reg=__uint_as_float(rr[0])+__uint_as_float(rr[1]);}
  if(hi==0)wsf[32+r32]=l_reg;
  asm volatile("s_waitcnt lgkmcnt(0)\n\ts_barrier":::"memory");
  float rli[16];
  #pragma unroll
  for(int r=0;r<16;++r)rli[r]=__builtin_amdgcn_rcpf(wsf[32+crow(r,hi)]);
  bf16*Ow=Ob+(long)(q0+wid*QBLK)*op;
  typedef __attribute__((address_space(3))) unsigned lds_u32;
  lds_u32* park=(lds_u32*)((lds_ptr_)shm+LM::BYTES)+tid;
  if(MODE==1){
    #pragma unroll
    for(int d0=0;d0<2*VH;++d0)
      #pragma unroll
      for(int r=0;r<16;r+=2)park[(d0*8+(r>>1))*512]=cvtpk_s(o[d0][r]*rli[r],o[d0][r+1]*rli[r+1]);
  } else {
    if(MODE==2){
      #pragma unroll
      for(int d0=0;d0<2*VH;++d0)
        #pragma unroll
        for(int r=0;r<16;r+=2){ const unsigned w_=park[(d0*8+(r>>1))*512];
          o[d0][r]=__uint_as_float(w_<<16)-lam*(o[d0][r]*rli[r]); o[d0][r+1]=__uint_as_float(w_&0xffff0000u)-lam*(o[d0][r+1]*rli[r+1]); }
      float gsub[2*VH];
      #pragma unroll
      for(int d0=0;d0<2*VH;++d0)gsub[d0]=subg[d0*32+r32]*gmul;
      #pragma unroll
      for(int r=0;r<16;++r){ float ss=0.f;
        #pragma unroll
        for(int d0=0;d0<2*VH;++d0)ss+=o[d0][r]*o[d0][r];
        ss+=__shfl_xor(ss,1);ss+=__shfl_xor(ss,2);ss+=__shfl_xor(ss,4);ss+=__shfl_xor(ss,8);ss+=__shfl_xor(ss,16);
        const float rs=1.0f/sqrtf(ss*(1.0f/(64.f*VH))+1e-6f);
        #pragma unroll
        for(int d0=0;d0<2*VH;++d0)o[d0][r]=o[d0][r]*rs*gsub[d0];
        rli[r]=1.0f; }
    }
    { bf16*stg=(bf16*)(shm)+wid*(2048*VH);
      #pragma unroll
      for(int r=0;r<16;++r){const int orow=crow(r,hi);
        #pragma unroll
        for(int d0=0;d0<2*VH;++d0)stg[orow*(64*VH)+d0*32+r32]=__float2bfloat16(o[d0][r]*rli[r]);}
      asm volatile("s_waitcnt lgkmcnt(0)":::"memory");
      #pragma unroll
      for(int i=0;i<4*VH;++i){const int row=(VH==1)?(i*8+(lane>>3)):(i*4+(lane>>4)),ch=(VH==1)?(lane&7):(lane&15); const u32x4 v=*(const u32x4*)(stg+row*(64*VH)+ch*8); ATTN_STORE16(Ow+(long)row*op+ch*8,v);} }
  }
  asm volatile("s_waitcnt lgkmcnt(0)\n\ts_barrier":::"memory");
  #undef DMA_K
  #undef DMA_V
  #undef BIASADD
  #undef CREG
  #undef RSCALE
  #undef ROT
}
#undef SBAR
#undef WAIT_BAR
}
constexpr int NWAVES = 8;
constexpr int DM = 1024, MP = 65536, MS = 16384, MT = MP + MS, NSEQ = 33, LP = 2048, LS = 16384, DFF = 2816, NMOD = 6144;
constexpr float EPS = 1e-6f;
constexpr float LAMBDA_INIT1 = 0.35550907f;
constexpr float QSCALE = 0.125f * 1.4426950408889634f;
constexpr size_t MiB = 1u << 20;
constexpr size_t WS_BAR = 0, BAR_BYTES = 16384;
constexpr size_t WS_MOD = 1 * MiB;
constexpr size_t WS_ROPE = 3 * MiB;
constexpr size_t WS_WQKVA = 4 * MiB, WS_WOA = 7 * MiB, WS_WQKVB = 9 * MiB, WS_WOB = 15 * MiB, WS_WGU = 17 * MiB  , WS_WD = 39 * MiB  ;
constexpr size_t WS_BV = 51 * MiB;
constexpr size_t WS_RSS = 54 * MiB;
constexpr int BV_GU0 = 0, BV_QKV1 = 33 * 5632, BV_GU1 = 33 * 5632 + 33 * 3072;
constexpr size_t WS_H = 64 * MiB, WS_Q = 224 * MiB, WS_K = 384 * MiB, WS_V = 544 * MiB, WS_O = 704 * MiB, WS_END = 864 * MiB;
constexpr size_t WS_ACT = WS_Q;
constexpr size_t WS_OC0 = WS_H, WS_OC1 = WS_O;
static_assert(WS_WD + 2 * (size_t)DM * DFF * 2 <= WS_H && WS_ACT + (size_t)MT * DFF * 2 <= WS_O, "ws map");
constexpr int RING_OFF = 0;
constexpr int LDS_BYTES = 155648;

#define GAS __attribute__((address_space(1)))
#define LAS __attribute__((address_space(3)))
typedef unsigned short bf16;
typedef unsigned v4u __attribute__((ext_vector_type(4)));
typedef float f32x4 __attribute__((ext_vector_type(4)));
#define LDS_WAIT() asm volatile("s_waitcnt lgkmcnt(0)" ::: "memory")
__device__ __forceinline__ unsigned f2bf(float f) { unsigned u = __builtin_bit_cast(unsigned, f); return (u + 0x7fffu + ((u >> 16) & 1u)) >> 16; }
__device__ __forceinline__ unsigned pk2(float lo, float hi) { return f2bf(lo) | (f2bf(hi) << 16); }
__device__ __forceinline__ float bf_lo(unsigned w) { return __builtin_bit_cast(float, w << 16); }
__device__ __forceinline__ float bf_hi(unsigned w) { return __builtin_bit_cast(float, w & 0xffff0000u); }
__device__ __forceinline__ float wave_sum(float v) {
#pragma unroll
    for (int o = 1; o < 64; o <<= 1) v += __shfl_xor(v, o);
    return v;
}
#define XB_TMO      128
#define XB_XCNT(j)  (256  + 64 * (j))
#define XB_XSUB(j)  (1280 + 64 * (j))
#define XB_XGEN(j)  (2304 + 64 * (j))
#define XB_TOP      3328
#define XB_TOPGEN   3392
#define XCD_BAR_WORDS 3456
#define XB_SPIN_CAP (1u << 18)

__device__ __forceinline__ unsigned xb_ld(unsigned* p)              { return __hip_atomic_load(p, __ATOMIC_RELAXED, __HIP_MEMORY_SCOPE_AGENT); }
__device__ __forceinline__ unsigned xb_add(unsigned* p, unsigned v) { return __hip_atomic_fetch_add(p, v, __ATOMIC_RELAXED, __HIP_MEMORY_SCOPE_AGENT); }
__device__ __forceinline__ unsigned xb_xcc_id() { return (unsigned)__builtin_amdgcn_s_getreg((3 << 11) | 20) & 0xFu; }
#define XB_SPIN(cond, bar) do { unsigned _sp = 0; while (cond) { __builtin_amdgcn_s_sleep(1); \
    if ((++_sp & 255u) == 0u) { if (xb_ld(&(bar)[XB_TMO])) break; if (_sp > XB_SPIN_CAP) { atomicAdd(&(bar)[XB_TMO], 1u); break; } } } } while (0)

struct XcdBarrier {
    unsigned* bar; unsigned x;
    volatile LAS unsigned* st;
};

__device__ __forceinline__ XcdBarrier xcd_barrier_post(unsigned* bar, volatile LAS unsigned* st) {
    XcdBarrier b; b.bar = bar; b.x = xb_xcc_id(); b.st = st;
    if (threadIdx.x == 0) (void)xb_add(&bar[XB_XCNT(b.x)], 1u);
    return b;
}
__device__ __forceinline__ void xcd_barrier_complete(unsigned* bar, unsigned x, unsigned& nloc, unsigned& nx) {
    const unsigned G = gridDim.x * gridDim.y * gridDim.z;
    unsigned sum, cnt, mine, sp = 0u;
    for (;;) {
        sum = 0u; cnt = 0u; mine = 0u;
#pragma unroll
        for (unsigned j = 0; j < 16; ++j) { const unsigned c = xb_ld(&bar[XB_XCNT(j)]); sum += c; cnt += (c > 0u) ? 1u : 0u; mine = (j == x) ? c : mine; }
        if (sum == G) break;
        __builtin_amdgcn_s_sleep(1);
        if ((++sp & 255u) == 0u) { if (xb_ld(&bar[XB_TMO])) break; if (sp > XB_SPIN_CAP) { atomicAdd(&bar[XB_TMO], 1u); break; } }
    }
    nloc = mine > 0u ? mine : 1u; nx = cnt > 0u ? cnt : 1u;
}

__device__ __forceinline__ void xcd_barrier(const XcdBarrier& b) {
    asm volatile("s_waitcnt vmcnt(0)" ::: "memory");
    __syncthreads();
    if (threadIdx.x == 0) {
        unsigned* bar = b.bar;
        __builtin_amdgcn_s_waitcnt(0);
        unsigned nloc = b.st[0], nx = b.st[1];
        if (nloc == 0u) { xcd_barrier_complete(bar, b.x, nloc, nx); b.st[0] = nloc; b.st[1] = nx; }
        const unsigned old = xb_add(&bar[XB_XSUB(b.x)], 1u);
        const unsigned gen = old / nloc;
        if (old + 1u == (gen + 1u) * nloc) {
            __builtin_amdgcn_fence(__ATOMIC_RELEASE, "agent");
            asm volatile("s_waitcnt vmcnt(0)" ::: "memory");
            const unsigned og = xb_add(&bar[XB_TOP], 1u);
            const unsigned tg = og / nx;
            if (og + 1u == (tg + 1u) * nx) xb_add(&bar[XB_TOPGEN], 1u);
            else XB_SPIN(xb_ld(&bar[XB_TOPGEN]) == tg, bar);
            __builtin_amdgcn_fence(__ATOMIC_ACQUIRE, "agent");
            xb_add(&bar[XB_XGEN(b.x)], 1u);
            asm volatile("s_waitcnt vmcnt(0)" ::: "memory");
        } else {
            XB_SPIN(xb_ld(&bar[XB_XGEN(b.x)]) == gen, bar);
            __builtin_amdgcn_fence(__ATOMIC_ACQUIRE, "agent");
            asm volatile("s_waitcnt vmcnt(0)" ::: "memory");
        }
    }
    __syncthreads();
}

__device__ __forceinline__ void p0_transpose_item(const float* W, int K, int N, bf16* WT, LAS float* scr, int k0, int n0, int drow0, int lane) {
    float tv[32];
#pragma unroll
    for (int i = 0; i < 32; ++i) { const int kk = 2 * i + (lane >> 5); tv[i] = W[(size_t)(k0 + kk) * N + n0 + (lane & 31)]; }
#pragma unroll
    for (int i = 0; i < 32; ++i) { const int kk = 2 * i + (lane >> 5); scr[kk * 33 + (lane & 31)] = tv[i]; }
    LDS_WAIT(); asm volatile("" ::: "memory");
    const int c = lane & 7;
#pragma unroll
    for (int j = 0; j < 4; ++j) { const int n = (lane >> 3) + 8 * j; const LAS float* s = scr + (8 * c) * 33 + n;
        v4u o; o.x = pk2(s[0 * 33], s[1 * 33]); o.y = pk2(s[2 * 33], s[3 * 33]); o.z = pk2(s[4 * 33], s[5 * 33]); o.w = pk2(s[6 * 33], s[7 * 33]);
        *(GAS v4u*)(WT + (size_t)(drow0 + n) * K + k0 + 8 * c) = o; }
    LDS_WAIT(); asm volatile("" ::: "memory");
}
__device__ __forceinline__ void gemv33c(int bidx, int bstride, int tid, const LAS float* vec, LAS float* red, const float* W, int N, float* outp, int ostride, const float* addb) {
    const int lane = tid & 63, wave = tid >> 6, kq = lane >> 4, nn = lane & 15, kbase = wave * 128 + 4 * kq;
    typedef float f4 __attribute__((ext_vector_type(4)));
    for (int cb = bidx; cb < N / 16; cb += bstride) {
        const float* Wn = W + 16 * cb + nn;
        float w[8][4];
#pragma unroll
        for (int u = 0; u < 8; ++u)
#pragma unroll
            for (int j = 0; j < 4; ++j) w[u][j] = Wn[(size_t)(kbase + 16 * u + j) * N];
        float acc[33];
#pragma unroll
        for (int s = 0; s < 33; ++s) acc[s] = 0.f;
#pragma unroll
        for (int s = 0; s < 33; ++s) {
#pragma unroll
            for (int u = 0; u < 8; ++u) { const f4 v = *(const LAS f4*)(vec + s * 1024 + kbase + 16 * u); acc[s] += (v.x * w[u][0] + v.y * w[u][1]) + (v.z * w[u][2] + v.w * w[u][3]); }
            asm volatile("" : "+v"(acc[s]) :: "memory"); }
#pragma unroll
        for (int s = 0; s < 33; ++s) { float a = acc[s]; a += __shfl_xor(a, 16); a += __shfl_xor(a, 32); if (kq == 0) red[(wave * 33 + s) * 16 + nn] = a; }
        __syncthreads();
        for (int o = tid; o < 528; o += 512) { const int s = o >> 4, n2 = o & 15; float a = 0.f;
#pragma unroll
            for (int ww = 0; ww < 8; ++ww) a += red[(ww * 33 + s) * 16 + n2];
            outp[(size_t)s * ostride + 16 * cb + n2] = a + (addb ? addb[16 * cb + n2] : 0.f); }
        __syncthreads();
    }
}
struct Args { const float* in[24]; float* out; unsigned char* ws; };

__device__ __forceinline__ void norm_rows(int gw, int NGW, int lane, const float* src_p, const float* src_s, const float* gain, const float* modl, int sh_off, int sc_off, bf16* H) {
    for (int m0 = gw; m0 < MT; m0 += 2 * NGW) {
        const int m1 = m0 + NGW; const bool has1 = m1 < MT; const int m1c = has1 ? m1 : m0;
        const float* s0 = (m0 < MP) ? src_p + (size_t)m0 * DM : src_s + (size_t)(m0 - MP) * DM;
        const float* s1 = (m1c < MP) ? src_p + (size_t)m1c * DM : src_s + (size_t)(m1c - MP) * DM;
        const GAS f32x4* x0 = (const GAS f32x4*)s0 + lane; const GAS f32x4* x1 = (const GAS f32x4*)s1 + lane;
        f32x4 v0[4], v1[4]; float q0 = 0.f, q1 = 0.f;
#pragma unroll
        for (int j = 0; j < 4; ++j) { v0[j] = x0[64 * j]; v1[j] = x1[64 * j]; }
#pragma unroll
        for (int j = 0; j < 4; ++j) { q0 += (v0[j].x * v0[j].x + v0[j].y * v0[j].y) + (v0[j].z * v0[j].z + v0[j].w * v0[j].w); q1 += (v1[j].x * v1[j].x + v1[j].y * v1[j].y) + (v1[j].z * v1[j].z + v1[j].w * v1[j].w); }
        const float r0 = 1.0f / sqrtf(wave_sum(q0) * (1.f / DM) + EPS), r1 = 1.0f / sqrtf(wave_sum(q1) * (1.f / DM) + EPS);
        const float* mr0 = modl + (size_t)((m0 < MP) ? (m0 >> 11) : 32) * NMOD; const float* mr1 = modl + (size_t)((m1c < MP) ? (m1c >> 11) : 32) * NMOD;
        GAS unsigned long long* o0 = (GAS unsigned long long*)(H + (size_t)m0 * DM) + lane; GAS unsigned long long* o1 = (GAS unsigned long long*)(H + (size_t)m1c * DM) + lane;
#pragma unroll
        for (int j = 0; j < 4; ++j) { const int col = 4 * lane + 256 * j; const f32x4 g = *(const f32x4*)(gain + col);
            const f32x4 y0 = (v0[j] * r0) * g * (*(const f32x4*)(mr0 + sc_off + col) + 1.0f) + *(const f32x4*)(mr0 + sh_off + col);
            o0[64 * j] = (unsigned long long)pk2(y0.x, y0.y) | ((unsigned long long)pk2(y0.z, y0.w) << 32);
            if (has1) { const f32x4 y1 = (v1[j] * r1) * g * (*(const f32x4*)(mr1 + sc_off + col) + 1.0f) + *(const f32x4*)(mr1 + sh_off + col);
                o1[64 * j] = (unsigned long long)pk2(y1.x, y1.y) | ((unsigned long long)pk2(y1.z, y1.w) << 32); } }
    }
}
__device__ __forceinline__ void qknorm_chunks(int gw, int NGW, int lane, bf16* buf, int nchunks, int row_width_log2, const float* gain, float qscale, bool rope, const float* ropetab) {
    const int d0 = 16 * (lane & 3);
    float g[16];
#pragma unroll
    for (int i = 0; i < 16; ++i) g[i] = gain[d0 + i] * qscale;
    for (int ci = gw; ci < nchunks; ci += NGW) {
        GAS v4u* p = (GAS v4u*)(buf + (size_t)ci * 1024 + 16 * lane);
        const v4u a = p[0], b = p[1];
        float x[16];
        x[0] = bf_lo(a.x); x[1] = bf_hi(a.x); x[2] = bf_lo(a.y); x[3] = bf_hi(a.y); x[4] = bf_lo(a.z); x[5] = bf_hi(a.z); x[6] = bf_lo(a.w); x[7] = bf_hi(a.w);
        x[8] = bf_lo(b.x); x[9] = bf_hi(b.x); x[10] = bf_lo(b.y); x[11] = bf_hi(b.y); x[12] = bf_lo(b.z); x[13] = bf_hi(b.z); x[14] = bf_lo(b.w); x[15] = bf_hi(b.w);
        float ss = 0.f;
#pragma unroll
        for (int i = 0; i < 16; ++i) ss += x[i] * x[i];
        ss += __shfl_xor(ss, 1); ss += __shfl_xor(ss, 2);
        const float r = 1.0f / sqrtf(ss * (1.f / 64.f) + EPS);
#pragma unroll
        for (int i = 0; i < 16; ++i) x[i] = x[i] * r * g[i];
        if (rope) {
            const int m = (int)((((size_t)ci * 1024 + 16 * lane)) >> row_width_log2);
            const int t = (m < MP) ? (m & (LP - 1)) : (m - MP);
            const int qd = lane & 3; const int pos = (qd < 2) ? (t >> 6) : (t & 63);
            const f32x4* tb = (const f32x4*)(ropetab + (size_t)(pos * 16 + 8 * (qd & 1)) * 2);
#pragma unroll
            for (int j = 0; j < 4; ++j) { const f32x4 cs = tb[j];
                const float a0 = x[4 * j], a1 = x[4 * j + 1], b0 = x[4 * j + 2], b1 = x[4 * j + 3];
                x[4 * j] = a0 * cs.x - a1 * cs.y; x[4 * j + 1] = a0 * cs.y + a1 * cs.x; x[4 * j + 2] = b0 * cs.z - b1 * cs.w; x[4 * j + 3] = b0 * cs.w + b1 * cs.z; }
        }
        v4u oa, ob;
        oa.x = pk2(x[0], x[1]); oa.y = pk2(x[2], x[3]); oa.z = pk2(x[4], x[5]); oa.w = pk2(x[6], x[7]);
        ob.x = pk2(x[8], x[9]); ob.y = pk2(x[10], x[11]); ob.z = pk2(x[12], x[13]); ob.w = pk2(x[14], x[15]);
        p[0] = oa; p[1] = ob;
    }
}
__device__ __forceinline__ void diff_combine(int gw, int NGW, int lane, const bf16* O0, bf16* O1, const float* subg, float lam) {
    const int d0 = 16 * (lane & 7);
    float g[16];
#pragma unroll
    for (int i = 0; i < 16; ++i) g[i] = subg[d0 + i] * (1.0f - LAMBDA_INIT1);
    for (int m = gw; m < MT; m += NGW) {
        const GAS v4u* p0 = (const GAS v4u*)(O0 + (size_t)m * 1024 + 16 * lane);
        GAS v4u* p1 = (GAS v4u*)(O1 + (size_t)m * 1024 + 16 * lane);
        const v4u a0 = p0[0], b0 = p0[1], a1 = p1[0], b1 = p1[1];
        float x[16];
#define DC(i, w0, w1) x[2 * (i)] = bf_lo(w0) - lam * bf_lo(w1); x[2 * (i) + 1] = bf_hi(w0) - lam * bf_hi(w1);
        DC(0, a0.x, a1.x) DC(1, a0.y, a1.y) DC(2, a0.z, a1.z) DC(3, a0.w, a1.w) DC(4, b0.x, b1.x) DC(5, b0.y, b1.y) DC(6, b0.z, b1.z) DC(7, b0.w, b1.w)
#undef DC
        float ss = 0.f;
#pragma unroll
        for (int i = 0; i < 16; ++i) ss += x[i] * x[i];
        ss += __shfl_xor(ss, 1); ss += __shfl_xor(ss, 2); ss += __shfl_xor(ss, 4);
        const float r = 1.0f / sqrtf(ss * (1.f / 128.f) + EPS);
#pragma unroll
        for (int i = 0; i < 16; ++i) x[i] = x[i] * r * g[i];
        v4u oa, ob;
        oa.x = pk2(x[0], x[1]); oa.y = pk2(x[2], x[3]); oa.z = pk2(x[4], x[5]); oa.w = pk2(x[6], x[7]);
        ob.x = pk2(x[8], x[9]); ob.y = pk2(x[10], x[11]); ob.z = pk2(x[12], x[13]); ob.w = pk2(x[14], x[15]);
        p1[0] = oa; p1[1] = ob;
    }
}

__global__ void __launch_bounds__(NWAVES * 64, 2) mega_fwd(Args args) {
    extern __shared__ __attribute__((aligned(16))) unsigned char lds[];
    cg::grid_group grid = cg::this_grid();
    LAS unsigned char* ldsl = (LAS unsigned char*)lds;
    const int tid = threadIdx.x, lane = tid & 63, wave = __builtin_amdgcn_readfirstlane(tid >> 6);
    const int G = gridDim.x, bx = blockIdx.x;
    const int vcu = (G % 8 == 0) ? (bx % 8) * (G / 8) + bx / 8 : bx;
    const int gw = vcu * NWAVES + wave, NGW = G * NWAVES;
    volatile LAS unsigned* bst = (volatile LAS unsigned*)(ldsl + 155584);
    if (tid < 16) bst[tid] = 0u;
    __syncthreads();
    const XcdBarrier xbar = xcd_barrier_post((unsigned*)(args.ws + WS_BAR), bst);
    typedef __attribute__((address_space(4))) const Args* cargs_t;
    const cargs_t ap0 = (cargs_t)__builtin_amdgcn_kernarg_segment_ptr();
#define AP() cargs_t ap = ap0; asm volatile("" : "+s"(ap))
#define WSP(T, off) ((T*)(ap->ws + (off)))
#define mod WSP(float, WS_MOD)
#define ropetab WSP(float, WS_ROPE)
#define Wqkv_a WSP(bf16, WS_WQKVA)
#define Wo_a WSP(bf16, WS_WOA)
#define Wqkv_b WSP(bf16, WS_WQKVB)
#define Wo_b WSP(bf16, WS_WOB)
#define Wgu WSP(bf16, WS_WGU)
#define Wd WSP(bf16, WS_WD)
#define H WSP(bf16, WS_H)
#define Qb WSP(bf16, WS_Q)
#define Kb WSP(bf16, WS_K)
#define Vb WSP(bf16, WS_V)
#define Ob WSP(bf16, WS_O)
#define ACT WSP(bf16, WS_ACT)
#define OC0 WSP(bf16, WS_OC0)
#define OC1 WSP(bf16, WS_OC1)
#define out (ap->out)
#define x_p (ap->in[0])
#define x_s (ap->in[1])
    {
        AP();
        LAS float* scr = (LAS float*)(ldsl + RING_OFF + wave * 16384);
        constexpr int I_QA = 16 * 48, I_OA = 16 * 32, I_QB = 16 * 96, I_OB = 16 * 32, I_GU = 16 * 176, I_D = 44 * 32;
        constexpr int NITEMS = I_QA + I_OA + I_QB + I_OB + 2 * I_GU + 2 * I_D;
        for (int it = gw; it < NITEMS; it += NGW) {
            int r = it;
            if (r < I_QA) { const int nb = r % 48, kb = r / 48; p0_transpose_item(ap->in[11], 1024, 1536, Wqkv_a, scr, 64 * kb, 32 * nb, 32 * nb, lane); continue; } r -= I_QA;
            if (r < I_OA) { const int nb = r % 32, kb = r / 32; p0_transpose_item(ap->in[12], 1024, 1024, Wo_a, scr, 64 * kb, 32 * nb, 32 * nb, lane); continue; } r -= I_OA;
            if (r < I_QB) { const int nb = r % 96, kb = r / 96; p0_transpose_item(ap->in[15], 1024, 3072, Wqkv_b, scr, 64 * kb, 32 * nb, 32 * nb, lane); continue; } r -= I_QB;
            if (r < I_OB) { const int nb = r % 32, kb = r / 32; p0_transpose_item(ap->in[16], 1024, 1024, Wo_b, scr, 64 * kb, 32 * nb, 32 * nb, lane); continue; } r -= I_OB;
            if (r < 2 * I_GU) { const int l = r / I_GU; r -= l * I_GU; const int nb = r % 176, kb = r / 176; const int n0 = 32 * nb;
                const int drow0 = (n0 < DFF) ? (n0 / 128) * 256 + (n0 % 128) : ((n0 - DFF) / 128) * 256 + 128 + ((n0 - DFF) % 128);
                p0_transpose_item(ap->in[8] + (size_t)l * 1024 * 5632, 1024, 5632, Wgu + (size_t)l * 5632 * 1024, scr, 64 * kb, n0, drow0, lane); continue; } r -= 2 * I_GU;
            { const int l = r / I_D; r -= l * I_D; const int nb = r % 32, kb = r / 32;
                p0_transpose_item(ap->in[9] + (size_t)l * DFF * 1024, DFF, 1024, Wd + (size_t)l * 1024 * DFF, scr, 64 * kb, 32 * nb, 32 * nb, lane); }
        }
        { const int gt = vcu * 512 + tid;
          if (gt < 4096) { const int pos = gt >> 4, f = gt & 15; const float inv = exp2f(-(float)f * (13.287712379549449f / 16.0f)); const float ang = (float)pos * inv;
              const float rev = ang * 0.15915494309189535f; ropetab[2 * gt] = __builtin_amdgcn_cosf(rev); ropetab[2 * gt + 1] = __builtin_amdgcn_sinf(rev); } }
        __syncthreads();
        LAS float* cact = (LAS float*)ldsl;
        for (int i = tid; i < NSEQ * 1024; i += 512) { const int s = i >> 10, k = i & 1023; const float c = (s < 32) ? ap->in[2][s * 1024 + k] : ap->in[3][k];
            cact[i] = c / (1.0f + __expf(-c)); }
        __syncthreads();
        { const int half = G / 2; const int l = (vcu >= half) ? 1 : 0;
          gemv33c(vcu - l * half, half > 0 ? half : 1, tid, cact, (LAS float*)(ldsl + 135168), ap->in[6] + (size_t)l * 1024 * NMOD, NMOD, mod + (size_t)l * NSEQ * NMOD, NMOD, ap->in[7] + l * NMOD); }
        { float* rss = WSP(float, WS_RSS); for (int i = vcu * 512 + tid; i < 3 * MT; i += G * 512) rss[i] = 0.f; }
        __syncthreads();
    }
    grid.sync();

    auto layer_body = [&](auto LC) __attribute__((always_inline)) {
        constexpr int layer = decltype(LC)::value;
        AP();
#define modl (mod + (size_t)layer * NSEQ * NMOD)
        if (layer == 0) {
            norm_rows(gw, NGW, lane, x_p, x_s, ap->in[4], modl, 0, 1024, H);
            LAS float* shv = (LAS float*)ldsl; float* bv = WSP(float, WS_BV);
#pragma unroll 1
            for (int which = 0; which < 3; ++which) {
                const float* shsrc = mod + (size_t)(which == 0 ? 0 : 1) * NSEQ * NMOD + (which == 1 ? 0 : 3072);
                for (int i = tid; i < NSEQ * 1024; i += 512) shv[i] = shsrc[(size_t)(i >> 10) * NMOD + (i & 1023)];
                __syncthreads();
                if (which == 0) gemv33c(vcu, G, tid, shv, (LAS float*)(ldsl + 135168), ap->in[8], 5632, bv + BV_GU0, 5632, nullptr);
                else if (which == 1) gemv33c(vcu, G, tid, shv, (LAS float*)(ldsl + 135168), ap->in[15], 3072, bv + BV_QKV1, 3072, nullptr);
                else gemv33c(vcu, G, tid, shv, (LAS float*)(ldsl + 135168), ap->in[8] + (size_t)1024 * 5632, 5632, bv + BV_GU1, 5632, nullptr);
                __syncthreads();
            }
            xcd_barrier(xbar);
        }
        if (layer == 0) {
            pg8::Gemm g{H, Wqkv_a, MT, 1536, 1024}; pg8::StaticOrder S; S.init(MT, 1536, G, bx);
            pg8::EpiSplit2<false, true> E{Qb, Kb, Vb, 1024, 256, 256, 4, 5, nullptr, nullptr, 0, ap->in[13], ap->in[14], QSCALE, ropetab, (LAS float*)(ldsl + 131072)};
            pg8::gemm_phase<pg8::EpiSplit2<false, true>, pg8::StaticOrder, true, PG8_SP2>(ldsl + RING_OFF, g, S, E);
        } else {
            pg8::Gemm g{H, Wqkv_b, MT, 3072, 1024}; pg8::StaticOrder S; S.init(MT, 3072, G, bx);
            pg8::EpiSplit2<true, false> E{Qb, Kb, Vb, 1024, 1024, 1024, 4, 8, WSP(float, WS_RSS) + MT, WSP(float, WS_BV) + BV_QKV1, 3072, ap->in[17], ap->in[18], QSCALE, ropetab, (LAS float*)(ldsl + 131072)};
            pg8::gemm_phase<pg8::EpiSplit2<true, false>, pg8::StaticOrder, true, PG8_SP2>(ldsl + RING_OFF, g, S, E);
        }
        xcd_barrier(xbar);
        if (layer == 0) {
            for (int idx = vcu; idx < 1024 + 4096; idx += G) {
                size_t tok0; int head, kvh, qb, NT;
                if (idx < 1024) { const int xcd = (idx >> 5) & 7, j = idx & 31, i = idx >> 8; kvh = xcd & 3; const int w = (((xcd >> 2) * 4 + i) << 5) + j; head = kvh * 4 + (w >> 6); qb = w & 63; tok0 = MP; NT = LS / 64; }
                else { const int id2 = idx - 1024; const int xcd = (id2 >> 5) & 7, j = id2 & 31, i = id2 >> 8; const int gq = xcd * 16 + i; kvh = gq & 3; head = kvh * 4 + (j >> 3); qb = j & 7; tok0 = (size_t)(gq >> 2) * LP; NT = LP / 64; }
                attn_body::attn_unit2<1, false, 0>((const attn_body::bf16*)(Qb + tok0 * 1024 + head * 64), 1024, (const attn_body::bf16*)(Kb + tok0 * 256 + kvh * 64), 256,
                    (const attn_body::bf16*)(Vb + tok0 * 256 + kvh * 64), 256, (attn_body::bf16*)(Ob + tok0 * 1024 + head * 64), 1024, qb * 256, NT, nullptr, (char*)lds + RING_OFF, 0.f, nullptr, 0.f); }
        } else {
            const float s1 = wave_sum(ap->in[19][lane] * ap->in[20][lane]), s2 = wave_sum(ap->in[21][lane] * ap->in[22][lane]);
            const float lam = expf(s1) - expf(s2) + LAMBDA_INIT1;
            for (int idx = vcu; idx < 512 + 2048; idx += G) {
                size_t tok0; int h, qb, NT;
                if (idx < 512) { const int xcd = (idx >> 5) & 7, j = idx & 31, i = idx >> 8; h = xcd; qb = (i << 5) + j; tok0 = MP; NT = LS / 64; }
                else { const int id2 = idx - 512; const int xcd = (id2 >> 5) & 7, j = id2 & 31, i = id2 >> 8; const int gq = ((xcd * 8 + i) << 2) + (j >> 3); h = gq & 7; qb = j & 7; tok0 = (size_t)(gq >> 3) * LP; NT = LP / 64; }
                attn_body::attn_unit2<2, true, 1>((const attn_body::bf16*)(Qb + tok0 * 1024 + (2 * h) * 64), 1024, (const attn_body::bf16*)(Kb + tok0 * 1024 + (2 * h) * 64), 1024,
                    (const attn_body::bf16*)(Vb + tok0 * 1024 + h * 128), 1024, (attn_body::bf16*)(Ob + tok0 * 1024 + h * 128), 1024, qb * 256, NT, ap->in[10] + h, (char*)lds + RING_OFF, lam, ap->in[23], 1.0f - LAMBDA_INIT1);
                attn_body::attn_unit2<2, true, 2>((const attn_body::bf16*)(Qb + tok0 * 1024 + (2 * h + 1) * 64), 1024, (const attn_body::bf16*)(Kb + tok0 * 1024 + (2 * h + 1) * 64), 1024,
                    (const attn_body::bf16*)(Vb + tok0 * 1024 + h * 128), 1024, (attn_body::bf16*)(Ob + tok0 * 1024 + h * 128), 1024, qb * 256, NT, ap->in[10] + h, (char*)lds + RING_OFF, lam, ap->in[23], 1.0f - LAMBDA_INIT1); }
        }
        xcd_barrier(xbar);
        {
            pg8::Gemm g{Ob, layer == 0 ? Wo_a : Wo_b, MT, 1024, 1024}; pg8::StaticOrder S; S.init(MT, 1024, G, bx);
            pg8::EpiResid2<true> E{layer == 0 ? x_p : out, layer == 0 ? (x_s - (size_t)MP * DM) : out, out, modl + 2048, ap->in[5] + layer * 1024, modl + 4096, H, WSP(float, WS_RSS) + (layer == 0 ? 0 : 2 * MT)};
            pg8::gemm_phase<pg8::EpiResid2<true>, pg8::StaticOrder, PG8_ALIGN, PG8_SP2>(ldsl + RING_OFF, g, S, E);
        }
        xcd_barrier(xbar);
        {
            pg8::Gemm g{H, Wgu + (size_t)layer * 5632 * 1024, MT, 5632, 1024}; pg8::StaticOrder S; S.init(MT, 5632, G, bx);
            pg8::EpiSwiGLU2 E{ACT, DFF, WSP(float, WS_RSS) + (layer == 0 ? 0 : 2 * MT), WSP(float, WS_BV) + (layer == 0 ? BV_GU0 : BV_GU1)};
            pg8::gemm_phase<pg8::EpiSwiGLU2, pg8::StaticOrder, PG8_ALIGN, PG8_SP2>(ldsl + RING_OFF, g, S, E);
        }
        xcd_barrier(xbar);
        {
            pg8::Gemm g{ACT, Wd + (size_t)layer * 1024 * DFF, MT, 1024, DFF}; pg8::StaticOrder S; S.init(MT, 1024, G, bx);
            if (layer == 0) {
                pg8::EpiResid2<true> E{out, out, out, modl + 5120, ap->in[4] + 1024, mod + (size_t)NSEQ * NMOD + 1024, H, WSP(float, WS_RSS) + MT};
                pg8::gemm_phase<pg8::EpiResid2<true>, pg8::StaticOrder, PG8_ALIGN, PG8_SP2>(ldsl + RING_OFF, g, S, E);
            } else {
                pg8::EpiResid2<false> E{out, out, out, modl + 5120, nullptr, nullptr, nullptr, nullptr};
                pg8::gemm_phase<pg8::EpiResid2<false>, pg8::StaticOrder, PG8_ALIGN, PG8_SP2>(ldsl + RING_OFF, g, S, E);
            }
        }
        if (layer == 0) xcd_barrier(xbar);
    };
    layer_body(std::integral_constant<int, 0>{});
    layer_body(std::integral_constant<int, 1>{});
}

#undef out
#undef H
#undef mod
#undef modl
#undef ACT
#undef Qb
#undef Kb
#undef Vb
#undef Ob
extern "C" void kernel_launch(void* const* d_in, const int* in_sizes, int n_in, void* d_out, int out_size, void* d_ws, size_t ws_size, hipStream_t stream) {
    static int grid = 0;
    if (grid == 0) {
        if (n_in != 24 || out_size != MT * DM || ws_size < WS_END) { fprintf(stderr, "kernel_launch: unexpected shapes (n_in %d, out %d, ws %zu)\n", n_in, out_size, ws_size); grid = -1; return; }
        int dev = 0, cus = 0, per_cu = 0;
        hipGetDevice(&dev); hipDeviceGetAttribute(&cus, hipDeviceAttributeMultiprocessorCount, dev);
        if (hipFuncSetAttribute((const void*)mega_fwd, hipFuncAttributeMaxDynamicSharedMemorySize, LDS_BYTES) != hipSuccess) { fprintf(stderr, "hipFuncSetAttribute failed\n"); grid = -1; return; }
        if (hipOccupancyMaxActiveBlocksPerMultiprocessor(&per_cu, (const void*)mega_fwd, NWAVES * 64, LDS_BYTES) != hipSuccess || per_cu < 1) per_cu = 1;
        (void)hipGetLastError();
        grid = cus;
        if (grid > 256) grid = 256;
    }
    if (grid < 0) return;
    if (hipMemsetAsync((char*)d_ws + WS_BAR, 0, BAR_BYTES, stream) != hipSuccess) { fprintf(stderr, "hipMemsetAsync of the barrier words failed\n"); return; }
    Args a{};
    for (int i = 0; i < 24; ++i) a.in[i] = (const float*)d_in[i];
    a.out = (float*)d_out; a.ws = (unsigned char*)d_ws;
    void* kargs[] = {&a};
    hipError_t e = hipLaunchCooperativeKernel((const void*)mega_fwd, dim3(grid), dim3(NWAVES * 64), kargs, LDS_BYTES, stream);
    if (e != hipSuccess) fprintf(stderr, "cooperative launch failed: %s (grid %d)\n", hipGetErrorString(e), grid);
}
```

```cpp
#include <hip/hip_runtime.h>
#include <hip/hip_cooperative_groups.h>
#include <hip/hip_bf16.h>
#include <cstdio>
#include <cstdint>
#include <cmath>
#include <type_traits>
namespace cg = cooperative_groups;
namespace pg8 {
#define PG8_LAS __attribute__((address_space(3)))
typedef unsigned short bf16_t;
typedef short bf16x8 __attribute__((ext_vector_type(8)));
typedef float f32x4 __attribute__((ext_vector_type(4)));
typedef unsigned u32x4 __attribute__((ext_vector_type(4)));
constexpr int BM = 256, BK = 64, HALF = 128, HTB = HALF * BK * 2  , STAGE_BYTES = 8 * HTB, NXCD = 8, WGM = 8;

__host__ __device__ __forceinline__ int lds_byte(int r, int c) { const int st = (r >> 4) * 2 + (c >> 5), rr = r & 15, cc = c & 31, ob = rr * 64 + cc * 2; return st * 1024 + (ob ^ (((ob >> 9) & 1) << 5)); }
__host__ __device__ __forceinline__ void stage_rc(int b, int& R, int& C) { const int st = b / 1024, sb = b % 1024, swz = sb ^ (((sb >> 9) & 1) << 5); R = (st >> 1) * 16 + swz / 64; C = (st & 1) * 32 + (swz % 64) / 2; }
__host__ __device__ __forceinline__ int perm32(int rho) { const int n = rho >> 4, i = rho & 15; return 8 * (i >> 2) + 4 * n + (i & 3); }

struct Unit { int pm, pn; };
struct Gemm { const bf16_t* A; const bf16_t* Bt; int M, N, K; };

struct StaticOrder {
    int nM, nN, nwg, G, c;
    __host__ __device__ void init(int M, int N, int G_, int c_) { nM = M / BM; nN = N / BM; nwg = nM * nN; G = G_; c = c_; }
    __host__ __device__ bool next(int i, Unit& u) const {
        const long L = (long)i * G + c; if (L >= nwg) return false;
        int wgid = (int)L; { const int q = nwg / NXCD, r = nwg % NXCD, xcd = wgid % NXCD, off = wgid / NXCD; wgid = (xcd < r ? xcd * (q + 1) : r * (q + 1) + (xcd - r) * q) + off; }
        const int nig = WGM * nN, gid = wgid / nig, fm = gid * WGM, gsz = (nM - fm) < WGM ? (nM - fm) : WGM;
        u.pm = fm + ((wgid % nig) % gsz); u.pn = (wgid % nig) / gsz; return true;
    }
    __device__ __forceinline__ void a_ready(const Unit&) const {}
    __device__ __forceinline__ void done(const Unit&) const {}
};

__device__ __forceinline__ unsigned cvt_pk_bf16(float lo, float hi) { unsigned r; asm volatile("v_cvt_pk_bf16_f32 %0, %1, %2" : "=v"(r) : "v"(lo), "v"(hi)); return r; }
typedef float f32x2 __attribute__((ext_vector_type(2)));
__device__ __forceinline__ float silu_mul(float g, float uu) { const float e = __builtin_amdgcn_exp2f(g * -1.4426950408889634f); return g * __builtin_amdgcn_rcpf(1.0f + e) * uu; }
constexpr float EPI_EPS = 1e-6f;
template <bool NEXT> struct EpiResid2 {
    static constexpr bool PERM = true, AFTER_DRAIN = false;
    const float* base_p; const float* base_s; float* out; const float* gate;
    const float* ngain; const float* nsc; bf16_t* Hn; float* rowss;
    __device__ __forceinline__ void prefetch(PG8_LAS unsigned char*, const Unit&, int, int) const {}
    __device__ __forceinline__ void operator()(const f32x4 (&acc)[2][2][4][2], const Unit& u, int wr, int wc, int fr, int fq, PG8_LAS unsigned char*) const {
        const int seq = (u.pm < 256) ? (u.pm >> 3) : 32;
        const float* base = (u.pm < 256) ? base_p : base_s;
        const int col0 = u.pn * BM + wc * 32 + 8 * fq;
        u32x4 dl[2][4][2];
        { f32x4 gv[2][2];
#pragma unroll
          for (int bj = 0; bj < 2; ++bj)
#pragma unroll
            for (int n = 0; n < 2; ++n) gv[bj][n] = *(const f32x4*)(gate + (size_t)seq * 6144 + col0 + bj * HALF + 4 * n);
#pragma unroll
          for (int ai = 0; ai < 2; ++ai)
#pragma unroll
            for (int m = 0; m < 4; ++m)
#pragma unroll
                for (int bj = 0; bj < 2; ++bj) { const f32x4 a = gv[bj][0] * acc[ai][bj][m][0], b = gv[bj][1] * acc[ai][bj][m][1];
                    dl[ai][m][bj].x = cvt_pk_bf16(a[0], a[1]); dl[ai][m][bj].y = cvt_pk_bf16(a[2], a[3]); dl[ai][m][bj].z = cvt_pk_bf16(b[0], b[1]); dl[ai][m][bj].w = cvt_pk_bf16(b[2], b[3]); } }
        f32x4 gm[2][2];
        if (NEXT) {
#pragma unroll
          for (int bj = 0; bj < 2; ++bj)
#pragma unroll
            for (int n = 0; n < 2; ++n) { const int c = col0 + bj * HALF + 4 * n; gm[bj][n] = *(const f32x4*)(ngain + c) * (*(const f32x4*)(nsc + (size_t)seq * 6144 + c) + 1.0f); } }
#define BFLO(w) __builtin_bit_cast(float, (w) << 16)
#define BFHI(w) __builtin_bit_cast(float, (w) & 0xffff0000u)
#pragma unroll
        for (int ai = 0; ai < 2; ++ai) {
            f32x4 bs[4][2][2];
#pragma unroll
            for (int m = 0; m < 4; ++m) { const size_t off = (size_t)(u.pm * BM + ai * HALF + wr * 64 + m * 16 + fr) * 1024 + col0;
#pragma unroll
                for (int bj = 0; bj < 2; ++bj) { bs[m][bj][0] = *(const f32x4*)(base + off + bj * HALF); bs[m][bj][1] = *(const f32x4*)(base + off + bj * HALF + 4); } }
#pragma unroll
            for (int m = 0; m < 4; ++m) { const int row = u.pm * BM + ai * HALF + wr * 64 + m * 16 + fr; const size_t off = (size_t)row * 1024 + col0; float ss = 0.f;
#pragma unroll
                for (int bj = 0; bj < 2; ++bj) { const u32x4 d = dl[ai][m][bj];
                    const f32x4 o0 = bs[m][bj][0] + (f32x4){BFLO(d.x), BFHI(d.x), BFLO(d.y), BFHI(d.y)}, o1 = bs[m][bj][1] + (f32x4){BFLO(d.z), BFHI(d.z), BFLO(d.w), BFHI(d.w)};
                    *(f32x4*)(out + off + bj * HALF) = o0; *(f32x4*)(out + off + bj * HALF + 4) = o1;
                    if (NEXT) { ss += (o0[0] * o0[0] + o0[1] * o0[1]) + (o0[2] * o0[2] + o0[3] * o0[3]) + (o1[0] * o1[0] + o1[1] * o1[1]) + (o1[2] * o1[2] + o1[3] * o1[3]);
                        const f32x4 h0 = o0 * gm[bj][0], h1 = o1 * gm[bj][1];
                        u32x4 w; w.x = cvt_pk_bf16(h0[0], h0[1]); w.y = cvt_pk_bf16(h0[2], h0[3]); w.z = cvt_pk_bf16(h1[0], h1[1]); w.w = cvt_pk_bf16(h1[2], h1[3]);
                        *(u32x4*)(Hn + off + bj * HALF) = w; } }
                if (NEXT) { ss += __shfl_xor(ss, 16); ss += __shfl_xor(ss, 32); if (fq == 0) __hip_atomic_fetch_add(rowss + row, ss, __ATOMIC_RELAXED, __HIP_MEMORY_SCOPE_AGENT); } }
            asm volatile("" ::: "memory"); }
#undef BFLO
#undef BFHI
    }
};

template <bool NEXT> struct EpiResid3 {
    static constexpr bool PERM = true, AFTER_DRAIN = false;
    const float* base_p; const float* base_s; float* out; const float* gate;
    const float* ngain; const float* nsc; bf16_t* Hn; float* rowss;
    __device__ __forceinline__ void prefetch(PG8_LAS unsigned char*, const Unit&, int, int) const {}
    __device__ __forceinline__ void operator()(const f32x4 (&acc)[2][2][4][2], const Unit& u, int wr, int wc, int fr, int fq, PG8_LAS unsigned char* sp) const {
        typedef unsigned u32x2 __attribute__((ext_vector_type(2)));
        const int seq = (u.pm < 256) ? (u.pm >> 3) : 32;
        const float* base = (u.pm < 256) ? base_p : base_s;
        const int wid = wr * 4 + wc, l = fq * 16 + fr, rr = l >> 3, pp = l & 7;
        PG8_LAS float* T = (PG8_LAS float*)(sp + 2048) + wid * 576;
        PG8_LAS float* Tw = T + fr * 36 + 8 * fq;
        const PG8_LAS float* Tr = T + rr * 36 + 4 * pp;
        const int col0 = u.pn * BM + wc * 32 + 8 * fq, colr = u.pn * BM + wc * 32 + 4 * pp;
        u32x4 dl[2][4][2];
        { f32x4 gv[2][2];
#pragma unroll
          for (int bj = 0; bj < 2; ++bj)
#pragma unroll
            for (int n = 0; n < 2; ++n) gv[bj][n] = *(const f32x4*)(gate + (size_t)seq * 6144 + col0 + bj * HALF + 4 * n);
#pragma unroll
          for (int ai = 0; ai < 2; ++ai)
#pragma unroll
            for (int m = 0; m < 4; ++m)
#pragma unroll
                for (int bj = 0; bj < 2; ++bj) { const f32x4 a = gv[bj][0] * acc[ai][bj][m][0], b = gv[bj][1] * acc[ai][bj][m][1];
                    dl[ai][m][bj].x = cvt_pk_bf16(a[0], a[1]); dl[ai][m][bj].y = cvt_pk_bf16(a[2], a[3]); dl[ai][m][bj].z = cvt_pk_bf16(b[0], b[1]); dl[ai][m][bj].w = cvt_pk_bf16(b[2], b[3]); } }
        f32x4 gmr[2];
        if (NEXT) {
#pragma unroll
            for (int bj = 0; bj < 2; ++bj) gmr[bj] = *(const f32x4*)(ngain + colr + bj * HALF) * (*(const f32x4*)(nsc + (size_t)seq * 6144 + colr + bj * HALF) + 1.0f); }
#define BFLO3(w) __builtin_bit_cast(float, (w) << 16)
#define BFHI3(w) __builtin_bit_cast(float, (w) & 0xffff0000u)
#pragma unroll
        for (int ai = 0; ai < 2; ++ai) {
            const int rowb = u.pm * BM + ai * HALF + wr * 64 + rr;
            f32x4 bs[4][2][2];
#pragma unroll
            for (int m = 0; m < 4; ++m)
#pragma unroll
                for (int bj = 0; bj < 2; ++bj)
#pragma unroll
                    for (int h = 0; h < 2; ++h) bs[m][bj][h] = *(const f32x4*)(base + (size_t)(rowb + m * 16 + 8 * h) * 1024 + colr + bj * HALF);
            asm volatile("" ::: "memory");
#pragma unroll
            for (int m = 0; m < 4; ++m) { float ss0 = 0.f, ss1 = 0.f; const size_t off0 = (size_t)(rowb + m * 16) * 1024 + colr, off1 = off0 + 8 * 1024;
#pragma unroll
                for (int bj = 0; bj < 2; ++bj) {
                    { const u32x4 d = dl[ai][m][bj]; *(PG8_LAS f32x4*)(Tw) = (f32x4){BFLO3(d.x), BFHI3(d.x), BFLO3(d.y), BFHI3(d.y)}; *(PG8_LAS f32x4*)(Tw + 4) = (f32x4){BFLO3(d.z), BFHI3(d.z), BFLO3(d.w), BFHI3(d.w)}; }
                    asm volatile("s_waitcnt lgkmcnt(0)" ::: "memory");
                    const f32x4 d0 = *(const PG8_LAS f32x4*)(Tr), d1 = *(const PG8_LAS f32x4*)(Tr + 8 * 36);
                    asm volatile("s_waitcnt lgkmcnt(0)" ::: "memory");
                    const f32x4 o0 = bs[m][bj][0] + d0, o1 = bs[m][bj][1] + d1;
                    *(f32x4*)(out + off0 + bj * HALF) = o0; *(f32x4*)(out + off1 + bj * HALF) = o1;
                    if (NEXT) { ss0 += (o0[0] * o0[0] + o0[1] * o0[1]) + (o0[2] * o0[2] + o0[3] * o0[3]); ss1 += (o1[0] * o1[0] + o1[1] * o1[1]) + (o1[2] * o1[2] + o1[3] * o1[3]);
                        const f32x4 h0 = o0 * gmr[bj], h1 = o1 * gmr[bj];
                        u32x2 w0, w1; w0.x = cvt_pk_bf16(h0[0], h0[1]); w0.y = cvt_pk_bf16(h0[2], h0[3]); w1.x = cvt_pk_bf16(h1[0], h1[1]); w1.y = cvt_pk_bf16(h1[2], h1[3]);
                        *(u32x2*)(Hn + off0 + bj * HALF) = w0; *(u32x2*)(Hn + off1 + bj * HALF) = w1; } }
                if (NEXT) { ss0 += __shfl_xor(ss0, 1); ss0 += __shfl_xor(ss0, 2); ss0 += __shfl_xor(ss0, 4); ss1 += __shfl_xor(ss1, 1); ss1 += __shfl_xor(ss1, 2); ss1 += __shfl_xor(ss1, 4);
                    if (pp == 0) { __hip_atomic_fetch_add(rowss + rowb + m * 16, ss0, __ATOMIC_RELAXED, __HIP_MEMORY_SCOPE_AGENT); __hip_atomic_fetch_add(rowss + rowb + m * 16 + 8, ss1, __ATOMIC_RELAXED, __HIP_MEMORY_SCOPE_AGENT); } } }
            asm volatile("" ::: "memory"); }
    }
};
struct EpiSwiGLU2 {
    static constexpr bool PERM = true, AFTER_DRAIN = false;
    bf16_t* O; int ldc; const float* rowss; const float* bias;
    __device__ __forceinline__ void prefetch(PG8_LAS unsigned char* sp, const Unit& u, int wid, int lane) const {
        const int seq = (u.pm < 256) ? (u.pm >> 3) : 32;
        const float* src = (wid < 4) ? rowss + u.pm * BM + wid * 64 : bias + (size_t)seq * 5632 + u.pn * HALF + (wid < 6 ? (wid - 4) * 64 : 2816 + (wid - 6) * 64);
        __builtin_amdgcn_global_load_lds((const unsigned*)(src + lane), (PG8_LAS unsigned*)(sp + wid * 256), 4, 0, 0);
    }
    __device__ __forceinline__ void operator()(const f32x4 (&acc)[2][2][4][2], const Unit& u, int wr, int wc, int fr, int fq, PG8_LAS unsigned char* sp) const {
        const int row0 = u.pm * BM + wr * 64 + fr; const int col0 = u.pn * HALF + wc * 32 + 8 * fq;
        const PG8_LAS float* spf = (const PG8_LAS float*)sp;
        const f32x4 bg0 = *(const PG8_LAS f32x4*)(spf + 256 + wc * 32 + 8 * fq), bg1 = *(const PG8_LAS f32x4*)(spf + 256 + wc * 32 + 8 * fq + 4);
        const f32x4 bu0 = *(const PG8_LAS f32x4*)(spf + 384 + wc * 32 + 8 * fq), bu1 = *(const PG8_LAS f32x4*)(spf + 384 + wc * 32 + 8 * fq + 4);
#pragma unroll
        for (int ai = 0; ai < 2; ++ai)
#pragma unroll
            for (int m = 0; m < 4; ++m) { const int row = row0 + ai * HALF + m * 16; const float rr = 1.0f / sqrtf(spf[ai * HALF + wr * 64 + m * 16 + fr] * (1.0f / 1024.0f) + EPI_EPS);
                const f32x4 g0 = acc[ai][0][m][0] * rr + bg0, g1 = acc[ai][0][m][1] * rr + bg1, u0 = acc[ai][1][m][0] * rr + bu0, u1 = acc[ai][1][m][1] * rr + bu1;
                u32x4 w; w.x = cvt_pk_bf16(silu_mul(g0[0], u0[0]), silu_mul(g0[1], u0[1])); w.y = cvt_pk_bf16(silu_mul(g0[2], u0[2]), silu_mul(g0[3], u0[3]));
                w.z = cvt_pk_bf16(silu_mul(g1[0], u1[0]), silu_mul(g1[1], u1[1])); w.w = cvt_pk_bf16(silu_mul(g1[2], u1[2]), silu_mul(g1[3], u1[3]));
                *(u32x4*)(O + (size_t)row * ldc + col0) = w; }
    }
};
template <bool PRE, bool ROPE> struct EpiSplit2 {
    static constexpr bool PERM = true, AFTER_DRAIN = false;
    bf16_t* p0; bf16_t* p1; bf16_t* p2; int ld0, ld1, ld2, n0, n1;
    const float* rowss; const float* bias; int N;
    const float* qgain; const float* kgain; float qscale; const float* ropetab; PG8_LAS float* xch;
    __device__ __forceinline__ void prefetch(PG8_LAS unsigned char* sp, const Unit& u, int wid, int lane) const {
        if (PRE) { const int seq = (u.pm < 256) ? (u.pm >> 3) : 32;
            const float* src = (wid < 4) ? rowss + u.pm * BM + wid * 64 : bias + (size_t)seq * N + u.pn * BM + (wid - 4) * 64;
            __builtin_amdgcn_global_load_lds((const unsigned*)(src + lane), (PG8_LAS unsigned*)(sp + wid * 256), 4, 0, 0); }
    }
    __device__ __forceinline__ void operator()(f32x4 (&acc)[2][2][4][2], const Unit& u, int wr, int wc, int fr, int fq, PG8_LAS unsigned char* sp) const {
        bf16_t* base; int ldc, colt;
        if (u.pn < n0) { base = p0; ldc = ld0; colt = u.pn * BM; }
        else if (u.pn < n1) { base = p1; ldc = ld1; colt = (u.pn - n0) * BM; }
        else { base = p2; ldc = ld2; colt = (u.pn - n1) * BM; }
        const bool isv = (u.pn >= n1), isq = (u.pn < n0);
        const int wid = wr * 4 + wc;
        const int row0 = u.pm * BM + wr * 64 + fr; const int col0 = colt + wc * 32 + 8 * fq;
        if (PRE) { const PG8_LAS float* spf = (const PG8_LAS float*)sp; const PG8_LAS float* bp = spf + 256 + wc * 32 + 8 * fq;
            const f32x4 b00 = *(const PG8_LAS f32x4*)(bp), b01 = *(const PG8_LAS f32x4*)(bp + 4), b10 = *(const PG8_LAS f32x4*)(bp + HALF), b11 = *(const PG8_LAS f32x4*)(bp + HALF + 4);
#pragma unroll
            for (int ai = 0; ai < 2; ++ai)
#pragma unroll
                for (int m = 0; m < 4; ++m) { const float rr = 1.0f / sqrtf(spf[ai * HALF + wr * 64 + m * 16 + fr] * (1.0f / 1024.0f) + EPI_EPS);
                    acc[ai][0][m][0] = acc[ai][0][m][0] * rr + b00; acc[ai][0][m][1] = acc[ai][0][m][1] * rr + b01; acc[ai][1][m][0] = acc[ai][1][m][0] * rr + b10; acc[ai][1][m][1] = acc[ai][1][m][1] * rr + b11; } }
        float part[16];
        if (!isv) {
#pragma unroll
            for (int ai = 0; ai < 2; ++ai)
#pragma unroll
                for (int m = 0; m < 4; ++m)
#pragma unroll
                    for (int bj = 0; bj < 2; ++bj) { const f32x4 a = acc[ai][bj][m][0], b = acc[ai][bj][m][1];
                        float s = (a[0] * a[0] + a[1] * a[1]) + (a[2] * a[2] + a[3] * a[3]) + (b[0] * b[0] + b[1] * b[1]) + (b[2] * b[2] + b[3] * b[3]);
                        s += __shfl_xor(s, 16); s += __shfl_xor(s, 32); const int idx = (ai * 4 + m) * 2 + bj; part[idx] = s;
                        if (fq == 0) xch[wid * 256 + idx * 16 + fr] = s; }
        }
        asm volatile("s_waitcnt lgkmcnt(0)" ::: "memory"); __builtin_amdgcn_s_barrier(); asm volatile("" ::: "memory");
        if (!isv) {
            const float* gp = (isq ? qgain : kgain) + 32 * (wc & 1) + 8 * fq; const float gs = isq ? qscale : 1.0f;
            const f32x4 gl0 = *(const f32x4*)(gp) * gs, gl1 = *(const f32x4*)(gp + 4) * gs;
#pragma unroll
            for (int ai = 0; ai < 2; ++ai)
#pragma unroll
                for (int m = 0; m < 4; ++m) { const int row = row0 + ai * HALF + m * 16;
                    f32x4 cs0 = {1.f, 0.f, 1.f, 0.f}, cs1 = {1.f, 0.f, 1.f, 0.f};
                    if (ROPE) { const int t = (row < 65536) ? (row & 2047) : (row - 65536); const int pos = (wc & 1) ? (t & 63) : (t >> 6);
                        const float* tp = ropetab + (size_t)(pos * 16 + 4 * fq) * 2; cs0 = *(const f32x4*)(tp); cs1 = *(const f32x4*)(tp + 4); }
                    bf16_t* rowp = base + (size_t)row * ldc + col0;
#pragma unroll
                    for (int bj = 0; bj < 2; ++bj) { const int idx = (ai * 4 + m) * 2 + bj;
                        const float tot = part[idx] + xch[(wid ^ 1) * 256 + idx * 16 + fr]; const float rinv = 1.0f / sqrtf(tot * (1.0f / 64.0f) + EPI_EPS);
                        f32x4 v0 = acc[ai][bj][m][0] * rinv * gl0, v1 = acc[ai][bj][m][1] * rinv * gl1;
                        if (ROPE) { const f32x4 a = v0, b = v1;
                            v0[0] = a[0] * cs0[0] - a[1] * cs0[1]; v0[1] = a[0] * cs0[1] + a[1] * cs0[0]; v0[2] = a[2] * cs0[2] - a[3] * cs0[3]; v0[3] = a[2] * cs0[3] + a[3] * cs0[2];
                            v1[0] = b[0] * cs1[0] - b[1] * cs1[1]; v1[1] = b[0] * cs1[1] + b[1] * cs1[0]; v1[2] = b[2] * cs1[2] - b[3] * cs1[3]; v1[3] = b[2] * cs1[3] + b[3] * cs1[2]; }
                        u32x4 w; w.x = cvt_pk_bf16(v0[0], v0[1]); w.y = cvt_pk_bf16(v0[2], v0[3]); w.z = cvt_pk_bf16(v1[0], v1[1]); w.w = cvt_pk_bf16(v1[2], v1[3]);
                        *(u32x4*)(rowp + bj * HALF) = w; } }
        } else {
#pragma unroll
            for (int ai = 0; ai < 2; ++ai)
#pragma unroll
                for (int m = 0; m < 4; ++m) { bf16_t* rowp = base + (size_t)(row0 + ai * HALF + m * 16) * ldc + col0;
#pragma unroll
                    for (int bj = 0; bj < 2; ++bj) { const f32x4 v0 = acc[ai][bj][m][0], v1 = acc[ai][bj][m][1];
                        u32x4 w; w.x = cvt_pk_bf16(v0[0], v0[1]); w.y = cvt_pk_bf16(v0[2], v0[3]); w.z = cvt_pk_bf16(v1[0], v1[1]); w.w = cvt_pk_bf16(v1[2], v1[3]);
                        *(u32x4*)(rowp + bj * HALF) = w; } }
        }
    }
};
template <class Epi, class Sched, bool ALIGN_EPI = false, bool SP2 = false>
__device__ __forceinline__ void gemm_phase(PG8_LAS unsigned char* lds, const Gemm g, const Sched& S, const Epi& E) {
    int tid_ = threadIdx.x; asm volatile("" : "+v"(tid_));
    const int tid = tid_, wid = __builtin_amdgcn_readfirstlane(tid >> 6), lane = tid & 63, wr = wid >> 2, wc = wid & 3, fr = lane & 15, fq = lane >> 4;
    const int K = g.K, nt = K / BK;
    unsigned voffA[2], voffB[2];
#pragma unroll
    for (int i = 0; i < 2; ++i) { int R, C; stage_rc(tid * 16 + i * 8192, R, C); const int Rb = Epi::PERM ? ((R & ~31) + perm32(R & 31)) : R;
        voffA[i] = (unsigned)(R * K + C) * 2u; voffB[i] = (unsigned)(Rb * K + C) * 2u; }
    const size_t kstep = (size_t)(BK * 2);
    const size_t hstep = (size_t)HALF * K * 2;
    const size_t tstep = 2 * hstep;
    const unsigned ldsw = (unsigned)wid * 1024u;
    const int aoff = lds_byte(wr * 64 + fr, fq * 8), boff = lds_byte(wc * 32 + fr, fq * 8);
#define PG8_SA(b, h) (((b) * 2 + (h)) * HTB)
#define PG8_SB(b, h) ((4 + (b) * 2 + (h)) * HTB)
#define PG8_STAGE(bufoff, gbase, voff) do { _Pragma("unroll") for (int _i = 0; _i < 2; ++_i) \
        __builtin_amdgcn_global_load_lds((const unsigned*)((const char*)(gbase) + (voff)[_i]), (PG8_LAS unsigned*)(lds + (bufoff) + ldsw + _i * 8192), 16, 0, 0); } while (0)
#define PG8_LDA(dst, b, h) do { _Pragma("unroll") for (int m = 0; m < 4; ++m) _Pragma("unroll") for (int k = 0; k < 2; ++k) dst[m][k] = *(const PG8_LAS bf16x8*)(lds + PG8_SA(b, h) + aoff + m * 2048 + k * 1024); } while (0)
#define PG8_LDB(dst, b, h) do { _Pragma("unroll") for (int n = 0; n < 2; ++n) _Pragma("unroll") for (int k = 0; k < 2; ++k) dst[n][k] = *(const PG8_LAS bf16x8*)(lds + PG8_SB(b, h) + boff + n * 2048 + k * 1024); } while (0)
#define PG8_MMA(ai, bj, At, Bt) do { __builtin_amdgcn_s_setprio(1); _Pragma("unroll") for (int m = 0; m < 4; ++m) _Pragma("unroll") for (int n = 0; n < 2; ++n) _Pragma("unroll") for (int k = 0; k < 2; ++k) \
        acc[ai][bj][m][n] = __builtin_amdgcn_mfma_f32_16x16x32_bf16(Bt[n][k], At[m][k], acc[ai][bj][m][n], 0, 0, 0); __builtin_amdgcn_s_setprio(0); } while (0)
#define PG8_WAIT_V(n) asm volatile("s_waitcnt vmcnt(" #n ")" ::: "memory")
#define PG8_WAIT_L(n) asm volatile("s_waitcnt lgkmcnt(" #n ")" ::: "memory")
#define PG8_BAR __builtin_amdgcn_s_barrier()
#define PG8_SCHED __builtin_amdgcn_sched_barrier(0)
    Unit cur, nxt; int ui = 0;
    if (!S.next(0, cur)) return;
    f32x4 acc[2][2][4][2];
#pragma unroll
    for (int a = 0; a < 2; ++a)
#pragma unroll
        for (int b = 0; b < 2; ++b)
#pragma unroll
            for (int m = 0; m < 4; ++m)
#pragma unroll
                for (int n = 0; n < 2; ++n) acc[a][b][m][n] = (f32x4){0.f, 0.f, 0.f, 0.f};
    bf16x8 At[4][2], B0[2][2], B1[2][2];
    const char* cA = (const char*)g.A + (size_t)cur.pm * tstep; const char* cB = (const char*)g.Bt + (size_t)cur.pn * tstep;
    S.a_ready(cur);
    if constexpr (SP2) {
        PG8_STAGE(PG8_SB(0, 0), cB, voffB); PG8_STAGE(PG8_SB(0, 1), cB + hstep, voffB); PG8_STAGE(PG8_SA(0, 0), cA, voffA); PG8_STAGE(PG8_SA(0, 1), cA + hstep, voffA);
        if (wr == 1) PG8_BAR;
        PG8_WAIT_V(2); PG8_BAR;
        PG8_STAGE(PG8_SB(1, 0), cB + kstep, voffB); PG8_STAGE(PG8_SA(1, 0), cA + kstep, voffA); PG8_STAGE(PG8_SB(1, 1), cB + hstep + kstep, voffB);
        PG8_WAIT_V(6); PG8_BAR;
    } else {
        PG8_STAGE(PG8_SB(0, 0), cB, voffB); PG8_STAGE(PG8_SA(0, 0), cA, voffA); PG8_STAGE(PG8_SB(0, 1), cB + hstep, voffB); PG8_STAGE(PG8_SA(0, 1), cA + hstep, voffA);
        if (wr == 1) PG8_BAR;
        PG8_WAIT_V(4); PG8_BAR;
        PG8_STAGE(PG8_SB(1, 0), cB + kstep, voffB); PG8_STAGE(PG8_SA(1, 0), cA + kstep, voffA); PG8_STAGE(PG8_SB(1, 1), cB + hstep + kstep, voffB);
        PG8_WAIT_V(6); PG8_BAR;
    }
    for (;;) {
        const bool has_next = S.next(ui + 1, nxt);
        const char* nA = has_next ? (const char*)g.A + (size_t)nxt.pm * tstep : cA; const char* nB = has_next ? (const char*)g.Bt + (size_t)nxt.pn * tstep : cB;
        for (int t = 0; t < nt; t += 2) {
            const bool last = (t == nt - 2);
            const char* a1 = cA + (size_t)(t + 1) * kstep;
            const char* a2 = last ? nA : cA + (size_t)(t + 2) * kstep; const char* b2 = last ? nB : cB + (size_t)(t + 2) * kstep;
            const char* a3 = a2 + kstep; const char* b3 = b2 + kstep;
            if (last && has_next) S.a_ready(nxt);
            if (last) E.prefetch(lds + 139264, cur, wid, lane);
            if constexpr (SP2) {
            PG8_LDB(B0, 0, 0); PG8_LDB(B1, 0, 1); PG8_SCHED; PG8_LDA(At, 0, 0); PG8_STAGE(PG8_SA(1, 1), a1 + hstep, voffA);
            PG8_WAIT_V(8); PG8_WAIT_L(0); PG8_BAR; PG8_MMA(0, 0, At, B0); PG8_MMA(0, 1, At, B1); PG8_BAR; PG8_SCHED;
            PG8_LDA(At, 0, 1); PG8_STAGE(PG8_SB(0, 0), b2, voffB); PG8_STAGE(PG8_SB(0, 1), b2 + hstep, voffB); PG8_STAGE(PG8_SA(0, 0), a2, voffA);
            PG8_WAIT_V(8); PG8_WAIT_L(0); PG8_BAR; PG8_MMA(1, 0, At, B0); PG8_MMA(1, 1, At, B1); PG8_BAR; PG8_SCHED;
            PG8_LDB(B0, 1, 0); PG8_LDB(B1, 1, 1); PG8_SCHED; PG8_LDA(At, 1, 0); PG8_STAGE(PG8_SA(0, 1), a2 + hstep, voffA);
            PG8_WAIT_V(8); PG8_WAIT_L(0); PG8_BAR; PG8_MMA(0, 0, At, B0); PG8_MMA(0, 1, At, B1); PG8_BAR; PG8_SCHED;
            PG8_LDA(At, 1, 1); PG8_STAGE(PG8_SB(1, 0), b3, voffB); PG8_STAGE(PG8_SB(1, 1), b3 + hstep, voffB); PG8_STAGE(PG8_SA(1, 0), a3, voffA);
            PG8_WAIT_V(8); PG8_WAIT_L(0); PG8_BAR; PG8_MMA(1, 0, At, B0); PG8_MMA(1, 1, At, B1); PG8_BAR; PG8_SCHED;
            } else {
            PG8_LDB(B0, 0, 0); PG8_SCHED; PG8_LDA(At, 0, 0); PG8_STAGE(PG8_SA(1, 1), a1 + hstep, voffA);
            PG8_WAIT_L(8); PG8_BAR; PG8_WAIT_L(0); PG8_MMA(0, 0, At, B0); PG8_BAR; PG8_SCHED;
            PG8_LDB(B1, 0, 1); PG8_STAGE(PG8_SB(0, 0), b2, voffB);
            PG8_BAR; PG8_WAIT_L(0); PG8_MMA(0, 1, At, B1); PG8_BAR;
            PG8_LDA(At, 0, 1); PG8_STAGE(PG8_SA(0, 0), a2, voffA);
            PG8_BAR; PG8_WAIT_L(0); PG8_MMA(1, 0, At, B0); PG8_BAR; PG8_SCHED;
            PG8_STAGE(PG8_SB(0, 1), b2 + hstep, voffB);
            PG8_WAIT_V(6); PG8_BAR; PG8_MMA(1, 1, At, B1); PG8_BAR;
            PG8_LDB(B0, 1, 0); PG8_SCHED; PG8_LDA(At, 1, 0); PG8_STAGE(PG8_SA(0, 1), a2 + hstep, voffA);
            PG8_WAIT_L(8); PG8_BAR; PG8_WAIT_L(0); PG8_MMA(0, 0, At, B0); PG8_BAR; PG8_SCHED;
            PG8_LDB(B1, 1, 1); PG8_STAGE(PG8_SB(1, 0), b3, voffB);
            PG8_BAR; PG8_WAIT_L(0); PG8_MMA(0, 1, At, B1); PG8_BAR;
            PG8_LDA(At, 1, 1); PG8_STAGE(PG8_SA(1, 0), a3, voffA);
            PG8_BAR; PG8_WAIT_L(0); PG8_MMA(1, 0, At, B0); PG8_BAR; PG8_SCHED;
            PG8_STAGE(PG8_SB(1, 1), b3 + hstep, voffB);
            PG8_WAIT_V(6); PG8_BAR; PG8_MMA(1, 1, At, B1); PG8_BAR;
            }
        }
        if constexpr (ALIGN_EPI) { if (wr == 0) PG8_BAR; }
        if constexpr (!Epi::AFTER_DRAIN) { E(acc, cur, wr, wc, fr, fq, lds + 139264); S.done(cur); }
        if (!has_next) break;
#pragma unroll
        for (int a = 0; a < 2; ++a)
#pragma unroll
            for (int b = 0; b < 2; ++b)
#pragma unroll
                for (int m = 0; m < 4; ++m)
#pragma unroll
                    for (int n = 0; n < 2; ++n) acc[a][b][m][n] = (f32x4){0.f, 0.f, 0.f, 0.f};
        cur = nxt; cA = nA; cB = nB; ++ui;
        if constexpr (ALIGN_EPI) { if (wr == 1) PG8_BAR; }
    }
    PG8_WAIT_V(0);
    if constexpr (!ALIGN_EPI) { if (wr == 0) PG8_BAR; }
    PG8_BAR;
    if constexpr (Epi::AFTER_DRAIN) { E.fused(acc, cur, wr, wc, fr, fq, lds, wid, lane); S.done(cur); }
#undef PG8_SA
#undef PG8_SB
#undef PG8_STAGE
#undef PG8_LDA
#undef PG8_LDB
#undef PG8_MMA
#undef PG8_WAIT_V
#undef PG8_WAIT_L
#undef PG8_BAR
#undef PG8_SCHED
}
}
#ifndef PG8_SP2
#define PG8_SP2 true
#endif
#ifndef PG8_ALIGN
#define PG8_ALIGN true
#endif
#include <hip/hip_bf16.h>
#include <cmath>
namespace attn_body {
using bf16=__hip_bfloat16;
using bf16x8=__attribute__((ext_vector_type(8)))short;
using s16x4=__attribute__((ext_vector_type(4)))short;
using f32x16=__attribute__((ext_vector_type(16)))float;
using u32x4=__attribute__((ext_vector_type(4)))unsigned;
constexpr int D=64;
constexpr int NW=8,QBLK=32,QB=QBLK*NW,KVBLK=64;
constexpr int ATTN_UNIT_ROWS=QB;
__device__ __forceinline__ int crow(int r,int hi){return (r&3)+8*(r>>2)+4*hi;}
#define SBAR() __builtin_amdgcn_sched_barrier(0)
constexpr int NSLOT=3, SLOTB=8192;
constexpr int LDS_K=0, LDS_V=NSLOT*SLOTB, LDS_WS=2*NSLOT*SLOTB, LDS_OST=LDS_WS+NW*64*4, LDS_BT=LDS_OST+NW*4096, LDS_BYTES=LDS_BT+768*4;
constexpr float C2=0.125f*1.4426950408889634f;
__device__ __forceinline__ void glds16(const void*gsrc,unsigned lds_dst){unsigned keep;
  asm volatile("s_mov_b32 %0, m0\n\ts_mov_b32 m0, %2\n\ts_nop 0\n\tglobal_load_lds_dwordx4 %1, off\n\ts_mov_b32 m0, %0":"=&s"(keep):"v"(gsrc),"s"(lds_dst):"memory");}
__device__ __forceinline__ void glds16s(const void*sbase,unsigned voff,unsigned lds_dst){unsigned keep;
  asm volatile("s_mov_b32 %0, m0\n\ts_mov_b32 m0, %3\n\ts_nop 0\n\tglobal_load_lds_dwordx4 %1, %2\n\ts_mov_b32 m0, %0":"=&s"(keep):"v"(voff),"s"(sbase),"s"(lds_dst):"memory");}
__device__ __forceinline__ float max3f(float a,float b,float c){float r;asm("v_max3_f32 %0, %1, %2, %3":"=v"(r):"v"(a),"v"(b),"v"(c));return r;}
__device__ __forceinline__ float max2f(float a,float b){float r;asm("v_max_f32_e32 %0, %1, %2":"=v"(r):"v"(a),"v"(b));return r;}
__device__ __forceinline__ float fadd_s(float a,float b){float r;asm("v_add_f32_e32 %0, %1, %2":"=v"(r):"v"(a),"v"(b));return r;}
__device__ __forceinline__ float fsub_s(float a,float b){float r;asm("v_sub_f32_e32 %0, %1, %2":"=v"(r):"v"(a),"v"(b));return r;}
typedef float f32x2_t __attribute__((ext_vector_type(2))); typedef __bf16 bf16x2_t __attribute__((ext_vector_type(2)));
__device__ __forceinline__ unsigned cvtpk_s(float lo,float hi){f32x2_t v={lo,hi};bf16x2_t b=__builtin_convertvector(v,bf16x2_t);return __builtin_bit_cast(unsigned,b);}
#define WAIT_BAR(N) asm volatile("s_waitcnt vmcnt(" #N ") lgkmcnt(0)\n\ts_barrier":::"memory")

__device__ __forceinline__ void qkt(f32x16&p0,f32x16&p1,const char*Kslot,const bf16x8*qr,const f32x16&negm,int r32,int hi){
  const char*kb=Kslot+hi*1024+r32*16;
  #pragma unroll
  for(int d0=0;d0<4;++d0){
    const bf16x8 b0=*reinterpret_cast<const bf16x8*>(kb+d0*2048);
    const bf16x8 b1=*reinterpret_cast<const bf16x8*>(kb+d0*2048+512);
    if(d0==0){p0=__builtin_amdgcn_mfma_f32_32x32x16_bf16(b0,qr[0],negm,0,0,0);p1=__builtin_amdgcn_mfma_f32_32x32x16_bf16(b1,qr[0],negm,0,0,0);}
    else{p0=__builtin_amdgcn_mfma_f32_32x32x16_bf16(b0,qr[d0],p0,0,0,0);p1=__builtin_amdgcn_mfma_f32_32x32x16_bf16(b1,qr[d0],p1,0,0,0);}}
}
typedef __attribute__((address_space(3))) const char* lds_cptr;
typedef short v4i16_t __attribute__((ext_vector_type(4)));
__device__ __forceinline__ void kload8(bf16x8*kf,lds_cptr kp){
  kf[0]=*(const __attribute__((address_space(3))) bf16x8*)(kp);      kf[1]=*(const __attribute__((address_space(3))) bf16x8*)(kp+512);
  kf[2]=*(const __attribute__((address_space(3))) bf16x8*)(kp+2048); kf[3]=*(const __attribute__((address_space(3))) bf16x8*)(kp+2560);
  kf[4]=*(const __attribute__((address_space(3))) bf16x8*)(kp+4096); kf[5]=*(const __attribute__((address_space(3))) bf16x8*)(kp+4608);
  kf[6]=*(const __attribute__((address_space(3))) bf16x8*)(kp+6144); kf[7]=*(const __attribute__((address_space(3))) bf16x8*)(kp+6656);
}
__device__ __forceinline__ void kload2(bf16x8*kf,lds_cptr kp,int j){ kf[2*j]=*(const __attribute__((address_space(3))) bf16x8*)(kp+j*2048); kf[2*j+1]=*(const __attribute__((address_space(3))) bf16x8*)(kp+j*2048+512); }
__device__ __forceinline__ s16x4 vtr(lds_cptr p){ return __builtin_bit_cast(s16x4,__builtin_amdgcn_ds_read_tr16_b64_v4i16((__attribute__((address_space(3))) v4i16_t*)p)); }
__device__ __forceinline__ float rowmax(const f32x16&p0,const f32x16&p1){
  float a=max3f(p0[0],p0[1],p1[0]),b=max3f(p0[2],p0[3],p1[1]);a=max3f(a,p1[2],p1[3]);
  #pragma unroll
  for(int r=4;r<16;r+=4){a=max3f(a,p0[r],p0[r+1]);b=max3f(b,p0[r+2],p0[r+3]);a=max3f(a,p1[r],p1[r+1]);b=max3f(b,p1[r+2],p1[r+3]);}
  const float m=max2f(a,b);
  auto rr=__builtin_amdgcn_permlane32_swap(__float_as_uint(m),__float_as_uint(m),false,false);
  return max2f(__uint_as_float(rr[0]),__uint_as_float(rr[1]));
}
__device__ __forceinline__ void pv(f32x16*o,int vb,bf16x8 pa0,bf16x8 pa1,bf16x8 pa2,bf16x8 pa3){
  #pragma unroll
  for(int d0=0;d0<2;++d0){s16x4 lo[4],hi[4];
    #pragma unroll
    for(int ks=0;ks<4;++ks){
      asm volatile("ds_read_b64_tr_b16 %0,%1 offset:%c2":"=&v"(lo[ks]):"v"(vb),"i"(d0*4096+ks*1024):"memory");
      asm volatile("ds_read_b64_tr_b16 %0,%1 offset:%c2":"=&v"(hi[ks]):"v"(vb),"i"(d0*4096+ks*1024+512):"memory");}
    asm volatile("s_waitcnt lgkmcnt(0)":::"memory");SBAR();
    #define PK(k) (bf16x8){lo[k][0],lo[k][1],lo[k][2],lo[k][3],hi[k][0],hi[k][1],hi[k][2],hi[k][3]}
    o[d0]=__builtin_amdgcn_mfma_f32_32x32x16_bf16(pa0,PK(0),o[d0],0,0,0);
    o[d0]=__builtin_amdgcn_mfma_f32_32x32x16_bf16(pa1,PK(1),o[d0],0,0,0);
    o[d0]=__builtin_amdgcn_mfma_f32_32x32x16_bf16(pa2,PK(2),o[d0],0,0,0);
    o[d0]=__builtin_amdgcn_mfma_f32_32x32x16_bf16(pa3,PK(3),o[d0],0,0,0);
    #undef PK
  }
}

#ifndef ATTN_STORE16
#define ATTN_STORE16(p,v) (*(u32x4*)(p)=(v))
#endif
template<int VH> struct AttnLds { static constexpr int KSL=8192, VSL=8192*VH, L_K=0, L_V=4*KSL, L_WS=L_V+3*VSL, L_BT=L_WS+NW*64*4, BYTES=L_BT+768*4; };
template<int VH,bool HAS_BIAS,int MODE> __device__ __forceinline__ void attn_unit2(const bf16*Qb,int qp,const bf16*__restrict__ Kb,int kp,const bf16*__restrict__ Vb,int vp,bf16*Ob,int op,int q0,int NT,const float*relb,char*shm,float lam,const float*subg,float gmul){
  typedef AttnLds<VH> LM; constexpr int KSL=LM::KSL, VSL=LM::VSL;
  int tid_=threadIdx.x; asm volatile("":"+v"(tid_));
  const int tid=tid_,lane=tid&63,r32=lane&31,hi=lane>>5; const int wid=__builtin_amdgcn_readfirstlane(tid>>6);
  const bf16*Qw=Qb+(long)(q0+wid*QBLK)*qp;
  const unsigned lds0=(unsigned)(uintptr_t)shm;
  const lds_cptr shm3=(lds_cptr)shm;
  float*wsf=(float*)(shm+LM::L_WS)+wid*64;
  const unsigned ksrc=(unsigned)(lane*kp+wid*8)*2u;
  const unsigned vsrc=(unsigned)((16*(wid&3)+(lane>>2))*vp+(wid>>2)*32+(lane&3)*8)*2u;
  const unsigned kdst=lds0+LM::L_K+wid*1024, vdst=lds0+LM::L_V+wid*1024;
  #define DMA_K(t,slot) glds16s(Kb+(long)(t)*KVBLK*kp,ksrc,(unsigned)__builtin_amdgcn_readfirstlane(kdst+(slot)))
  #define DMA_V(t,slot) do{ glds16s(Vb+(long)(t)*KVBLK*vp,vsrc,(unsigned)__builtin_amdgcn_readfirstlane(vdst+(slot))); \
      if(VH==2) glds16s(Vb+(long)(t)*KVBLK*vp+64,vsrc,(unsigned)__builtin_amdgcn_readfirstlane(vdst+(slot)+8192)); }while(0)
  const int vb0=(int)(lds0+LM::L_V)+((lane>>4)&1)*32+(lane&3)*8+(4*hi+((lane&15)>>2))*64;
  const lds_cptr kp0=shm3+LM::L_K+hi*1024+r32*16;
  const lds_cptr vp0=shm3+LM::L_V+((lane>>4)&1)*32+(lane&3)*8+(4*hi+((lane&15)>>2))*64;
  const int qw_=q0+32*wid; const int tn0=HAS_BIAS?(qw_>=90?((qw_-90)>>6):0):0, tn1=HAS_BIAS?(((qw_+185)>>6)<NT?((qw_+185)>>6):NT):0;
  float cb=0.f,ca=0.f;
  typedef __attribute__((address_space(3))) float lds_f32;
  typedef __attribute__((address_space(3))) char* lds_ptr_;
  lds_f32* btab=(lds_f32*)((lds_ptr_)shm)+LM::L_BT/4;
  if(HAS_BIAS){ const float L2E=1.4426950408889634f; cb=L2E*relb[15*8]; ca=L2E*relb[31*8];
    for(int i=tid;i<768;i+=512){ const int rel=i-384; const int n=rel<0?-rel:rel; int bk=n<8?n:(8+(31-__builtin_clz((unsigned)(n*n)))-6); if(n>=8&&bk>15)bk=15; if(rel>0)bk+=16; btab[i]=L2E*relb[bk*8]; } }
  const int lanebias=-q0-32*wid-r32+4*hi+384;
  #define CREG(tt) (HAS_BIAS?(((tt)<tn0)?cb:(((tt)<tn1)?0.f:ca)):0.f)
  #define BIASADD(P0,P1,t) do{ if(HAS_BIAS&&(t)>=tn0&&(t)<tn1){ const lds_f32*bp_=btab+(64*(t)+lanebias); \
    _Pragma("unroll") for(int r=0;r<16;++r){ P0[r]+=bp_[(r&3)+8*(r>>2)]; P1[r]+=bp_[(r&3)+8*(r>>2)+32]; } } }while(0)
  #define RSCALE(t) do{ if(HAS_BIAS&&((t)==tn0||(t)==tn1)){ const float f_=__builtin_amdgcn_exp2f(CREG((t)-1)-CREG(t)); l_reg*=f_; \
    _Pragma("unroll") for(int d_=0;d_<2*VH;++d_) _Pragma("unroll") for(int r=0;r<16;++r)o[d_][r]*=f_; } }while(0)
  DMA_K(0,0);DMA_V(0,0);DMA_K(1,KSL);
  bf16x8 qr[4];
  #pragma unroll
  for(int d0=0;d0<4;++d0)qr[d0]=*reinterpret_cast<const bf16x8*>(&Qw[(long)r32*qp+d0*16+hi*8]);
  DMA_K(2,2*KSL);
  float l_reg=0.f;f32x16 o[2*VH];
  #pragma unroll
  for(int d_=0;d_<2*VH;++d_)o[d_]=f32x16{};
  const f32x16 zero16=f32x16{};
  f32x16 pA0,pA1,pB0,pB1; bf16x8 kf[4];
  int sv_prev=0,sv_cur=0,sv_next=VSL;
  #define ROT() do{sv_prev=sv_cur;sv_cur=sv_next;sv_next=(sv_next==2*VSL)?0:sv_next+VSL;}while(0)
  #define KLD(p) (*(const __attribute__((address_space(3))) bf16x8*)(p))
  #define KPRE(tn) do{ const lds_cptr kn_=kp0+(((tn)&3)*KSL); kf[0]=KLD(kn_); kf[1]=KLD(kn_+512); kf[2]=KLD(kn_+2048); kf[3]=KLD(kn_+2560); }while(0)
  if(VH==1){WAIT_BAR(3);}else{WAIT_BAR(4);}
  qkt(pA0,pA1,shm+LM::L_K,qr,zero16,r32,hi);
  BIASADD(pA0,pA1,0);
  _Pragma("unroll") for(int r=0;r<16;++r){pA0[r]=__builtin_amdgcn_exp2f(pA0[r]);pA1[r]=__builtin_amdgcn_exp2f(pA1[r]);}
  WAIT_BAR(0);
  DMA_K(3,3*KSL);DMA_V(1,VSL);
  ROT();
  KPRE(1);
  s16x4 vlo[8],vhi[8]; u32x4 pw0,pw1,pw2,pw3;
  #define PKW(P,B) cvtpk_s(P[B],P[B+1])
  #define PAF(k) __builtin_bit_cast(bf16x8,pw##k)
  #define VFR(i) (bf16x8){vlo[i][0],vlo[i][1],vlo[i][2],vlo[i][3],vhi[i][0],vhi[i][1],vhi[i][2],vhi[i][3]}
  #define PIN(x) asm volatile("":"+v"(x))
  #define MF(a,b,c) __builtin_amdgcn_mfma_f32_32x32x16_bf16(a,b,c,0,0,0)
  #define GAPA(MFX,A0,A1,A2,A3,W0,W1,PW) do{ MFX; sacc+=A0; sacc+=A1; sacc+=A2; sacc+=A3; PIN(sacc); W0; W1; PIN(PW); SBAR(); }while(0)
  #define EX(v) __builtin_amdgcn_exp2f(v)
  #define GAPB4(MFX,X,B) do{ MFX; X[B]=EX(X[B]); X[B+1]=EX(X[B+1]); X[B+2]=EX(X[B+2]); X[B+3]=EX(X[B+3]); PIN(X); SBAR(); }while(0)
  #define GAPB2(MFX,X,B) do{ MFX; X[B]=EX(X[B]); X[B+1]=EX(X[B+1]); PIN(X); SBAR(); }while(0)
  #define VRD(i,hv) do{ vlo[i]=vtr(vp_+((hv)*8192+((i)>>2)*4096+((i)&3)*1024)); vhi[i]=vtr(vp_+((hv)*8192+((i)>>2)*4096+((i)&3)*1024+512)); }while(0)
  #define STEP(C0,C1,P0,P1,t,GK,GV,GL) do{ SBAR(); \
    const lds_cptr vp_=vp0+sv_prev; const lds_cptr kq_=kp0+(((t)&3)*KSL); \
    VRD(0,0); SBAR(); float sacc=(P0[0]+P0[1]); \
    GAPA(C0=MF(kf[0],qr[0],zero16), P0[2],P0[3],P0[4],P0[5],     pw0[0]=PKW(P0,0), pw0[1]=PKW(P0,2), pw0); \
    VRD(4,0); SBAR(); GAPA(C1=MF(kf[1],qr[0],zero16), P0[6],P0[7],P0[8],P0[9],     pw0[2]=PKW(P0,4), pw0[3]=PKW(P0,6), pw0); \
    kf[0]=KLD(kq_+4096); kf[1]=KLD(kq_+4608); SBAR(); \
    VRD(1,0); SBAR(); GAPA(C0=MF(kf[2],qr[1],C0),   P0[10],P0[11],P0[12],P0[13], pw1[0]=PKW(P0,8), pw1[1]=PKW(P0,10), pw1); \
    VRD(5,0); SBAR(); GAPA(C1=MF(kf[3],qr[1],C1),   P0[14],P0[15],P1[0],P1[1],   pw1[2]=PKW(P0,12),pw1[3]=PKW(P0,14), pw1); \
    kf[2]=KLD(kq_+6144); kf[3]=KLD(kq_+6656); SBAR(); \
    VRD(2,0); SBAR(); GAPA(C0=MF(kf[0],qr[2],C0),   P1[2],P1[3],P1[4],P1[5],     pw2[0]=PKW(P1,0), pw2[1]=PKW(P1,2), pw2); \
    VRD(6,0); SBAR(); GAPA(C1=MF(kf[1],qr[2],C1),   P1[6],P1[7],P1[8],P1[9],     pw2[2]=PKW(P1,4), pw2[3]=PKW(P1,6), pw2); \
    VRD(3,0); SBAR(); GAPA(C0=MF(kf[2],qr[3],C0),   P1[10],P1[11],P1[12],P1[13], pw3[0]=PKW(P1,8), pw3[1]=PKW(P1,10), pw3); \
    VRD(7,0); SBAR(); GAPA(C1=MF(kf[3],qr[3],C1),   P1[14],P1[15],0.f,0.f,       pw3[2]=PKW(P1,12),pw3[3]=PKW(P1,14), pw3); \
    l_reg+=sacc; \
    if(GK){DMA_K((t)+3,(((t)+3)&3)*KSL);} if(GV){DMA_V((t)+1,sv_next);} \
    BIASADD(C0,C1,t); SBAR(); \
    if(VH==1){ \
      GAPB4(o[0]=MF(PAF(0),VFR(0),o[0]), C0,0); \
      GAPB4(o[1]=MF(PAF(0),VFR(4),o[1]), C0,4); \
      GAPB4(o[0]=MF(PAF(1),VFR(1),o[0]), C0,8); \
      GAPB4(o[1]=MF(PAF(1),VFR(5),o[1]), C0,12); \
      if(GL){ KPRE((t)+1); SBAR(); } \
      GAPB4(o[0]=MF(PAF(2),VFR(2),o[0]), C1,0); \
      GAPB4(o[1]=MF(PAF(2),VFR(6),o[1]), C1,4); \
      GAPB4(o[0]=MF(PAF(3),VFR(3),o[0]), C1,8); \
      GAPB4(o[1]=MF(PAF(3),VFR(7),o[1]), C1,12); \
    } else { \
      GAPB2(o[0]=MF(PAF(0),VFR(0),o[0]), C0,0);  VRD(0,1); SBAR(); \
      GAPB2(o[1]=MF(PAF(0),VFR(4),o[1]), C0,2);  VRD(4,1); SBAR(); \
      GAPB2(o[0]=MF(PAF(1),VFR(1),o[0]), C0,4);  VRD(1,1); SBAR(); \
      GAPB2(o[1]=MF(PAF(1),VFR(5),o[1]), C0,6);  VRD(5,1); SBAR(); \
      GAPB2(o[0]=MF(PAF(2),VFR(2),o[0]), C0,8);  VRD(2,1); SBAR(); \
      GAPB2(o[1]=MF(PAF(2),VFR(6),o[1]), C0,10); VRD(6,1); SBAR(); \
      GAPB2(o[0]=MF(PAF(3),VFR(3),o[0]), C0,12); VRD(3,1); SBAR(); \
      GAPB2(o[1]=MF(PAF(3),VFR(7),o[1]), C0,14); VRD(7,1); SBAR(); \
      if(GL){ KPRE((t)+1); SBAR(); } \
      GAPB2(o[2*(VH-1)]=MF(PAF(0),VFR(0),o[2*(VH-1)]), C1,0); \
      GAPB2(o[2*(VH-1)+1]=MF(PAF(0),VFR(4),o[2*(VH-1)+1]), C1,2); \
      GAPB2(o[2*(VH-1)]=MF(PAF(1),VFR(1),o[2*(VH-1)]), C1,4); \
      GAPB2(o[2*(VH-1)+1]=MF(PAF(1),VFR(5),o[2*(VH-1)+1]), C1,6); \
      GAPB2(o[2*(VH-1)]=MF(PAF(2),VFR(2),o[2*(VH-1)]), C1,8); \
      GAPB2(o[2*(VH-1)+1]=MF(PAF(2),VFR(6),o[2*(VH-1)+1]), C1,10); \
      GAPB2(o[2*(VH-1)]=MF(PAF(3),VFR(3),o[2*(VH-1)]), C1,12); \
      GAPB2(o[2*(VH-1)+1]=MF(PAF(3),VFR(7),o[2*(VH-1)+1]), C1,14); \
    } \
    }while(0)
  #define WAITFULL() do{ if(VH==1){WAIT_BAR(2);}else{WAIT_BAR(3);} }while(0)
  #define ENDW(tt) do{ if((tt)+3<NT){WAITFULL();} else if((tt)+2<NT){ if(VH==1){WAIT_BAR(1);}else{WAIT_BAR(2);} } else {WAIT_BAR(0);} }while(0)
  int t=1;
  for(;t+5<NT;t+=2){
    STEP(pB0,pB1,pA0,pA1,t,true,true,true);     WAITFULL(); RSCALE(t);   ROT();
    STEP(pA0,pA1,pB0,pB1,t+1,true,true,true);   WAITFULL(); RSCALE(t+1); ROT();
  }
  for(;t+1<NT;t+=2){
    STEP(pB0,pB1,pA0,pA1,t,(t+3<NT),(t+1<NT),(t+1<NT));       ENDW(t);   RSCALE(t);   ROT();
    STEP(pA0,pA1,pB0,pB1,t+1,(t+4<NT),(t+2<NT),(t+2<NT));     ENDW(t+1); RSCALE(t+1); ROT();
  }
  STEP(pB0,pB1,pA0,pA1,NT-1,false,false,false); RSCALE(NT-1);
  { float sacc=pB0[0]+pB0[1]; _Pragma("unroll") for(int r=2;r<16;++r)sacc+=pB0[r]; _Pragma("unroll") for(int r=0;r<16;++r)sacc+=pB1[r]; l_reg+=sacc;
    pw0=(u32x4){PKW(pB0,0),PKW(pB0,2),PKW(pB0,4),PKW(pB0,6)};pw1=(u32x4){PKW(pB0,8),PKW(pB0,10),PKW(pB0,12),PKW(pB0,14)};pw2=(u32x4){PKW(pB1,0),PKW(pB1,2),PKW(pB1,4),PKW(pB1,6)};pw3=(u32x4){PKW(pB1,8),PKW(pB1,10),PKW(pB1,12),PKW(pB1,14)};
    SBAR(); pv(o,vb0+sv_cur,PAF(0),PAF(1),PAF(2),PAF(3)); if(VH==2){ SBAR(); pv(o+2*(VH-1),vb0+sv_cur+8192,PAF(0),PAF(1),PAF(2),PAF(3)); } }
  #undef PKW
  #undef PAF
  #undef VFR
  #undef PIN
  #undef MF
  #undef GAPA
  #undef GAPB4
  #undef GAPB2
  #undef EX
  #undef VRD
  #undef STEP
  #undef ENDW
  #undef WAITFULL
  #undef KLD
  #undef KPRE
  {auto rr=__builtin_amdgcn_permlane32_swap(__float_as_uint(l_reg),__float_as_uint(l_reg),false,false);l_reg=__uint_as_float(rr[0])+__uint_as_float(rr[1]);}
  if(hi==0)wsf[32+r32]=l_reg;
  asm volatile("s_waitcnt lgkmcnt(0)\n\ts_barrier":::"memory");
  float rli[16];
  #pragma unroll
  for(int r=0;r<16;++r)rli[r]=__builtin_amdgcn_rcpf(wsf[32+crow(r,hi)]);
  bf16*Ow=Ob+(long)(q0+wid*QBLK)*op;
  typedef __attribute__((address_space(3))) unsigned lds_u32;
  lds_u32* park=(lds_u32*)((lds_ptr_)shm+LM::BYTES)+tid;
  if(MODE==1){
    #pragma unroll
    for(int d0=0;d0<2*VH;++d0)
      #pragma unroll
      for(int r=0;r<16;r+=2)park[(d0*8+(r>>1))*512]=cvtpk_s(o[d0][r]*rli[r],o[d0][r+1]*rli[r+1]);
  } else {
    if(MODE==2){
      #pragma unroll
      for(int d0=0;d0<2*VH;++d0)
        #pragma unroll
        for(int r=0;r<16;r+=2){ const unsigned w_=park[(d0*8+(r>>1))*512];
          o[d0][r]=__uint_as_float(w_<<16)-lam*(o[d0][r]*rli[r]); o[d0][r+1]=__uint_as_float(w_&0xffff0000u)-lam*(o[d0][r+1]*rli[r+1]); }
      float gsub[2*VH];
      #pragma unroll
      for(int d0=0;d0<2*VH;++d0)gsub[d0]=subg[d0*32+r32]*gmul;
      #pragma unroll
      for(int r=0;r<16;++r){ float ss=0.f;
        #pragma unroll
        for(int d0=0;d0<2*VH;++d0)ss+=o[d0][r]*o[d0][r];
        ss+=__shfl_xor(ss,1);ss+=__shfl_xor(ss,2);ss+=__shfl_xor(ss,4);ss+=__shfl_xor(ss,8);ss+=__shfl_xor(ss,16);
        const float rs=1.0f/sqrtf(ss*(1.0f/(64.f*VH))+1e-6f);
        #pragma unroll
        for(int d0=0;d0<2*VH;++d0)o[d0][r]=o[d0][r]*rs*gsub[d0];
        rli[r]=1.0f; }
    }
    { bf16*stg=(bf16*)(shm)+wid*(2048*VH);
      #pragma unroll
      for(int r=0;r<16;++r){const int orow=crow(r,hi);
        #pragma unroll
        for(int d0=0;d0<2*VH;++d0)stg[orow*(64*VH)+d0*32+r32]=__float2bfloat16(o[d0][r]*rli[r]);}
      asm volatile("s_waitcnt lgkmcnt(0)":::"memory");
      #pragma unroll
      for(int i=0;i<4*VH;++i){const int row=(VH==1)?(i*8+(lane>>3)):(i*4+(lane>>4)),ch=(VH==1)?(lane&7):(lane&15); const u32x4 v=*(const u32x4*)(stg+row*(64*VH)+ch*8); ATTN_STORE16(Ow+(long)row*op+ch*8,v);} }
  }
  asm volatile("s_waitcnt lgkmcnt(0)\n\ts_barrier":::"memory");
  #undef DMA_K
  #undef DMA_V
  #undef BIASADD
  #undef CREG
  #undef RSCALE
  #undef ROT
}
#undef SBAR
#undef WAIT_BAR
}
constexpr int NWAVES = 8;
constexpr int DM = 1024, MP = 65536, MS = 16384, MT = MP + MS, NSEQ = 33, LP = 2048, LS = 16384, DFF = 2816, NMOD = 6144;
constexpr float EPS = 1e-6f;
constexpr float LAMBDA_INIT1 = 0.35550907f;
constexpr float QSCALE = 0.125f * 1.4426950408889634f;
constexpr size_t MiB = 1u << 20;
constexpr size_t WS_BAR = 0, BAR_BYTES = 16384;
constexpr size_t WS_MOD = 1 * MiB;
constexpr size_t WS_ROPE = 3 * MiB;
constexpr size_t WS_WQKVA = 4 * MiB, WS_WOA = 7 * MiB, WS_WQKVB = 9 * MiB, WS_WOB = 15 * MiB, WS_WGU = 17 * MiB  , WS_WD = 39 * MiB  ;
constexpr size_t WS_BV = 51 * MiB;
constexpr size_t WS_RSS = 54 * MiB;
constexpr int BV_GU0 = 0, BV_QKV1 = 33 * 5632, BV_GU1 = 33 * 5632 + 33 * 3072;
constexpr size_t WS_H = 64 * MiB, WS_Q = 224 * MiB, WS_K = 384 * MiB, WS_V = 544 * MiB, WS_O = 704 * MiB, WS_END = 864 * MiB;
constexpr size_t WS_ACT = WS_Q;
constexpr size_t WS_OC0 = WS_H, WS_OC1 = WS_O;
static_assert(WS_WD + 2 * (size_t)DM * DFF * 2 <= WS_H && WS_ACT + (size_t)MT * DFF * 2 <= WS_O, "ws map");
constexpr int RING_OFF = 0;
constexpr int LDS_BYTES = 163840;

#define GAS __attribute__((address_space(1)))
#define LAS __attribute__((address_space(3)))
typedef unsigned short bf16;
typedef unsigned v4u __attribute__((ext_vector_type(4)));
typedef float f32x4 __attribute__((ext_vector_type(4)));
#define LDS_WAIT() asm volatile("s_waitcnt lgkmcnt(0)" ::: "memory")
__device__ __forceinline__ unsigned f2bf(float f) { unsigned u = __builtin_bit_cast(unsigned, f); return (u + 0x7fffu + ((u >> 16) & 1u)) >> 16; }
__device__ __forceinline__ unsigned pk2(float lo, float hi) { return f2bf(lo) | (f2bf(hi) << 16); }
__device__ __forceinline__ float bf_lo(unsigned w) { return __builtin_bit_cast(float, w << 16); }
__device__ __forceinline__ float bf_hi(unsigned w) { return __builtin_bit_cast(float, w & 0xffff0000u); }
__device__ __forceinline__ float wave_sum(float v) {
#pragma unroll
    for (int o = 1; o < 64; o <<= 1) v += __shfl_xor(v, o);
    return v;
}
#define XB_TMO      128
#define XB_XCNT(j)  (256  + 64 * (j))
#define XB_XSUB(j)  (1280 + 64 * (j))
#define XB_XGEN(j)  (2304 + 64 * (j))
#define XB_TOP      3328
#define XB_TOPGEN   3392
#define XCD_BAR_WORDS 3456
#define XB_SPIN_CAP (1u << 18)

__device__ __forceinline__ unsigned xb_ld(unsigned* p)              { return __hip_atomic_load(p, __ATOMIC_RELAXED, __HIP_MEMORY_SCOPE_AGENT); }
__device__ __forceinline__ unsigned xb_add(unsigned* p, unsigned v) { return __hip_atomic_fetch_add(p, v, __ATOMIC_RELAXED, __HIP_MEMORY_SCOPE_AGENT); }
__device__ __forceinline__ unsigned xb_xcc_id() { return (unsigned)__builtin_amdgcn_s_getreg((3 << 11) | 20) & 0xFu; }
#define XB_SPIN(cond, bar) do { unsigned _sp = 0; while (cond) { __builtin_amdgcn_s_sleep(1); \
    if ((++_sp & 255u) == 0u) { if (xb_ld(&(bar)[XB_TMO])) break; if (_sp > XB_SPIN_CAP) { atomicAdd(&(bar)[XB_TMO], 1u); break; } } } } while (0)

struct XcdBarrier {
    unsigned* bar; unsigned x;
    volatile LAS unsigned* st;
};

__device__ __forceinline__ XcdBarrier xcd_barrier_post(unsigned* bar, volatile LAS unsigned* st) {
    XcdBarrier b; b.bar = bar; b.x = xb_xcc_id(); b.st = st;
    if (threadIdx.x == 0) (void)xb_add(&bar[XB_XCNT(b.x)], 1u);
    return b;
}
__device__ __forceinline__ void xcd_barrier_complete(unsigned* bar, unsigned x, unsigned& nloc, unsigned& nx) {
    const unsigned G = gridDim.x * gridDim.y * gridDim.z;
    unsigned sum, cnt, mine, sp = 0u;
    for (;;) {
        sum = 0u; cnt = 0u; mine = 0u;
#pragma unroll
        for (unsigned j = 0; j < 16; ++j) { const unsigned c = xb_ld(&bar[XB_XCNT(j)]); sum += c; cnt += (c > 0u) ? 1u : 0u; mine = (j == x) ? c : mine; }
        if (sum == G) break;
        __builtin_amdgcn_s_sleep(1);
        if ((++sp & 255u) == 0u) { if (xb_ld(&bar[XB_TMO])) break; if (sp > XB_SPIN_CAP) { atomicAdd(&bar[XB_TMO], 1u); break; } }
    }
    nloc = mine > 0u ? mine : 1u; nx = cnt > 0u ? cnt : 1u;
}

__device__ __forceinline__ void xcd_barrier(const XcdBarrier& b) {
    asm volatile("s_waitcnt vmcnt(0)" ::: "memory");
    __syncthreads();
    if (threadIdx.x == 0) {
        unsigned* bar = b.bar;
        __builtin_amdgcn_s_waitcnt(0);
        unsigned nloc = b.st[0], nx = b.st[1];
        if (nloc == 0u) { xcd_barrier_complete(bar, b.x, nloc, nx); b.st[0] = nloc; b.st[1] = nx; }
        const unsigned old = xb_add(&bar[XB_XSUB(b.x)], 1u);
        const unsigned gen = old / nloc;
        if (old + 1u == (gen + 1u) * nloc) {
            __builtin_amdgcn_fence(__ATOMIC_RELEASE, "agent");
            asm volatile("s_waitcnt vmcnt(0)" ::: "memory");
            const unsigned og = xb_add(&bar[XB_TOP], 1u);
            const unsigned tg = og / nx;
            if (og + 1u == (tg + 1u) * nx) xb_add(&bar[XB_TOPGEN], 1u);
            else XB_SPIN(xb_ld(&bar[XB_TOPGEN]) == tg, bar);
            __builtin_amdgcn_fence(__ATOMIC_ACQUIRE, "agent");
            xb_add(&bar[XB_XGEN(b.x)], 1u);
            asm volatile("s_waitcnt vmcnt(0)" ::: "memory");
        } else {
            XB_SPIN(xb_ld(&bar[XB_XGEN(b.x)]) == gen, bar);
            __builtin_amdgcn_fence(__ATOMIC_ACQUIRE, "agent");
            asm volatile("s_waitcnt vmcnt(0)" ::: "memory");
        }
    }
    __syncthreads();
}

__device__ __forceinline__ void p0_transpose_item(const float* W, int K, int N, bf16* WT, LAS float* scr, int k0, int n0, int drow0, int lane) {
    float tv[32];
#pragma unroll
    for (int i = 0; i < 32; ++i) { const int kk = 2 * i + (lane >> 5); tv[i] = W[(size_t)(k0 + kk) * N + n0 + (lane & 31)]; }
#pragma unroll
    for (int i = 0; i < 32; ++i) { const int kk = 2 * i + (lane >> 5); scr[kk * 33 + (lane & 31)] = tv[i]; }
    LDS_WAIT(); asm volatile("" ::: "memory");
    const int c = lane & 7;
#pragma unroll
    for (int j = 0; j < 4; ++j) { const int n = (lane >> 3) + 8 * j; const LAS float* s = scr + (8 * c) * 33 + n;
        v4u o; o.x = pk2(s[0 * 33], s[1 * 33]); o.y = pk2(s[2 * 33], s[3 * 33]); o.z = pk2(s[4 * 33], s[5 * 33]); o.w = pk2(s[6 * 33], s[7 * 33]);
        *(GAS v4u*)(WT + (size_t)(drow0 + n) * K + k0 + 8 * c) = o; }
    LDS_WAIT(); asm volatile("" ::: "memory");
}
__device__ __forceinline__ void gemv33c(int bidx, int bstride, int tid, const LAS float* vec, LAS float* red, const float* W, int N, float* outp, int ostride, const float* addb) {
    const int lane = tid & 63, wave = tid >> 6, kq = lane >> 4, nn = lane & 15, kbase = wave * 128 + 4 * kq;
    typedef float f4 __attribute__((ext_vector_type(4)));
    for (int cb = bidx; cb < N / 16; cb += bstride) {
        const float* Wn = W + 16 * cb + nn;
        float w[8][4];
#pragma unroll
        for (int u = 0; u < 8; ++u)
#pragma unroll
            for (int j = 0; j < 4; ++j) w[u][j] = Wn[(size_t)(kbase + 16 * u + j) * N];
        float acc[33];
#pragma unroll
        for (int s = 0; s < 33; ++s) acc[s] = 0.f;
#pragma unroll
        for (int s = 0; s < 33; ++s) {
#pragma unroll
            for (int u = 0; u < 8; ++u) { const f4 v = *(const LAS f4*)(vec + s * 1024 + kbase + 16 * u); acc[s] += (v.x * w[u][0] + v.y * w[u][1]) + (v.z * w[u][2] + v.w * w[u][3]); }
            asm volatile("" : "+v"(acc[s]) :: "memory"); }
#pragma unroll
        for (int s = 0; s < 33; ++s) { float a = acc[s]; a += __shfl_xor(a, 16); a += __shfl_xor(a, 32); if (kq == 0) red[(wave * 33 + s) * 16 + nn] = a; }
        __syncthreads();
        for (int o = tid; o < 528; o += 512) { const int s = o >> 4, n2 = o & 15; float a = 0.f;
#pragma unroll
            for (int ww = 0; ww < 8; ++ww) a += red[(ww * 33 + s) * 16 + n2];
            outp[(size_t)s * ostride + 16 * cb + n2] = a + (addb ? addb[16 * cb + n2] : 0.f); }
        __syncthreads();
    }
}
struct Args { const float* in[24]; float* out; unsigned char* ws; };

__device__ __forceinline__ void norm_rows(int gw, int NGW, int lane, const float* src_p, const float* src_s, const float* gain, const float* modl, int sh_off, int sc_off, bf16* H) {
    for (int m0 = gw; m0 < MT; m0 += 2 * NGW) {
        const int m1 = m0 + NGW; const bool has1 = m1 < MT; const int m1c = has1 ? m1 : m0;
        const float* s0 = (m0 < MP) ? src_p + (size_t)m0 * DM : src_s + (size_t)(m0 - MP) * DM;
        const float* s1 = (m1c < MP) ? src_p + (size_t)m1c * DM : src_s + (size_t)(m1c - MP) * DM;
        const GAS f32x4* x0 = (const GAS f32x4*)s0 + lane; const GAS f32x4* x1 = (const GAS f32x4*)s1 + lane;
        f32x4 v0[4], v1[4]; float q0 = 0.f, q1 = 0.f;
#pragma unroll
        for (int j = 0; j < 4; ++j) { v0[j] = x0[64 * j]; v1[j] = x1[64 * j]; }
#pragma unroll
        for (int j = 0; j < 4; ++j) { q0 += (v0[j].x * v0[j].x + v0[j].y * v0[j].y) + (v0[j].z * v0[j].z + v0[j].w * v0[j].w); q1 += (v1[j].x * v1[j].x + v1[j].y * v1[j].y) + (v1[j].z * v1[j].z + v1[j].w * v1[j].w); }
        const float r0 = 1.0f / sqrtf(wave_sum(q0) * (1.f / DM) + EPS), r1 = 1.0f / sqrtf(wave_sum(q1) * (1.f / DM) + EPS);
        const float* mr0 = modl + (size_t)((m0 < MP) ? (m0 >> 11) : 32) * NMOD; const float* mr1 = modl + (size_t)((m1c < MP) ? (m1c >> 11) : 32) * NMOD;
        GAS unsigned long long* o0 = (GAS unsigned long long*)(H + (size_t)m0 * DM) + lane; GAS unsigned long long* o1 = (GAS unsigned long long*)(H + (size_t)m1c * DM) + lane;
#pragma unroll
        for (int j = 0; j < 4; ++j) { const int col = 4 * lane + 256 * j; const f32x4 g = *(const f32x4*)(gain + col);
            const f32x4 y0 = (v0[j] * r0) * g * (*(const f32x4*)(mr0 + sc_off + col) + 1.0f) + *(const f32x4*)(mr0 + sh_off + col);
            o0[64 * j] = (unsigned long long)pk2(y0.x, y0.y) | ((unsigned long long)pk2(y0.z, y0.w) << 32);
            if (has1) { const f32x4 y1 = (v1[j] * r1) * g * (*(const f32x4*)(mr1 + sc_off + col) + 1.0f) + *(const f32x4*)(mr1 + sh_off + col);
                o1[64 * j] = (unsigned long long)pk2(y1.x, y1.y) | ((unsigned long long)pk2(y1.z, y1.w) << 32); } }
    }
}
__device__ __forceinline__ void qknorm_chunks(int gw, int NGW, int lane, bf16* buf, int nchunks, int row_width_log2, const float* gain, float qscale, bool rope, const float* ropetab) {
    const int d0 = 16 * (lane & 3);
    float g[16];
#pragma unroll
    for (int i = 0; i < 16; ++i) g[i] = gain[d0 + i] * qscale;
    for (int ci = gw; ci < nchunks; ci += NGW) {
        GAS v4u* p = (GAS v4u*)(buf + (size_t)ci * 1024 + 16 * lane);
        const v4u a = p[0], b = p[1];
        float x[16];
        x[0] = bf_lo(a.x); x[1] = bf_hi(a.x); x[2] = bf_lo(a.y); x[3] = bf_hi(a.y); x[4] = bf_lo(a.z); x[5] = bf_hi(a.z); x[6] = bf_lo(a.w); x[7] = bf_hi(a.w);
        x[8] = bf_lo(b.x); x[9] = bf_hi(b.x); x[10] = bf_lo(b.y); x[11] = bf_hi(b.y); x[12] = bf_lo(b.z); x[13] = bf_hi(b.z); x[14] = bf_lo(b.w); x[15] = bf_hi(b.w);
        float ss = 0.f;
#pragma unroll
        for (int i = 0; i < 16; ++i) ss += x[i] * x[i];
        ss += __shfl_xor(ss, 1); ss += __shfl_xor(ss, 2);
        const float r = 1.0f / sqrtf(ss * (1.f / 64.f) + EPS);
#pragma unroll
        for (int i = 0; i < 16; ++i) x[i] = x[i] * r * g[i];
        if (rope) {
            const int m = (int)((((size_t)ci * 1024 + 16 * lane)) >> row_width_log2);
            const int t = (m < MP) ? (m & (LP - 1)) : (m - MP);
            const int qd = lane & 3; const int pos = (qd < 2) ? (t >> 6) : (t & 63);
            const f32x4* tb = (const f32x4*)(ropetab + (size_t)(pos * 16 + 8 * (qd & 1)) * 2);
#pragma unroll
            for (int j = 0; j < 4; ++j) { const f32x4 cs = tb[j];
                const float a0 = x[4 * j], a1 = x[4 * j + 1], b0 = x[4 * j + 2], b1 = x[4 * j + 3];
                x[4 * j] = a0 * cs.x - a1 * cs.y; x[4 * j + 1] = a0 * cs.y + a1 * cs.x; x[4 * j + 2] = b0 * cs.z - b1 * cs.w; x[4 * j + 3] = b0 * cs.w + b1 * cs.z; }
        }
        v4u oa, ob;
        oa.x = pk2(x[0], x[1]); oa.y = pk2(x[2], x[3]); oa.z = pk2(x[4], x[5]); oa.w = pk2(x[6], x[7]);
        ob.x = pk2(x[8], x[9]); ob.y = pk2(x[10], x[11]); ob.z = pk2(x[12], x[13]); ob.w = pk2(x[14], x[15]);
        p[0] = oa; p[1] = ob;
    }
}
__device__ __forceinline__ void diff_combine(int gw, int NGW, int lane, const bf16* O0, bf16* O1, const float* subg, float lam) {
    const int d0 = 16 * (lane & 7);
    float g[16];
#pragma unroll
    for (int i = 0; i < 16; ++i) g[i] = subg[d0 + i] * (1.0f - LAMBDA_INIT1);
    for (int m = gw; m < MT; m += NGW) {
        const GAS v4u* p0 = (const GAS v4u*)(O0 + (size_t)m * 1024 + 16 * lane);
        GAS v4u* p1 = (GAS v4u*)(O1 + (size_t)m * 1024 + 16 * lane);
        const v4u a0 = p0[0], b0 = p0[1], a1 = p1[0], b1 = p1[1];
        float x[16];
#define DC(i, w0, w1) x[2 * (i)] = bf_lo(w0) - lam * bf_lo(w1); x[2 * (i) + 1] = bf_hi(w0) - lam * bf_hi(w1);
        DC(0, a0.x, a1.x) DC(1, a0.y, a1.y) DC(2, a0.z, a1.z) DC(3, a0.w, a1.w) DC(4, b0.x, b1.x) DC(5, b0.y, b1.y) DC(6, b0.z, b1.z) DC(7, b0.w, b1.w)
#undef DC
        float ss = 0.f;
#pragma unroll
        for (int i = 0; i < 16; ++i) ss += x[i] * x[i];
        ss += __shfl_xor(ss, 1); ss += __shfl_xor(ss, 2); ss += __shfl_xor(ss, 4);
        const float r = 1.0f / sqrtf(ss * (1.f / 128.f) + EPS);
#pragma unroll
        for (int i = 0; i < 16; ++i) x[i] = x[i] * r * g[i];
        v4u oa, ob;
        oa.x = pk2(x[0], x[1]); oa.y = pk2(x[2], x[3]); oa.z = pk2(x[4], x[5]); oa.w = pk2(x[6], x[7]);
        ob.x = pk2(x[8], x[9]); ob.y = pk2(x[10], x[11]); ob.z = pk2(x[12], x[13]); ob.w = pk2(x[14], x[15]);
        p1[0] = oa; p1[1] = ob;
    }
}

__global__ void __launch_bounds__(NWAVES * 64, 2) mega_fwd(Args args) {
    extern __shared__ __attribute__((aligned(16))) unsigned char lds[];
    cg::grid_group grid = cg::this_grid();
    LAS unsigned char* ldsl = (LAS unsigned char*)lds;
    const int tid = threadIdx.x, lane = tid & 63, wave = __builtin_amdgcn_readfirstlane(tid >> 6);
    const int G = gridDim.x, bx = blockIdx.x;
    const int vcu = (G % 8 == 0) ? (bx % 8) * (G / 8) + bx / 8 : bx;
    const int gw = vcu * NWAVES + wave, NGW = G * NWAVES;
    volatile LAS unsigned* bst = (volatile LAS unsigned*)(ldsl + 163776);
    if (tid < 16) bst[tid] = 0u;
    __syncthreads();
    const XcdBarrier xbar = xcd_barrier_post((unsigned*)(args.ws + WS_BAR), bst);
    typedef __attribute__((address_space(4))) const Args* cargs_t;
    const cargs_t ap0 = (cargs_t)__builtin_amdgcn_kernarg_segment_ptr();
#define AP() cargs_t ap = ap0; asm volatile("" : "+s"(ap))
#define WSP(T, off) ((T*)(ap->ws + (off)))
#define mod WSP(float, WS_MOD)
#define ropetab WSP(float, WS_ROPE)
#define Wqkv_a WSP(bf16, WS_WQKVA)
#define Wo_a WSP(bf16, WS_WOA)
#define Wqkv_b WSP(bf16, WS_WQKVB)
#define Wo_b WSP(bf16, WS_WOB)
#define Wgu WSP(bf16, WS_WGU)
#define Wd WSP(bf16, WS_WD)
#define H WSP(bf16, WS_H)
#define Qb WSP(bf16, WS_Q)
#define Kb WSP(bf16, WS_K)
#define Vb WSP(bf16, WS_V)
#define Ob WSP(bf16, WS_O)
#define ACT WSP(bf16, WS_ACT)
#define OC0 WSP(bf16, WS_OC0)
#define OC1 WSP(bf16, WS_OC1)
#define out (ap->out)
#define x_p (ap->in[0])
#define x_s (ap->in[1])
    {
        AP();
        LAS float* scr = (LAS float*)(ldsl + RING_OFF + wave * 16384);
        constexpr int I_QA = 16 * 48, I_OA = 16 * 32, I_QB = 16 * 96, I_OB = 16 * 32, I_GU = 16 * 176, I_D = 44 * 32;
        constexpr int NITEMS = I_QA + I_OA + I_QB + I_OB + 2 * I_GU + 2 * I_D;
        for (int it = gw; it < NITEMS; it += NGW) {
            int r = it;
            if (r < I_QA) { const int nb = r % 48, kb = r / 48; p0_transpose_item(ap->in[11], 1024, 1536, Wqkv_a, scr, 64 * kb, 32 * nb, 32 * nb, lane); continue; } r -= I_QA;
            if (r < I_OA) { const int nb = r % 32, kb = r / 32; p0_transpose_item(ap->in[12], 1024, 1024, Wo_a, scr, 64 * kb, 32 * nb, 32 * nb, lane); continue; } r -= I_OA;
            if (r < I_QB) { const int nb = r % 96, kb = r / 96; p0_transpose_item(ap->in[15], 1024, 3072, Wqkv_b, scr, 64 * kb, 32 * nb, 32 * nb, lane); continue; } r -= I_QB;
            if (r < I_OB) { const int nb = r % 32, kb = r / 32; p0_transpose_item(ap->in[16], 1024, 1024, Wo_b, scr, 64 * kb, 32 * nb, 32 * nb, lane); continue; } r -= I_OB;
            if (r < 2 * I_GU) { const int l = r / I_GU; r -= l * I_GU; const int nb = r % 176, kb = r / 176; const int n0 = 32 * nb;
                const int drow0 = (n0 < DFF) ? (n0 / 128) * 256 + (n0 % 128) : ((n0 - DFF) / 128) * 256 + 128 + ((n0 - DFF) % 128);
                p0_transpose_item(ap->in[8] + (size_t)l * 1024 * 5632, 1024, 5632, Wgu + (size_t)l * 5632 * 1024, scr, 64 * kb, n0, drow0, lane); continue; } r -= 2 * I_GU;
            { const int l = r / I_D; r -= l * I_D; const int nb = r % 32, kb = r / 32;
                p0_transpose_item(ap->in[9] + (size_t)l * DFF * 1024, DFF, 1024, Wd + (size_t)l * 1024 * DFF, scr, 64 * kb, 32 * nb, 32 * nb, lane); }
        }
        { const int gt = vcu * 512 + tid;
          if (gt < 4096) { const int pos = gt >> 4, f = gt & 15; const float inv = exp2f(-(float)f * (13.287712379549449f / 16.0f)); const float ang = (float)pos * inv;
              const float rev = ang * 0.15915494309189535f; ropetab[2 * gt] = __builtin_amdgcn_cosf(rev); ropetab[2 * gt + 1] = __builtin_amdgcn_sinf(rev); } }
        __syncthreads();
        LAS float* cact = (LAS float*)ldsl;
        for (int i = tid; i < NSEQ * 1024; i += 512) { const int s = i >> 10, k = i & 1023; const float c = (s < 32) ? ap->in[2][s * 1024 + k] : ap->in[3][k];
            cact[i] = c / (1.0f + __expf(-c)); }
        __syncthreads();
        { const int half = G / 2; const int l = (vcu >= half) ? 1 : 0;
          gemv33c(vcu - l * half, half > 0 ? half : 1, tid, cact, (LAS float*)(ldsl + 135168), ap->in[6] + (size_t)l * 1024 * NMOD, NMOD, mod + (size_t)l * NSEQ * NMOD, NMOD, ap->in[7] + l * NMOD); }
        { float* rss = WSP(float, WS_RSS); for (int i = vcu * 512 + tid; i < 3 * MT; i += G * 512) rss[i] = 0.f; }
        __syncthreads();
    }
    grid.sync();

    auto layer_body = [&](auto LC) __attribute__((always_inline)) {
        constexpr int layer = decltype(LC)::value;
        AP();
#define modl (mod + (size_t)layer * NSEQ * NMOD)
        if (layer == 0) {
            norm_rows(gw, NGW, lane, x_p, x_s, ap->in[4], modl, 0, 1024, H);
            LAS float* shv = (LAS float*)ldsl; float* bv = WSP(float, WS_BV);
#pragma unroll 1
            for (int which = 0; which < 3; ++which) {
                const float* shsrc = mod + (size_t)(which == 0 ? 0 : 1) * NSEQ * NMOD + (which == 1 ? 0 : 3072);
                for (int i = tid; i < NSEQ * 1024; i += 512) shv[i] = shsrc[(size_t)(i >> 10) * NMOD + (i & 1023)];
                __syncthreads();
                if (which == 0) gemv33c(vcu, G, tid, shv, (LAS float*)(ldsl + 135168), ap->in[8], 5632, bv + BV_GU0, 5632, nullptr);
                else if (which == 1) gemv33c(vcu, G, tid, shv, (LAS float*)(ldsl + 135168), ap->in[15], 3072, bv + BV_QKV1, 3072, nullptr);
                else gemv33c(vcu, G, tid, shv, (LAS float*)(ldsl + 135168), ap->in[8] + (size_t)1024 * 5632, 5632, bv + BV_GU1, 5632, nullptr);
                __syncthreads();
            }
            xcd_barrier(xbar);
        }
        if (layer == 0) {
            pg8::Gemm g{H, Wqkv_a, MT, 1536, 1024}; pg8::StaticOrder S; S.init(MT, 1536, G, bx);
            pg8::EpiSplit2<false, true> E{Qb, Kb, Vb, 1024, 256, 256, 4, 5, nullptr, nullptr, 0, ap->in[13], ap->in[14], QSCALE, ropetab, (LAS float*)(ldsl + 131072)};
            pg8::gemm_phase<pg8::EpiSplit2<false, true>, pg8::StaticOrder, true, PG8_SP2>(ldsl + RING_OFF, g, S, E);
        } else {
            pg8::Gemm g{H, Wqkv_b, MT, 3072, 1024}; pg8::StaticOrder S; S.init(MT, 3072, G, bx);
            pg8::EpiSplit2<true, false> E{Qb, Kb, Vb, 1024, 1024, 1024, 4, 8, WSP(float, WS_RSS) + MT, WSP(float, WS_BV) + BV_QKV1, 3072, ap->in[17], ap->in[18], QSCALE, ropetab, (LAS float*)(ldsl + 131072)};
            pg8::gemm_phase<pg8::EpiSplit2<true, false>, pg8::StaticOrder, true, PG8_SP2>(ldsl + RING_OFF, g, S, E);
        }
        xcd_barrier(xbar);
        if (layer == 0) {
            for (int idx = vcu; idx < 1024 + 4096; idx += G) {
                size_t tok0; int head, kvh, qb, NT;
                if (idx < 1024) { const int xcd = (idx >> 5) & 7, j = idx & 31, i = idx >> 8; kvh = xcd & 3; const int w = (((xcd >> 2) * 4 + i) << 5) + j; head = kvh * 4 + (w >> 6); qb = w & 63; tok0 = MP; NT = LS / 64; }
                else { const int id2 = idx - 1024; const int xcd = (id2 >> 5) & 7, j = id2 & 31, i = id2 >> 8; const int gq = xcd * 16 + i; kvh = gq & 3; head = kvh * 4 + (j >> 3); qb = j & 7; tok0 = (size_t)(gq >> 2) * LP; NT = LP / 64; }
                attn_body::attn_unit2<1, false, 0>((const attn_body::bf16*)(Qb + tok0 * 1024 + head * 64), 1024, (const attn_body::bf16*)(Kb + tok0 * 256 + kvh * 64), 256,
                    (const attn_body::bf16*)(Vb + tok0 * 256 + kvh * 64), 256, (attn_body::bf16*)(Ob + tok0 * 1024 + head * 64), 1024, qb * 256, NT, nullptr, (char*)lds + RING_OFF, 0.f, nullptr, 0.f); }
        } else {
            const float s1 = wave_sum(ap->in[19][lane] * ap->in[20][lane]), s2 = wave_sum(ap->in[21][lane] * ap->in[22][lane]);
            const float lam = expf(s1) - expf(s2) + LAMBDA_INIT1;
            for (int idx = vcu; idx < 512 + 2048; idx += G) {
                size_t tok0; int h, qb, NT;
                if (idx < 512) { const int xcd = (idx >> 5) & 7, j = idx & 31, i = idx >> 8; h = xcd; qb = (i << 5) + j; tok0 = MP; NT = LS / 64; }
                else { const int id2 = idx - 512; const int xcd = (id2 >> 5) & 7, j = id2 & 31, i = id2 >> 8; const int gq = ((xcd * 8 + i) << 2) + (j >> 3); h = gq & 7; qb = j & 7; tok0 = (size_t)(gq >> 3) * LP; NT = LP / 64; }
                attn_body::attn_unit2<2, true, 1>((const attn_body::bf16*)(Qb + tok0 * 1024 + (2 * h) * 64), 1024, (const attn_body::bf16*)(Kb + tok0 * 1024 + (2 * h) * 64), 1024,
                    (const attn_body::bf16*)(Vb + tok0 * 1024 + h * 128), 1024, (attn_body::bf16*)(Ob + tok0 * 1024 + h * 128), 1024, qb * 256, NT, ap->in[10] + h, (char*)lds + RING_OFF, lam, ap->in[23], 1.0f - LAMBDA_INIT1);
                attn_body::attn_unit2<2, true, 2>((const attn_body::bf16*)(Qb + tok0 * 1024 + (2 * h + 1) * 64), 1024, (const attn_body::bf16*)(Kb + tok0 * 1024 + (2 * h + 1) * 64), 1024,
                    (const attn_body::bf16*)(Vb + tok0 * 1024 + h * 128), 1024, (attn_body::bf16*)(Ob + tok0 * 1024 + h * 128), 1024, qb * 256, NT, ap->in[10] + h, (char*)lds + RING_OFF, lam, ap->in[23], 1.0f - LAMBDA_INIT1); }
        }
        xcd_barrier(xbar);
        {
            pg8::Gemm g{Ob, layer == 0 ? Wo_a : Wo_b, MT, 1024, 1024}; pg8::StaticOrder S; S.init(MT, 1024, G, bx);
            pg8::EpiResid3<true> E{layer == 0 ? x_p : out, layer == 0 ? (x_s - (size_t)MP * DM) : out, out, modl + 2048, ap->in[5] + layer * 1024, modl + 4096, H, WSP(float, WS_RSS) + (layer == 0 ? 0 : 2 * MT)};
            pg8::gemm_phase<pg8::EpiResid3<true>, pg8::StaticOrder, PG8_ALIGN, PG8_SP2>(ldsl + RING_OFF, g, S, E);
        }
        xcd_barrier(xbar);
        {
            pg8::Gemm g{H, Wgu + (size_t)layer * 5632 * 1024, MT, 5632, 1024}; pg8::StaticOrder S; S.init(MT, 5632, G, bx);
            pg8::EpiSwiGLU2 E{ACT, DFF, WSP(float, WS_RSS) + (layer == 0 ? 0 : 2 * MT), WSP(float, WS_BV) + (layer == 0 ? BV_GU0 : BV_GU1)};
            pg8::gemm_phase<pg8::EpiSwiGLU2, pg8::StaticOrder, PG8_ALIGN, PG8_SP2>(ldsl + RING_OFF, g, S, E);
        }
        xcd_barrier(xbar);
        {
            pg8::Gemm g{ACT, Wd + (size_t)layer * 1024 * DFF, MT, 1024, DFF}; pg8::StaticOrder S; S.init(MT, 1024, G, bx);
            if (layer == 0) {
                pg8::EpiResid3<true> E{out, out, out, modl + 5120, ap->in[4] + 1024, mod + (size_t)NSEQ * NMOD + 1024, H, WSP(float, WS_RSS) + MT};
                pg8::gemm_phase<pg8::EpiResid3<true>, pg8::StaticOrder, PG8_ALIGN, PG8_SP2>(ldsl + RING_OFF, g, S, E);
            } else {
                pg8::EpiResid3<false> E{out, out, out, modl + 5120, nullptr, nullptr, nullptr, nullptr};
                pg8::gemm_phase<pg8::EpiResid3<false>, pg8::StaticOrder, PG8_ALIGN, PG8_SP2>(ldsl + RING_OFF, g, S, E);
            }
        }
        if (layer == 0) xcd_barrier(xbar);
    };
    layer_body(std::integral_constant<int, 0>{});
    layer_body(std::integral_constant<int, 1>{});
}

#undef out
#undef H
#undef mod
#undef modl
#undef ACT
#undef Qb
#undef Kb
#undef Vb
#undef Ob
extern "C" void kernel_launch(void* const* d_in, const int* in_sizes, int n_in, void* d_out, int out_size, void* d_ws, size_t ws_size, hipStream_t stream) {
    static int grid = 0;
    if (grid == 0) {
        if (n_in != 24 || out_size != MT * DM || ws_size < WS_END) { fprintf(stderr, "kernel_launch: unexpected shapes (n_in %d, out %d, ws %zu)\n", n_in, out_size, ws_size); grid = -1; return; }
        int dev = 0, cus = 0, per_cu = 0;
        hipGetDevice(&dev); hipDeviceGetAttribute(&cus, hipDeviceAttributeMultiprocessorCount, dev);
        if (hipFuncSetAttribute((const void*)mega_fwd, hipFuncAttributeMaxDynamicSharedMemorySize, LDS_BYTES) != hipSuccess) { fprintf(stderr, "hipFuncSetAttribute failed\n"); grid = -1; return; }
        if (hipOccupancyMaxActiveBlocksPerMultiprocessor(&per_cu, (const void*)mega_fwd, NWAVES * 64, LDS_BYTES) != hipSuccess || per_cu < 1) per_cu = 1;
        (void)hipGetLastError();
        grid = cus;
        if (grid > 256) grid = 256;
    }
    if (grid < 0) return;
    if (hipMemsetAsync((char*)d_ws + WS_BAR, 0, BAR_BYTES, stream) != hipSuccess) { fprintf(stderr, "hipMemsetAsync of the barrier words failed\n"); return; }
    Args a{};
    for (int i = 0; i < 24; ++i) a.in[i] = (const float*)d_in[i];
    a.out = (float*)d_out; a.ws = (unsigned char*)d_ws;
    void* kargs[] = {&a};
    hipError_t e = hipLaunchCooperativeKernel((const void*)mega_fwd, dim3(grid), dim3(NWAVES * 64), kargs, LDS_BYTES, stream);
    if (e != hipSuccess) fprintf(stderr, "cooperative launch failed: %s (grid %d)\n", hipGetErrorString(e), grid);
}
```

```cpp
#include <hip/hip_runtime.h>
#include <hip/hip_cooperative_groups.h>
#include <hip/hip_bf16.h>
#include <cstdio>
#include <cstdint>
#include <cmath>
#include <type_traits>
namespace cg = cooperative_groups;
namespace pg8 {
#define PG8_LAS __attribute__((address_space(3)))
typedef unsigned short bf16_t;
typedef short bf16x8 __attribute__((ext_vector_type(8)));
typedef float f32x4 __attribute__((ext_vector_type(4)));
typedef unsigned u32x4 __attribute__((ext_vector_type(4)));
constexpr int BM = 256, BK = 64, HALF = 128, HTB = HALF * BK * 2  , STAGE_BYTES = 8 * HTB, NXCD = 8, WGM = 8;

__host__ __device__ __forceinline__ int lds_byte(int r, int c) { const int st = (r >> 4) * 2 + (c >> 5), rr = r & 15, cc = c & 31, ob = rr * 64 + cc * 2; return st * 1024 + (ob ^ (((ob >> 9) & 1) << 5)); }
__host__ __device__ __forceinline__ void stage_rc(int b, int& R, int& C) { const int st = b / 1024, sb = b % 1024, swz = sb ^ (((sb >> 9) & 1) << 5); R = (st >> 1) * 16 + swz / 64; C = (st & 1) * 32 + (swz % 64) / 2; }
__host__ __device__ __forceinline__ int perm32(int rho) { const int n = rho >> 4, i = rho & 15; return 8 * (i >> 2) + 4 * n + (i & 3); }

struct Unit { int pm, pn; };
struct Gemm { const bf16_t* A; const bf16_t* Bt; int M, N, K; };

struct StaticOrder {
    int nM, nN, nwg, G, c;
    __host__ __device__ void init(int M, int N, int G_, int c_) { nM = M / BM; nN = N / BM; nwg = nM * nN; G = G_; c = c_; }
    __host__ __device__ bool next(int i, Unit& u) const {
        const long L = (long)i * G + c; if (L >= nwg) return false;
        int wgid = (int)L; { const int q = nwg / NXCD, r = nwg % NXCD, xcd = wgid % NXCD, off = wgid / NXCD; wgid = (xcd < r ? xcd * (q + 1) : r * (q + 1) + (xcd - r) * q) + off; }
        const int nig = WGM * nN, gid = wgid / nig, fm = gid * WGM, gsz = (nM - fm) < WGM ? (nM - fm) : WGM;
        u.pm = fm + ((wgid % nig) % gsz); u.pn = (wgid % nig) / gsz; return true;
    }
    __device__ __forceinline__ void a_ready(const Unit&) const {}
    __device__ __forceinline__ void done(const Unit&) const {}
};

__device__ __forceinline__ unsigned cvt_pk_bf16(float lo, float hi) { unsigned r; asm volatile("v_cvt_pk_bf16_f32 %0, %1, %2" : "=v"(r) : "v"(lo), "v"(hi)); return r; }
typedef float f32x2 __attribute__((ext_vector_type(2)));
__device__ __forceinline__ float silu_mul(float g, float uu) { const float e = __builtin_amdgcn_exp2f(g * -1.4426950408889634f); return g * __builtin_amdgcn_rcpf(1.0f + e) * uu; }
constexpr float EPI_EPS = 1e-6f;
template <bool NEXT> struct EpiResid2 {
    static constexpr bool PERM = true, AFTER_DRAIN = false;
    const float* base_p; const float* base_s; float* out; const float* gate;
    const float* ngain; const float* nsc; bf16_t* Hn; float* rowss;
    __device__ __forceinline__ void prefetch(PG8_LAS unsigned char*, const Unit&, int, int) const {}
    __device__ __forceinline__ void operator()(const f32x4 (&acc)[2][2][4][2], const Unit& u, int wr, int wc, int fr, int fq, PG8_LAS unsigned char*) const {
        const int seq = (u.pm < 256) ? (u.pm >> 3) : 32;
        const float* base = (u.pm < 256) ? base_p : base_s;
        const int col0 = u.pn * BM + wc * 32 + 8 * fq;
        u32x4 dl[2][4][2];
        { f32x4 gv[2][2];
#pragma unroll
          for (int bj = 0; bj < 2; ++bj)
#pragma unroll
            for (int n = 0; n < 2; ++n) gv[bj][n] = *(const f32x4*)(gate + (size_t)seq * 6144 + col0 + bj * HALF + 4 * n);
#pragma unroll
          for (int ai = 0; ai < 2; ++ai)
#pragma unroll
            for (int m = 0; m < 4; ++m)
#pragma unroll
                for (int bj = 0; bj < 2; ++bj) { const f32x4 a = gv[bj][0] * acc[ai][bj][m][0], b = gv[bj][1] * acc[ai][bj][m][1];
                    dl[ai][m][bj].x = cvt_pk_bf16(a[0], a[1]); dl[ai][m][bj].y = cvt_pk_bf16(a[2], a[3]); dl[ai][m][bj].z = cvt_pk_bf16(b[0], b[1]); dl[ai][m][bj].w = cvt_pk_bf16(b[2], b[3]); } }
        f32x4 gm[2][2];
        if (NEXT) {
#pragma unroll
          for (int bj = 0; bj < 2; ++bj)
#pragma unroll
            for (int n = 0; n < 2; ++n) { const int c = col0 + bj * HALF + 4 * n; gm[bj][n] = *(const f32x4*)(ngain + c) * (*(const f32x4*)(nsc + (size_t)seq * 6144 + c) + 1.0f); } }
#define BFLO(w) __builtin_bit_cast(float, (w) << 16)
#define BFHI(w) __builtin_bit_cast(float, (w) & 0xffff0000u)
#pragma unroll
        for (int ai = 0; ai < 2; ++ai) {
            f32x4 bs[4][2][2];
#pragma unroll
            for (int m = 0; m < 4; ++m) { const size_t off = (size_t)(u.pm * BM + ai * HALF + wr * 64 + m * 16 + fr) * 1024 + col0;
#pragma unroll
                for (int bj = 0; bj < 2; ++bj) { bs[m][bj][0] = *(const f32x4*)(base + off + bj * HALF); bs[m][bj][1] = *(const f32x4*)(base + off + bj * HALF + 4); } }
#pragma unroll
            for (int m = 0; m < 4; ++m) { const int row = u.pm * BM + ai * HALF + wr * 64 + m * 16 + fr; const size_t off = (size_t)row * 1024 + col0; float ss = 0.f;
#pragma unroll
                for (int bj = 0; bj < 2; ++bj) { const u32x4 d = dl[ai][m][bj];
                    const f32x4 o0 = bs[m][bj][0] + (f32x4){BFLO(d.x), BFHI(d.x), BFLO(d.y), BFHI(d.y)}, o1 = bs[m][bj][1] + (f32x4){BFLO(d.z), BFHI(d.z), BFLO(d.w), BFHI(d.w)};
                    *(f32x4*)(out + off + bj * HALF) = o0; *(f32x4*)(out + off + bj * HALF + 4) = o1;
                    if (NEXT) { ss += (o0[0] * o0[0] + o0[1] * o0[1]) + (o0[2] * o0[2] + o0[3] * o0[3]) + (o1[0] * o1[0] + o1[1] * o1[1]) + (o1[2] * o1[2] + o1[3] * o1[3]);
                        const f32x4 h0 = o0 * gm[bj][0], h1 = o1 * gm[bj][1];
                        u32x4 w; w.x = cvt_pk_bf16(h0[0], h0[1]); w.y = cvt_pk_bf16(h0[2], h0[3]); w.z = cvt_pk_bf16(h1[0], h1[1]); w.w = cvt_pk_bf16(h1[2], h1[3]);
                        *(u32x4*)(Hn + off + bj * HALF) = w; } }
                if (NEXT) { ss += __shfl_xor(ss, 16); ss += __shfl_xor(ss, 32); if (fq == 0) __hip_atomic_fetch_add(rowss + row, ss, __ATOMIC_RELAXED, __HIP_MEMORY_SCOPE_AGENT); } }
            asm volatile("" ::: "memory"); }
#undef BFLO
#undef BFHI
    }
};
struct EpiSwiGLU2 {
    static constexpr bool PERM = true, AFTER_DRAIN = false;
    bf16_t* O; int ldc; const float* rowss; const float* bias;
    __device__ __forceinline__ void prefetch(PG8_LAS unsigned char* sp, const Unit& u, int wid, int lane) const {
        const int seq = (u.pm < 256) ? (u.pm >> 3) : 32;
        const float* src = (wid < 4) ? rowss + u.pm * BM + wid * 64 : bias + (size_t)seq * 5632 + u.pn * HALF + (wid < 6 ? (wid - 4) * 64 : 2816 + (wid - 6) * 64);
        __builtin_amdgcn_global_load_lds((const unsigned*)(src + lane), (PG8_LAS unsigned*)(sp + wid * 256), 4, 0, 0);
    }
    __device__ __forceinline__ void operator()(const f32x4 (&acc)[2][2][4][2], const Unit& u, int wr, int wc, int fr, int fq, PG8_LAS unsigned char* sp) const {
        const int row0 = u.pm * BM + wr * 64 + fr; const int col0 = u.pn * HALF + wc * 32 + 8 * fq;
        const PG8_LAS float* spf = (const PG8_LAS float*)sp;
        const f32x4 bg0 = *(const PG8_LAS f32x4*)(spf + 256 + wc * 32 + 8 * fq), bg1 = *(const PG8_LAS f32x4*)(spf + 256 + wc * 32 + 8 * fq + 4);
        const f32x4 bu0 = *(const PG8_LAS f32x4*)(spf + 384 + wc * 32 + 8 * fq), bu1 = *(const PG8_LAS f32x4*)(spf + 384 + wc * 32 + 8 * fq + 4);
#pragma unroll
        for (int ai = 0; ai < 2; ++ai)
#pragma unroll
            for (int m = 0; m < 4; ++m) { const int row = row0 + ai * HALF + m * 16; const float rr = __builtin_amdgcn_rsqf(spf[ai * HALF + wr * 64 + m * 16 + fr] * (1.0f / 1024.0f) + EPI_EPS);
                const f32x4 g0 = acc[ai][0][m][0] * rr + bg0, g1 = acc[ai][0][m][1] * rr + bg1, u0 = acc[ai][1][m][0] * rr + bu0, u1 = acc[ai][1][m][1] * rr + bu1;
                u32x4 w; w.x = cvt_pk_bf16(silu_mul(g0[0], u0[0]), silu_mul(g0[1], u0[1])); w.y = cvt_pk_bf16(silu_mul(g0[2], u0[2]), silu_mul(g0[3], u0[3]));
                w.z = cvt_pk_bf16(silu_mul(g1[0], u1[0]), silu_mul(g1[1], u1[1])); w.w = cvt_pk_bf16(silu_mul(g1[2], u1[2]), silu_mul(g1[3], u1[3]));
                *(u32x4*)(O + (size_t)row * ldc + col0) = w; }
    }
};
template <bool PRE, bool ROPE> struct EpiSplit2 {
    static constexpr bool PERM = true, AFTER_DRAIN = false;
    bf16_t* p0; bf16_t* p1; bf16_t* p2; int ld0, ld1, ld2, n0, n1;
    const float* rowss; const float* bias; int N;
    const float* qgain; const float* kgain; float qscale; const float* ropetab; PG8_LAS float* xch;
    __device__ __forceinline__ void prefetch(PG8_LAS unsigned char* sp, const Unit& u, int wid, int lane) const {
        if (PRE) { const int seq = (u.pm < 256) ? (u.pm >> 3) : 32;
            const float* src = (wid < 4) ? rowss + u.pm * BM + wid * 64 : bias + (size_t)seq * N + u.pn * BM + (wid - 4) * 64;
            __builtin_amdgcn_global_load_lds((const unsigned*)(src + lane), (PG8_LAS unsigned*)(sp + wid * 256), 4, 0, 0); }
    }
    __device__ __forceinline__ void operator()(f32x4 (&acc)[2][2][4][2], const Unit& u, int wr, int wc, int fr, int fq, PG8_LAS unsigned char* sp) const {
        bf16_t* base; int ldc, colt;
        if (u.pn < n0) { base = p0; ldc = ld0; colt = u.pn * BM; }
        else if (u.pn < n1) { base = p1; ldc = ld1; colt = (u.pn - n0) * BM; }
        else { base = p2; ldc = ld2; colt = (u.pn - n1) * BM; }
        const bool isv = (u.pn >= n1), isq = (u.pn < n0);
        const int wid = wr * 4 + wc;
        const int row0 = u.pm * BM + wr * 64 + fr; const int col0 = colt + wc * 32 + 8 * fq;
        if (PRE) { const PG8_LAS float* spf = (const PG8_LAS float*)sp; const PG8_LAS float* bp = spf + 256 + wc * 32 + 8 * fq;
            const f32x4 b00 = *(const PG8_LAS f32x4*)(bp), b01 = *(const PG8_LAS f32x4*)(bp + 4), b10 = *(const PG8_LAS f32x4*)(bp + HALF), b11 = *(const PG8_LAS f32x4*)(bp + HALF + 4);
#pragma unroll
            for (int ai = 0; ai < 2; ++ai)
#pragma unroll
                for (int m = 0; m < 4; ++m) { const float rr = __builtin_amdgcn_rsqf(spf[ai * HALF + wr * 64 + m * 16 + fr] * (1.0f / 1024.0f) + EPI_EPS);
                    acc[ai][0][m][0] = acc[ai][0][m][0] * rr + b00; acc[ai][0][m][1] = acc[ai][0][m][1] * rr + b01; acc[ai][1][m][0] = acc[ai][1][m][0] * rr + b10; acc[ai][1][m][1] = acc[ai][1][m][1] * rr + b11; } }
        float part[16];
        if (!isv) {
#pragma unroll
            for (int ai = 0; ai < 2; ++ai)
#pragma unroll
                for (int m = 0; m < 4; ++m)
#pragma unroll
                    for (int bj = 0; bj < 2; ++bj) { const f32x4 a = acc[ai][bj][m][0], b = acc[ai][bj][m][1];
                        float s = (a[0] * a[0] + a[1] * a[1]) + (a[2] * a[2] + a[3] * a[3]) + (b[0] * b[0] + b[1] * b[1]) + (b[2] * b[2] + b[3] * b[3]);
                        s += __shfl_xor(s, 16); s += __shfl_xor(s, 32); const int idx = (ai * 4 + m) * 2 + bj; part[idx] = s;
                        if (fq == 0) xch[wid * 256 + idx * 16 + fr] = s; }
        }
        asm volatile("s_waitcnt lgkmcnt(0)" ::: "memory"); __builtin_amdgcn_s_barrier(); asm volatile("" ::: "memory");
        if (!isv) {
            const float* gp = (isq ? qgain : kgain) + 32 * (wc & 1) + 8 * fq; const float gs = isq ? qscale : 1.0f;
            const f32x4 gl0 = *(const f32x4*)(gp) * gs, gl1 = *(const f32x4*)(gp + 4) * gs;
#pragma unroll
            for (int ai = 0; ai < 2; ++ai)
#pragma unroll
                for (int m = 0; m < 4; ++m) { const int row = row0 + ai * HALF + m * 16;
                    f32x4 cs0 = {1.f, 0.f, 1.f, 0.f}, cs1 = {1.f, 0.f, 1.f, 0.f};
                    if (ROPE) { const int t = (row < 65536) ? (row & 2047) : (row - 65536); const int pos = (wc & 1) ? (t & 63) : (t >> 6);
                        const float* tp = ropetab + (size_t)(pos * 16 + 4 * fq) * 2; cs0 = *(const f32x4*)(tp); cs1 = *(const f32x4*)(tp + 4); }
                    bf16_t* rowp = base + (size_t)row * ldc + col0;
#pragma unroll
                    for (int bj = 0; bj < 2; ++bj) { const int idx = (ai * 4 + m) * 2 + bj;
                        const float tot = part[idx] + xch[(wid ^ 1) * 256 + idx * 16 + fr]; const float rinv = __builtin_amdgcn_rsqf(tot * (1.0f / 64.0f) + EPI_EPS);
                        f32x4 v0 = acc[ai][bj][m][0] * rinv * gl0, v1 = acc[ai][bj][m][1] * rinv * gl1;
                        if (ROPE) { const f32x4 a = v0, b = v1;
                            v0[0] = a[0] * cs0[0] - a[1] * cs0[1]; v0[1] = a[0] * cs0[1] + a[1] * cs0[0]; v0[2] = a[2] * cs0[2] - a[3] * cs0[3]; v0[3] = a[2] * cs0[3] + a[3] * cs0[2];
                            v1[0] = b[0] * cs1[0] - b[1] * cs1[1]; v1[1] = b[0] * cs1[1] + b[1] * cs1[0]; v1[2] = b[2] * cs1[2] - b[3] * cs1[3]; v1[3] = b[2] * cs1[3] + b[3] * cs1[2]; }
                        u32x4 w; w.x = cvt_pk_bf16(v0[0], v0[1]); w.y = cvt_pk_bf16(v0[2], v0[3]); w.z = cvt_pk_bf16(v1[0], v1[1]); w.w = cvt_pk_bf16(v1[2], v1[3]);
                        *(u32x4*)(rowp + bj * HALF) = w; } }
        } else {
#pragma unroll
            for (int ai = 0; ai < 2; ++ai)
#pragma unroll
                for (int m = 0; m < 4; ++m) { bf16_t* rowp = base + (size_t)(row0 + ai * HALF + m * 16) * ldc + col0;
#pragma unroll
                    for (int bj = 0; bj < 2; ++bj) { const f32x4 v0 = acc[ai][bj][m][0], v1 = acc[ai][bj][m][1];
                        u32x4 w; w.x = cvt_pk_bf16(v0[0], v0[1]); w.y = cvt_pk_bf16(v0[2], v0[3]); w.z = cvt_pk_bf16(v1[0], v1[1]); w.w = cvt_pk_bf16(v1[2], v1[3]);
                        *(u32x4*)(rowp + bj * HALF) = w; } }
        }
    }
};
template <class Epi, class Sched, bool ALIGN_EPI = false, bool SP2 = false>
__device__ __forceinline__ void gemm_phase(PG8_LAS unsigned char* lds, const Gemm g, const Sched& S, const Epi& E) {
    int tid_ = threadIdx.x; asm volatile("" : "+v"(tid_));
    const int tid = tid_, wid = __builtin_amdgcn_readfirstlane(tid >> 6), lane = tid & 63, wr = wid >> 2, wc = wid & 3, fr = lane & 15, fq = lane >> 4;
    const int K = g.K, nt = K / BK;
    unsigned voffA[2], voffB[2];
#pragma unroll
    for (int i = 0; i < 2; ++i) { int R, C; stage_rc(tid * 16 + i * 8192, R, C); const int Rb = Epi::PERM ? ((R & ~31) + perm32(R & 31)) : R;
        voffA[i] = (unsigned)(R * K + C) * 2u; voffB[i] = (unsigned)(Rb * K + C) * 2u; }
    const size_t kstep = (size_t)(BK * 2);
    const size_t hstep = (size_t)HALF * K * 2;
    const size_t tstep = 2 * hstep;
    const unsigned ldsw = (unsigned)wid * 1024u;
    const int aoff = lds_byte(wr * 64 + fr, fq * 8), boff = lds_byte(wc * 32 + fr, fq * 8);
#define PG8_SA(b, h) (((b) * 2 + (h)) * HTB)
#define PG8_SB(b, h) ((4 + (b) * 2 + (h)) * HTB)
#define PG8_STAGE(bufoff, gbase, voff) do { _Pragma("unroll") for (int _i = 0; _i < 2; ++_i) \
        __builtin_amdgcn_global_load_lds((const unsigned*)((const char*)(gbase) + (voff)[_i]), (PG8_LAS unsigned*)(lds + (bufoff) + ldsw + _i * 8192), 16, 0, 0); } while (0)
#define PG8_LDA(dst, b, h) do { _Pragma("unroll") for (int m = 0; m < 4; ++m) _Pragma("unroll") for (int k = 0; k < 2; ++k) dst[m][k] = *(const PG8_LAS bf16x8*)(lds + PG8_SA(b, h) + aoff + m * 2048 + k * 1024); } while (0)
#define PG8_LDB(dst, b, h) do { _Pragma("unroll") for (int n = 0; n < 2; ++n) _Pragma("unroll") for (int k = 0; k < 2; ++k) dst[n][k] = *(const PG8_LAS bf16x8*)(lds + PG8_SB(b, h) + boff + n * 2048 + k * 1024); } while (0)
#define PG8_MMA(ai, bj, At, Bt) do { __builtin_amdgcn_s_setprio(1); _Pragma("unroll") for (int m = 0; m < 4; ++m) _Pragma("unroll") for (int n = 0; n < 2; ++n) _Pragma("unroll") for (int k = 0; k < 2; ++k) \
        acc[ai][bj][m][n] = __builtin_amdgcn_mfma_f32_16x16x32_bf16(Bt[n][k], At[m][k], acc[ai][bj][m][n], 0, 0, 0); __builtin_amdgcn_s_setprio(0); } while (0)
#define PG8_WAIT_V(n) asm volatile("s_waitcnt vmcnt(" #n ")" ::: "memory")
#define PG8_WAIT_L(n) asm volatile("s_waitcnt lgkmcnt(" #n ")" ::: "memory")
#define PG8_BAR __builtin_amdgcn_s_barrier()
#define PG8_SCHED __builtin_amdgcn_sched_barrier(0)
    Unit cur, nxt; int ui = 0;
    if (!S.next(0, cur)) return;
    f32x4 acc[2][2][4][2];
#pragma unroll
    for (int a = 0; a < 2; ++a)
#pragma unroll
        for (int b = 0; b < 2; ++b)
#pragma unroll
            for (int m = 0; m < 4; ++m)
#pragma unroll
                for (int n = 0; n < 2; ++n) acc[a][b][m][n] = (f32x4){0.f, 0.f, 0.f, 0.f};
    bf16x8 At[4][2], B0[2][2], B1[2][2];
    const char* cA = (const char*)g.A + (size_t)cur.pm * tstep; const char* cB = (const char*)g.Bt + (size_t)cur.pn * tstep;
    S.a_ready(cur);
    if constexpr (SP2) {
        PG8_STAGE(PG8_SB(0, 0), cB, voffB); PG8_STAGE(PG8_SB(0, 1), cB + hstep, voffB); PG8_STAGE(PG8_SA(0, 0), cA, voffA); PG8_STAGE(PG8_SA(0, 1), cA + hstep, voffA);
        if (wr == 1) PG8_BAR;
        PG8_WAIT_V(2); PG8_BAR;
        PG8_STAGE(PG8_SB(1, 0), cB + kstep, voffB); PG8_STAGE(PG8_SA(1, 0), cA + kstep, voffA); PG8_STAGE(PG8_SB(1, 1), cB + hstep + kstep, voffB);
        PG8_WAIT_V(6); PG8_BAR;
    } else {
        PG8_STAGE(PG8_SB(0, 0), cB, voffB); PG8_STAGE(PG8_SA(0, 0), cA, voffA); PG8_STAGE(PG8_SB(0, 1), cB + hstep, voffB); PG8_STAGE(PG8_SA(0, 1), cA + hstep, voffA);
        if (wr == 1) PG8_BAR;
        PG8_WAIT_V(4); PG8_BAR;
        PG8_STAGE(PG8_SB(1, 0), cB + kstep, voffB); PG8_STAGE(PG8_SA(1, 0), cA + kstep, voffA); PG8_STAGE(PG8_SB(1, 1), cB + hstep + kstep, voffB);
        PG8_WAIT_V(6); PG8_BAR;
    }
    for (;;) {
        const bool has_next = S.next(ui + 1, nxt);
        const char* nA = has_next ? (const char*)g.A + (size_t)nxt.pm * tstep : cA; const char* nB = has_next ? (const char*)g.Bt + (size_t)nxt.pn * tstep : cB;
        for (int t = 0; t < nt; t += 2) {
            const bool last = (t == nt - 2);
            const char* a1 = cA + (size_t)(t + 1) * kstep;
            const char* a2 = last ? nA : cA + (size_t)(t + 2) * kstep; const char* b2 = last ? nB : cB + (size_t)(t + 2) * kstep;
            const char* a3 = a2 + kstep; const char* b3 = b2 + kstep;
            if (last && has_next) S.a_ready(nxt);
            if (last) E.prefetch(lds + 139264, cur, wid, lane);
            if constexpr (SP2) {
            PG8_LDB(B0, 0, 0); PG8_LDB(B1, 0, 1); PG8_SCHED; PG8_LDA(At, 0, 0); PG8_STAGE(PG8_SA(1, 1), a1 + hstep, voffA);
            PG8_WAIT_V(8); PG8_WAIT_L(0); PG8_BAR; PG8_MMA(0, 0, At, B0); PG8_MMA(0, 1, At, B1); PG8_BAR; PG8_SCHED;
            PG8_LDA(At, 0, 1); PG8_STAGE(PG8_SB(0, 0), b2, voffB); PG8_STAGE(PG8_SB(0, 1), b2 + hstep, voffB); PG8_STAGE(PG8_SA(0, 0), a2, voffA);
            PG8_WAIT_V(8); PG8_WAIT_L(0); PG8_BAR; PG8_MMA(1, 0, At, B0); PG8_MMA(1, 1, At, B1); PG8_BAR; PG8_SCHED;
            PG8_LDB(B0, 1, 0); PG8_LDB(B1, 1, 1); PG8_SCHED; PG8_LDA(At, 1, 0); PG8_STAGE(PG8_SA(0, 1), a2 + hstep, voffA);
            PG8_WAIT_V(8); PG8_WAIT_L(0); PG8_BAR; PG8_MMA(0, 0, At, B0); PG8_MMA(0, 1, At, B1); PG8_BAR; PG8_SCHED;
            PG8_LDA(At, 1, 1); PG8_STAGE(PG8_SB(1, 0), b3, voffB); PG8_STAGE(PG8_SB(1, 1), b3 + hstep, voffB); PG8_STAGE(PG8_SA(1, 0), a3, voffA);
            PG8_WAIT_V(8); PG8_WAIT_L(0); PG8_BAR; PG8_MMA(1, 0, At, B0); PG8_MMA(1, 1, At, B1); PG8_BAR; PG8_SCHED;
            } else {
            PG8_LDB(B0, 0, 0); PG8_SCHED; PG8_LDA(At, 0, 0); PG8_STAGE(PG8_SA(1, 1), a1 + hstep, voffA);
            PG8_WAIT_L(8); PG8_BAR; PG8_WAIT_L(0); PG8_MMA(0, 0, At, B0); PG8_BAR; PG8_SCHED;
            PG8_LDB(B1, 0, 1); PG8_STAGE(PG8_SB(0, 0), b2, voffB);
            PG8_BAR; PG8_WAIT_L(0); PG8_MMA(0, 1, At, B1); PG8_BAR;
            PG8_LDA(At, 0, 1); PG8_STAGE(PG8_SA(0, 0), a2, voffA);
            PG8_BAR; PG8_WAIT_L(0); PG8_MMA(1, 0, At, B0); PG8_BAR; PG8_SCHED;
            PG8_STAGE(PG8_SB(0, 1), b2 + hstep, voffB);
            PG8_WAIT_V(6); PG8_BAR; PG8_MMA(1, 1, At, B1); PG8_BAR;
            PG8_LDB(B0, 1, 0); PG8_SCHED; PG8_LDA(At, 1, 0); PG8_STAGE(PG8_SA(0, 1), a2 + hstep, voffA);
            PG8_WAIT_L(8); PG8_BAR; PG8_WAIT_L(0); PG8_MMA(0, 0, At, B0); PG8_BAR; PG8_SCHED;
            PG8_LDB(B1, 1, 1); PG8_STAGE(PG8_SB(1, 0), b3, voffB);
            PG8_BAR; PG8_WAIT_L(0); PG8_MMA(0, 1, At, B1); PG8_BAR;
            PG8_LDA(At, 1, 1); PG8_STAGE(PG8_SA(1, 0), a3, voffA);
            PG8_BAR; PG8_WAIT_L(0); PG8_MMA(1, 0, At, B0); PG8_BAR; PG8_SCHED;
            PG8_STAGE(PG8_SB(1, 1), b3 + hstep, voffB);
            PG8_WAIT_V(6); PG8_BAR; PG8_MMA(1, 1, At, B1); PG8_BAR;
            }
        }
        if constexpr (ALIGN_EPI) { if (wr == 0) PG8_BAR; }
        if constexpr (!Epi::AFTER_DRAIN) { E(acc, cur, wr, wc, fr, fq, lds + 139264); S.done(cur); }
        if (!has_next) break;
#pragma unroll
        for (int a = 0; a < 2; ++a)
#pragma unroll
            for (int b = 0; b < 2; ++b)
#pragma unroll
                for (int m = 0; m < 4; ++m)
#pragma unroll
                    for (int n = 0; n < 2; ++n) acc[a][b][m][n] = (f32x4){0.f, 0.f, 0.f, 0.f};
        cur = nxt; cA = nA; cB = nB; ++ui;
        if constexpr (ALIGN_EPI) { if (wr == 1) PG8_BAR; }
    }
    PG8_WAIT_V(0);
    if constexpr (!ALIGN_EPI) { if (wr == 0) PG8_BAR; }
    PG8_BAR;
    if constexpr (Epi::AFTER_DRAIN) { E.fused(acc, cur, wr, wc, fr, fq, lds, wid, lane); S.done(cur); }
#undef PG8_SA
#undef PG8_SB
#undef PG8_STAGE
#undef PG8_LDA
#undef PG8_LDB
#undef PG8_MMA
#undef PG8_WAIT_V
#undef PG8_WAIT_L
#undef PG8_BAR
#undef PG8_SCHED
}
}
#ifndef PG8_SP2
#define PG8_SP2 true
#endif
#ifndef PG8_ALIGN
#define PG8_ALIGN true
#endif
#include <hip/hip_bf16.h>
#include <cmath>
namespace attn_body {
using bf16=__hip_bfloat16;
using bf16x8=__attribute__((ext_vector_type(8)))short;
using s16x4=__attribute__((ext_vector_type(4)))short;
using f32x16=__attribute__((ext_vector_type(16)))float;
using u32x4=__attribute__((ext_vector_type(4)))unsigned;
constexpr int D=64;
constexpr int NW=8,QBLK=32,QB=QBLK*NW,KVBLK=64;
constexpr int ATTN_UNIT_ROWS=QB;
__device__ __forceinline__ int crow(int r,int hi){return (r&3)+8*(r>>2)+4*hi;}
#define SBAR() __builtin_amdgcn_sched_barrier(0)
constexpr int NSLOT=3, SLOTB=8192;
constexpr int LDS_K=0, LDS_V=NSLOT*SLOTB, LDS_WS=2*NSLOT*SLOTB, LDS_OST=LDS_WS+NW*64*4, LDS_BT=LDS_OST+NW*4096, LDS_BYTES=LDS_BT+768*4;
constexpr float C2=0.125f*1.4426950408889634f;
__device__ __forceinline__ void glds16(const void*gsrc,unsigned lds_dst){unsigned keep;
  asm volatile("s_mov_b32 %0, m0\n\ts_mov_b32 m0, %2\n\ts_nop 0\n\tglobal_load_lds_dwordx4 %1, off\n\ts_mov_b32 m0, %0":"=&s"(keep):"v"(gsrc),"s"(lds_dst):"memory");}
__device__ __forceinline__ void glds16s(const void*sbase,unsigned voff,unsigned lds_dst){unsigned keep;
  asm volatile("s_mov_b32 %0, m0\n\ts_mov_b32 m0, %3\n\ts_nop 0\n\tglobal_load_lds_dwordx4 %1, %2\n\ts_mov_b32 m0, %0":"=&s"(keep):"v"(voff),"s"(sbase),"s"(lds_dst):"memory");}
__device__ __forceinline__ float max3f(float a,float b,float c){float r;asm("v_max3_f32 %0, %1, %2, %3":"=v"(r):"v"(a),"v"(b),"v"(c));return r;}
__device__ __forceinline__ float max2f(float a,float b){float r;asm("v_max_f32_e32 %0, %1, %2":"=v"(r):"v"(a),"v"(b));return r;}
__device__ __forceinline__ float fadd_s(float a,float b){float r;asm("v_add_f32_e32 %0, %1, %2":"=v"(r):"v"(a),"v"(b));return r;}
__device__ __forceinline__ float fsub_s(float a,float b){float r;asm("v_sub_f32_e32 %0, %1, %2":"=v"(r):"v"(a),"v"(b));return r;}
typedef float f32x2_t __attribute__((ext_vector_type(2))); typedef __bf16 bf16x2_t __attribute__((ext_vector_type(2)));
__device__ __forceinline__ unsigned cvtpk_s(float lo,float hi){f32x2_t v={lo,hi};bf16x2_t b=__builtin_convertvector(v,bf16x2_t);return __builtin_bit_cast(unsigned,b);}
#define WAIT_BAR(N) asm volatile("s_waitcnt vmcnt(" #N ") lgkmcnt(0)\n\ts_barrier":::"memory")

__device__ __forceinline__ void qkt(f32x16&p0,f32x16&p1,const char*Kslot,const bf16x8*qr,const f32x16&negm,int r32,int hi){
  const char*kb=Kslot+hi*1024+r32*16;
  #pragma unroll
  for(int d0=0;d0<4;++d0){
    const bf16x8 b0=*reinterpret_cast<const bf16x8*>(kb+d0*2048);
    const bf16x8 b1=*reinterpret_cast<const bf16x8*>(kb+d0*2048+512);
    if(d0==0){p0=__builtin_amdgcn_mfma_f32_32x32x16_bf16(b0,qr[0],negm,0,0,0);p1=__builtin_amdgcn_mfma_f32_32x32x16_bf16(b1,qr[0],negm,0,0,0);}
    else{p0=__builtin_amdgcn_mfma_f32_32x32x16_bf16(b0,qr[d0],p0,0,0,0);p1=__builtin_amdgcn_mfma_f32_32x32x16_bf16(b1,qr[d0],p1,0,0,0);}}
}
typedef __attribute__((address_space(3))) const char* lds_cptr;
typedef short v4i16_t __attribute__((ext_vector_type(4)));
__device__ __forceinline__ void kload8(bf16x8*kf,lds_cptr kp){
  kf[0]=*(const __attribute__((address_space(3))) bf16x8*)(kp);      kf[1]=*(const __attribute__((address_space(3))) bf16x8*)(kp+512);
  kf[2]=*(const __attribute__((address_space(3))) bf16x8*)(kp+2048); kf[3]=*(const __attribute__((address_space(3))) bf16x8*)(kp+2560);
  kf[4]=*(const __attribute__((address_space(3))) bf16x8*)(kp+4096); kf[5]=*(const __attribute__((address_space(3))) bf16x8*)(kp+4608);
  kf[6]=*(const __attribute__((address_space(3))) bf16x8*)(kp+6144); kf[7]=*(const __attribute__((address_space(3))) bf16x8*)(kp+6656);
}
__device__ __forceinline__ void kload2(bf16x8*kf,lds_cptr kp,int j){ kf[2*j]=*(const __attribute__((address_space(3))) bf16x8*)(kp+j*2048); kf[2*j+1]=*(const __attribute__((address_space(3))) bf16x8*)(kp+j*2048+512); }
__device__ __forceinline__ s16x4 vtr(lds_cptr p){ return __builtin_bit_cast(s16x4,__builtin_amdgcn_ds_read_tr16_b64_v4i16((__attribute__((address_space(3))) v4i16_t*)p)); }
__device__ __forceinline__ float rowmax(const f32x16&p0,const f32x16&p1){
  float a=max3f(p0[0],p0[1],p1[0]),b=max3f(p0[2],p0[3],p1[1]);a=max3f(a,p1[2],p1[3]);
  #pragma unroll
  for(int r=4;r<16;r+=4){a=max3f(a,p0[r],p0[r+1]);b=max3f(b,p0[r+2],p0[r+3]);a=max3f(a,p1[r],p1[r+1]);b=max3f(b,p1[r+2],p1[r+3]);}
  const float m=max2f(a,b);
  auto rr=__builtin_amdgcn_permlane32_swap(__float_as_uint(m),__float_as_uint(m),false,false);
  return max2f(__uint_as_float(rr[0]),__uint_as_float(rr[1]));
}
__device__ __forceinline__ void pv(f32x16*o,int vb,bf16x8 pa0,bf16x8 pa1,bf16x8 pa2,bf16x8 pa3){
  #pragma unroll
  for(int d0=0;d0<2;++d0){s16x4 lo[4],hi[4];
    #pragma unroll
    for(int ks=0;ks<4;++ks){
      asm volatile("ds_read_b64_tr_b16 %0,%1 offset:%c2":"=&v"(lo[ks]):"v"(vb),"i"(d0*4096+ks*1024):"memory");
      asm volatile("ds_read_b64_tr_b16 %0,%1 offset:%c2":"=&v"(hi[ks]):"v"(vb),"i"(d0*4096+ks*1024+512):"memory");}
    asm volatile("s_waitcnt lgkmcnt(0)":::"memory");SBAR();
    #define PK(k) (bf16x8){lo[k][0],lo[k][1],lo[k][2],lo[k][3],hi[k][0],hi[k][1],hi[k][2],hi[k][3]}
    o[d0]=__builtin_amdgcn_mfma_f32_32x32x16_bf16(pa0,PK(0),o[d0],0,0,0);
    o[d0]=__builtin_amdgcn_mfma_f32_32x32x16_bf16(pa1,PK(1),o[d0],0,0,0);
    o[d0]=__builtin_amdgcn_mfma_f32_32x32x16_bf16(pa2,PK(2),o[d0],0,0,0);
    o[d0]=__builtin_amdgcn_mfma_f32_32x32x16_bf16(pa3,PK(3),o[d0],0,0,0);
    #undef PK
  }
}

#ifndef ATTN_STORE16
#define ATTN_STORE16(p,v) (*(u32x4*)(p)=(v))
#endif
template<int VH> struct AttnLds { static constexpr int KSL=8192, VSL=8192*VH, L_K=0, L_V=4*KSL, L_WS=L_V+3*VSL, L_BT=L_WS+NW*64*4, BYTES=L_BT+768*4; };
template<int VH,bool HAS_BIAS,int MODE> __device__ __forceinline__ void attn_unit2(const bf16*Qb,int qp,const bf16*__restrict__ Kb,int kp,const bf16*__restrict__ Vb,int vp,bf16*Ob,int op,int q0,int NT,const float*relb,char*shm,float lam,const float*subg,float gmul){
  typedef AttnLds<VH> LM; constexpr int KSL=LM::KSL, VSL=LM::VSL;
  int tid_=threadIdx.x; asm volatile("":"+v"(tid_));
  const int tid=tid_,lane=tid&63,r32=lane&31,hi=lane>>5; const int wid=__builtin_amdgcn_readfirstlane(tid>>6);
  const bf16*Qw=Qb+(long)(q0+wid*QBLK)*qp;
  const unsigned lds0=(unsigned)(uintptr_t)shm;
  const lds_cptr shm3=(lds_cptr)shm;
  float*wsf=(float*)(shm+LM::L_WS)+wid*64;
  const unsigned ksrc=(unsigned)(lane*kp+wid*8)*2u;
  const unsigned vsrc=(unsigned)((16*(wid&3)+(lane>>2))*vp+(wid>>2)*32+(lane&3)*8)*2u;
  const unsigned kdst=lds0+LM::L_K+wid*1024, vdst=lds0+LM::L_V+wid*1024;
  #define DMA_K(t,slot) glds16s(Kb+(long)(t)*KVBLK*kp,ksrc,(unsigned)__builtin_amdgcn_readfirstlane(kdst+(slot)))
  #define DMA_V(t,slot) do{ glds16s(Vb+(long)(t)*KVBLK*vp,vsrc,(unsigned)__builtin_amdgcn_readfirstlane(vdst+(slot))); \
      if(VH==2) glds16s(Vb+(long)(t)*KVBLK*vp+64,vsrc,(unsigned)__builtin_amdgcn_readfirstlane(vdst+(slot)+8192)); }while(0)
  const int vb0=(int)(lds0+LM::L_V)+((lane>>4)&1)*32+(lane&3)*8+(4*hi+((lane&15)>>2))*64;
  const lds_cptr kp0=shm3+LM::L_K+hi*1024+r32*16;
  const lds_cptr vp0=shm3+LM::L_V+((lane>>4)&1)*32+(lane&3)*8+(4*hi+((lane&15)>>2))*64;
  const int qw_=q0+32*wid; const int tn0=HAS_BIAS?(qw_>=90?((qw_-90)>>6):0):0, tn1=HAS_BIAS?(((qw_+185)>>6)<NT?((qw_+185)>>6):NT):0;
  float cb=0.f,ca=0.f;
  typedef __attribute__((address_space(3))) float lds_f32;
  typedef __attribute__((address_space(3))) char* lds_ptr_;
  lds_f32* btab=(lds_f32*)((lds_ptr_)shm)+LM::L_BT/4;
  if(HAS_BIAS){ const float L2E=1.4426950408889634f; cb=L2E*relb[15*8]; ca=L2E*relb[31*8];
    for(int i=tid;i<768;i+=512){ const int rel=i-384; const int n=rel<0?-rel:rel; int bk=n<8?n:(8+(31-__builtin_clz((unsigned)(n*n)))-6); if(n>=8&&bk>15)bk=15; if(rel>0)bk+=16; btab[i]=L2E*relb[bk*8]; } }
  const int lanebias=-q0-32*wid-r32+4*hi+384;
  #define CREG(tt) (HAS_BIAS?(((tt)<tn0)?cb:(((tt)<tn1)?0.f:ca)):0.f)
  #define BIASADD(P0,P1,t) do{ if(HAS_BIAS&&(t)>=tn0&&(t)<tn1){ const lds_f32*bp_=btab+(64*(t)+lanebias); \
    _Pragma("unroll") for(int r=0;r<16;++r){ P0[r]+=bp_[(r&3)+8*(r>>2)]; P1[r]+=bp_[(r&3)+8*(r>>2)+32]; } } }while(0)
  #define RSCALE(t) do{ if(HAS_BIAS&&((t)==tn0||(t)==tn1)){ const float f_=__builtin_amdgcn_exp2f(CREG((t)-1)-CREG(t)); l_reg*=f_; \
    _Pragma("unroll") for(int d_=0;d_<2*VH;++d_) _Pragma("unroll") for(int r=0;r<16;++r)o[d_][r]*=f_; } }while(0)
  DMA_K(0,0);DMA_V(0,0);DMA_K(1,KSL);
  bf16x8 qr[4];
  #pragma unroll
  for(int d0=0;d0<4;++d0)qr[d0]=*reinterpret_cast<const bf16x8*>(&Qw[(long)r32*qp+d0*16+hi*8]);
  DMA_K(2,2*KSL);
  float l_reg=0.f;f32x16 o[2*VH];
  #pragma unroll
  for(int d_=0;d_<2*VH;++d_)o[d_]=f32x16{};
  const f32x16 zero16=f32x16{};
  f32x16 pA0,pA1,pB0,pB1; bf16x8 kf[4];
  int sv_prev=0,sv_cur=0,sv_next=VSL;
  #define ROT() do{sv_prev=sv_cur;sv_cur=sv_next;sv_next=(sv_next==2*VSL)?0:sv_next+VSL;}while(0)
  #define KLD(p) (*(const __attribute__((address_space(3))) bf16x8*)(p))
  #define KPRE(tn) do{ const lds_cptr kn_=kp0+(((tn)&3)*KSL); kf[0]=KLD(kn_); kf[1]=KLD(kn_+512); kf[2]=KLD(kn_+2048); kf[3]=KLD(kn_+2560); }while(0)
  if(VH==1){WAIT_BAR(3);}else{WAIT_BAR(4);}
  qkt(pA0,pA1,shm+LM::L_K,qr,zero16,r32,hi);
  BIASADD(pA0,pA1,0);
  _Pragma("unroll") for(int r=0;r<16;++r){pA0[r]=__builtin_amdgcn_exp2f(pA0[r]);pA1[r]=__builtin_amdgcn_exp2f(pA1[r]);}
  WAIT_BAR(0);
  DMA_K(3,3*KSL);DMA_V(1,VSL);
  ROT();
  KPRE(1);
  s16x4 vlo[8],vhi[8]; u32x4 pw0,pw1,pw2,pw3;
  #define PKW(P,B) cvtpk_s(P[B],P[B+1])
  #define PAF(k) __builtin_bit_cast(bf16x8,pw##k)
  #define VFR(i) (bf16x8){vlo[i][0],vlo[i][1],vlo[i][2],vlo[i][3],vhi[i][0],vhi[i][1],vhi[i][2],vhi[i][3]}
  #define PIN(x) asm volatile("":"+v"(x))
  #define MF(a,b,c) __builtin_amdgcn_mfma_f32_32x32x16_bf16(a,b,c,0,0,0)
  #define GAPA(MFX,A0,A1,A2,A3,W0,W1,PW) do{ MFX; sacc+=A0; sacc+=A1; sacc+=A2; sacc+=A3; PIN(sacc); W0; W1; PIN(PW); SBAR(); }while(0)
  #define EX(v) __builtin_amdgcn_exp2f(v)
  #define GAPB4(MFX,X,B) do{ MFX; X[B]=EX(X[B]); X[B+1]=EX(X[B+1]); X[B+2]=EX(X[B+2]); X[B+3]=EX(X[B+3]); PIN(X); SBAR(); }while(0)
  #define GAPB2(MFX,X,B) do{ MFX; X[B]=EX(X[B]); X[B+1]=EX(X[B+1]); PIN(X); SBAR(); }while(0)
  #define VRD(i,hv) do{ vlo[i]=vtr(vp_+((hv)*8192+((i)>>2)*4096+((i)&3)*1024)); vhi[i]=vtr(vp_+((hv)*8192+((i)>>2)*4096+((i)&3)*1024+512)); }while(0)
  #define STEP(C0,C1,P0,P1,t,GK,GV,GL) do{ SBAR(); \
    const lds_cptr vp_=vp0+sv_prev; const lds_cptr kq_=kp0+(((t)&3)*KSL); \
    VRD(0,0); SBAR(); float sacc=(P0[0]+P0[1]); \
    GAPA(C0=MF(kf[0],qr[0],zero16), P0[2],P0[3],P0[4],P0[5],     pw0[0]=PKW(P0,0), pw0[1]=PKW(P0,2), pw0); \
    VRD(4,0); SBAR(); GAPA(C1=MF(kf[1],qr[0],zero16), P0[6],P0[7],P0[8],P0[9],     pw0[2]=PKW(P0,4), pw0[3]=PKW(P0,6), pw0); \
    kf[0]=KLD(kq_+4096); kf[1]=KLD(kq_+4608); SBAR(); \
    VRD(1,0); SBAR(); GAPA(C0=MF(kf[2],qr[1],C0),   P0[10],P0[11],P0[12],P0[13], pw1[0]=PKW(P0,8), pw1[1]=PKW(P0,10), pw1); \
    VRD(5,0); SBAR(); GAPA(C1=MF(kf[3],qr[1],C1),   P0[14],P0[15],P1[0],P1[1],   pw1[2]=PKW(P0,12),pw1[3]=PKW(P0,14), pw1); \
    kf[2]=KLD(kq_+6144); kf[3]=KLD(kq_+6656); SBAR(); \
    VRD(2,0); SBAR(); GAPA(C0=MF(kf[0],qr[2],C0),   P1[2],P1[3],P1[4],P1[5],     pw2[0]=PKW(P1,0), pw2[1]=PKW(P1,2), pw2); \
    VRD(6,0); SBAR(); GAPA(C1=MF(kf[1],qr[2],C1),   P1[6],P1[7],P1[8],P1[9],     pw2[2]=PKW(P1,4), pw2[3]=PKW(P1,6), pw2); \
    VRD(3,0); SBAR(); GAPA(C0=MF(kf[2],qr[3],C0),   P1[10],P1[11],P1[12],P1[13], pw3[0]=PKW(P1,8), pw3[1]=PKW(P1,10), pw3); \
    VRD(7,0); SBAR(); GAPA(C1=MF(kf[3],qr[3],C1),   P1[14],P1[15],0.f,0.f,       pw3[2]=PKW(P1,12),pw3[3]=PKW(P1,14), pw3); \
    l_reg+=sacc; \
    if(GK){DMA_K((t)+3,(((t)+3)&3)*KSL);} if(GV){DMA_V((t)+1,sv_next);} \
    BIASADD(C0,C1,t); SBAR(); \
    if(VH==1){ \
      GAPB4(o[0]=MF(PAF(0),VFR(0),o[0]), C0,0); \
      GAPB4(o[1]=MF(PAF(0),VFR(4),o[1]), C0,4); \
      GAPB4(o[0]=MF(PAF(1),VFR(1),o[0]), C0,8); \
      GAPB4(o[1]=MF(PAF(1),VFR(5),o[1]), C0,12); \
      if(GL){ KPRE((t)+1); SBAR(); } \
      GAPB4(o[0]=MF(PAF(2),VFR(2),o[0]), C1,0); \
      GAPB4(o[1]=MF(PAF(2),VFR(6),o[1]), C1,4); \
      GAPB4(o[0]=MF(PAF(3),VFR(3),o[0]), C1,8); \
      GAPB4(o[1]=MF(PAF(3),VFR(7),o[1]), C1,12); \
    } else { \
      GAPB2(o[0]=MF(PAF(0),VFR(0),o[0]), C0,0);  VRD(0,1); SBAR(); \
      GAPB2(o[1]=MF(PAF(0),VFR(4),o[1]), C0,2);  VRD(4,1); SBAR(); \
      GAPB2(o[0]=MF(PAF(1),VFR(1),o[0]), C0,4);  VRD(1,1); SBAR(); \
      GAPB2(o[1]=MF(PAF(1),VFR(5),o[1]), C0,6);  VRD(5,1); SBAR(); \
      GAPB2(o[0]=MF(PAF(2),VFR(2),o[0]), C0,8);  VRD(2,1); SBAR(); \
      GAPB2(o[1]=MF(PAF(2),VFR(6),o[1]), C0,10); VRD(6,1); SBAR(); \
      GAPB2(o[0]=MF(PAF(3),VFR(3),o[0]), C0,12); VRD(3,1); SBAR(); \
      GAPB2(o[1]=MF(PAF(3),VFR(7),o[1]), C0,14); VRD(7,1); SBAR(); \
      if(GL){ KPRE((t)+1); SBAR(); } \
      GAPB2(o[2*(VH-1)]=MF(PAF(0),VFR(0),o[2*(VH-1)]), C1,0); \
      GAPB2(o[2*(VH-1)+1]=MF(PAF(0),VFR(4),o[2*(VH-1)+1]), C1,2); \
      GAPB2(o[2*(VH-1)]=MF(PAF(1),VFR(1),o[2*(VH-1)]), C1,4); \
      GAPB2(o[2*(VH-1)+1]=MF(PAF(1),VFR(5),o[2*(VH-1)+1]), C1,6); \
      GAPB2(o[2*(VH-1)]=MF(PAF(2),VFR(2),o[2*(VH-1)]), C1,8); \
      GAPB2(o[2*(VH-1)+1]=MF(PAF(2),VFR(6),o[2*(VH-1)+1]), C1,10); \
      GAPB2(o[2*(VH-1)]=MF(PAF(3),VFR(3),o[2*(VH-1)]), C1,12); \
      GAPB2(o[2*(VH-1)+1]=MF(PAF(3),VFR(7),o[2*(VH-1)+1]), C1,14); \
    } \
    }while(0)
  #define WAITFULL() do{ if(VH==1){WAIT_BAR(2);}else{WAIT_BAR(3);} }while(0)
  #define ENDW(tt) do{ if((tt)+3<NT){WAITFULL();} else if((tt)+2<NT){ if(VH==1){WAIT_BAR(1);}else{WAIT_BAR(2);} } else {WAIT_BAR(0);} }while(0)
  int t=1;
  for(;t+5<NT;t+=2){
    STEP(pB0,pB1,pA0,pA1,t,true,true,true);     WAITFULL(); RSCALE(t);   ROT();
    STEP(pA0,pA1,pB0,pB1,t+1,true,true,true);   WAITFULL(); RSCALE(t+1); ROT();
  }
  for(;t+1<NT;t+=2){
    STEP(pB0,pB1,pA0,pA1,t,(t+3<NT),(t+1<NT),(t+1<NT));       ENDW(t);   RSCALE(t);   ROT();
    STEP(pA0,pA1,pB0,pB1,t+1,(t+4<NT),(t+2<NT),(t+2<NT));     ENDW(t+1); RSCALE(t+1); ROT();
  }
  STEP(pB0,pB1,pA0,pA1,NT-1,false,false,false); RSCALE(NT-1);
  { float sacc=pB0[0]+pB0[1]; _Pragma("unroll") for(int r=2;r<16;++r)sacc+=pB0[r]; _Pragma("unroll") for(int r=0;r<16;++r)sacc+=pB1[r]; l_reg+=sacc;
    pw0=(u32x4){PKW(pB0,0),PKW(pB0,2),PKW(pB0,4),PKW(pB0,6)};pw1=(u32x4){PKW(pB0,8),PKW(pB0,10),PKW(pB0,12),PKW(pB0,14)};pw2=(u32x4){PKW(pB1,0),PKW(pB1,2),PKW(pB1,4),PKW(pB1,6)};pw3=(u32x4){PKW(pB1,8),PKW(pB1,10),PKW(pB1,12),PKW(pB1,14)};
    SBAR(); pv(o,vb0+sv_cur,PAF(0),PAF(1),PAF(2),PAF(3)); if(VH==2){ SBAR(); pv(o+2*(VH-1),vb0+sv_cur+8192,PAF(0),PAF(1),PAF(2),PAF(3)); } }
  #undef PKW
  #undef PAF
  #undef VFR
  #undef PIN
  #undef MF
  #undef GAPA
  #undef GAPB4
  #undef GAPB2
  #undef EX
  #undef VRD
  #undef STEP
  #undef ENDW
  #undef WAITFULL
  #undef KLD
  #undef KPRE
  {auto rr=__builtin_amdgcn_permlane32_swap(__float_as_uint(l_reg),__float_as_uint(l_reg),false,false);l_reg=__uint_as_float(rr[0])+__uint_as_float(rr[1]);}
  if(hi==0)wsf[32+r32]=l_reg;
  asm volatile("s_waitcnt lgkmcnt(0)\n\ts_barrier":::"memory");
  float rli[16];
  #pragma unroll
  for(int r=0;r<16;++r)rli[r]=__builtin_amdgcn_rcpf(wsf[32+crow(r,hi)]);
  bf16*Ow=Ob+(long)(q0+wid*QBLK)*op;
  typedef __attribute__((address_space(3))) unsigned lds_u32;
  lds_u32* park=(lds_u32*)((lds_ptr_)shm+LM::BYTES)+tid;
  if(MODE==1){
    #pragma unroll
    for(int d0=0;d0<2*VH;++d0)
      #pragma unroll
      for(int r=0;r<16;r+=2)park[(d0*8+(r>>1))*512]=cvtpk_s(o[d0][r]*rli[r],o[d0][r+1]*rli[r+1]);
  } else {
    if(MODE==2){
      #pragma unroll
      for(int d0=0;d0<2*VH;++d0)
        #pragma unroll
        for(int r=0;r<16;r+=2){ const unsigned w_=park[(d0*8+(r>>1))*512];
          o[d0][r]=__uint_as_float(w_<<16)-lam*(o[d0][r]*rli[r]); o[d0][r+1]=__uint_as_float(w_&0xffff0000u)-lam*(o[d0][r+1]*rli[r+1]); }
      float gsub[2*VH];
      #pragma unroll
      for(int d0=0;d0<2*VH;++d0)gsub[d0]=subg[d0*32+r32]*gmul;
      #pragma unroll
      for(int r=0;r<16;++r){ float ss=0.f;
        #pragma unroll
        for(int d0=0;d0<2*VH;++d0)ss+=o[d0][r]*o[d0][r];
        ss+=__shfl_xor(ss,1);ss+=__shfl_xor(ss,2);ss+=__shfl_xor(ss,4);ss+=__shfl_xor(ss,8);ss+=__shfl_xor(ss,16);
        const float rs=__builtin_amdgcn_rsqf(ss*(1.0f/(64.f*VH))+1e-6f);
        #pragma unroll
        for(int d0=0;d0<2*VH;++d0)o[d0][r]=o[d0][r]*rs*gsub[d0];
        rli[r]=1.0f; }
    }
    { bf16*stg=(bf16*)(shm)+wid*(2048*VH);
      #pragma unroll
      for(int r=0;r<16;++r){const int orow=crow(r,hi);
        #pragma unroll
        for(int d0=0;d0<2*VH;++d0)stg[orow*(64*VH)+d0*32+r32]=__float2bfloat16(o[d0][r]*rli[r]);}
      asm volatile("s_waitcnt lgkmcnt(0)":::"memory");
      #pragma unroll
      for(int i=0;i<4*VH;++i){const int row=(VH==1)?(i*8+(lane>>3)):(i*4+(lane>>4)),ch=(VH==1)?(lane&7):(lane&15); const u32x4 v=*(const u32x4*)(stg+row*(64*VH)+ch*8); ATTN_STORE16(Ow+(long)row*op+ch*8,v);} }
  }
  asm volatile("s_waitcnt lgkmcnt(0)\n\ts_barrier":::"memory");
  #undef DMA_K
  #undef DMA_V
  #undef BIASADD
  #undef CREG
  #undef RSCALE
  #undef ROT
}
#undef SBAR
#undef WAIT_BAR
}
constexpr int NWAVES = 8;
constexpr int DM = 1024, MP = 65536, MS = 16384, MT = MP + MS, NSEQ = 33, LP = 2048, LS = 16384, DFF = 2816, NMOD = 6144;
constexpr float EPS = 1e-6f;
constexpr float LAMBDA_INIT1 = 0.35550907f;
constexpr float QSCALE = 0.125f * 1.4426950408889634f;
constexpr size_t MiB = 1u << 20;
constexpr size_t WS_BAR = 0, BAR_BYTES = 16384;
constexpr size_t WS_MOD = 1 * MiB;
constexpr size_t WS_ROPE = 3 * MiB;
constexpr size_t WS_WQKVA = 4 * MiB, WS_WOA = 7 * MiB, WS_WQKVB = 9 * MiB, WS_WOB = 15 * MiB, WS_WGU = 17 * MiB  , WS_WD = 39 * MiB  ;
constexpr size_t WS_BV = 51 * MiB;
constexpr size_t WS_RSS = 54 * MiB;
constexpr int BV_GU0 = 0, BV_QKV1 = 33 * 5632, BV_GU1 = 33 * 5632 + 33 * 3072;
constexpr size_t WS_H = 64 * MiB, WS_Q = 224 * MiB, WS_K = 384 * MiB, WS_V = 544 * MiB, WS_O = 704 * MiB, WS_END = 864 * MiB;
constexpr size_t WS_ACT = WS_Q;
constexpr size_t WS_OC0 = WS_H, WS_OC1 = WS_O;
static_assert(WS_WD + 2 * (size_t)DM * DFF * 2 <= WS_H && WS_ACT + (size_t)MT * DFF * 2 <= WS_O, "ws map");
constexpr int RING_OFF = 0;
constexpr int LDS_BYTES = 155648;

#define GAS __attribute__((address_space(1)))
#define LAS __attribute__((address_space(3)))
typedef unsigned short bf16;
typedef unsigned v4u __attribute__((ext_vector_type(4)));
typedef float f32x4 __attribute__((ext_vector_type(4)));
#define LDS_WAIT() asm volatile("s_waitcnt lgkmcnt(0)" ::: "memory")
__device__ __forceinline__ unsigned f2bf(float f) { unsigned u = __builtin_bit_cast(unsigned, f); return (u + 0x7fffu + ((u >> 16) & 1u)) >> 16; }
__device__ __forceinline__ unsigned pk2(float lo, float hi) { return f2bf(lo) | (f2bf(hi) << 16); }
__device__ __forceinline__ float bf_lo(unsigned w) { return __builtin_bit_cast(float, w << 16); }
__device__ __forceinline__ float bf_hi(unsigned w) { return __builtin_bit_cast(float, w & 0xffff0000u); }
__device__ __forceinline__ float wave_sum(float v) {
#pragma unroll
    for (int o = 1; o < 64; o <<= 1) v += __shfl_xor(v, o);
    return v;
}
#define XB_TMO      128
#define XB_XCNT(j)  (256  + 64 * (j))
#define XB_XSUB(j)  (1280 + 64 * (j))
#define XB_XGEN(j)  (2304 + 64 * (j))
#define XB_TOP      3328
#define XB_TOPGEN   3392
#define XCD_BAR_WORDS 3456
#define XB_SPIN_CAP (1u << 18)

__device__ __forceinline__ unsigned xb_ld(unsigned* p)              { return __hip_atomic_load(p, __ATOMIC_RELAXED, __HIP_MEMORY_SCOPE_AGENT); }
__device__ __forceinline__ unsigned xb_add(unsigned* p, unsigned v) { return __hip_atomic_fetch_add(p, v, __ATOMIC_RELAXED, __HIP_MEMORY_SCOPE_AGENT); }
__device__ __forceinline__ unsigned xb_xcc_id() { return (unsigned)__builtin_amdgcn_s_getreg((3 << 11) | 20) & 0xFu; }
#define XB_SPIN(cond, bar) do { unsigned _sp = 0; while (cond) { __builtin_amdgcn_s_sleep(1); \
    if ((++_sp & 255u) == 0u) { if (xb_ld(&(bar)[XB_TMO])) break; if (_sp > XB_SPIN_CAP) { atomicAdd(&(bar)[XB_TMO], 1u); break; } } } } while (0)

struct XcdBarrier {
    unsigned* bar; unsigned x;
    volatile LAS unsigned* st;
};

__device__ __forceinline__ XcdBarrier xcd_barrier_post(unsigned* bar, volatile LAS unsigned* st) {
    XcdBarrier b; b.bar = bar; b.x = xb_xcc_id(); b.st = st;
    if (threadIdx.x == 0) (void)xb_add(&bar[XB_XCNT(b.x)], 1u);
    return b;
}
__device__ __forceinline__ void xcd_barrier_complete(unsigned* bar, unsigned x, unsigned& nloc, unsigned& nx) {
    const unsigned G = gridDim.x * gridDim.y * gridDim.z;
    unsigned sum, cnt, mine, sp = 0u;
    for (;;) {
        sum = 0u; cnt = 0u; mine = 0u;
#pragma unroll
        for (unsigned j = 0; j < 16; ++j) { const unsigned c = xb_ld(&bar[XB_XCNT(j)]); sum += c; cnt += (c > 0u) ? 1u : 0u; mine = (j == x) ? c : mine; }
        if (sum == G) break;
        __builtin_amdgcn_s_sleep(1);
        if ((++sp & 255u) == 0u) { if (xb_ld(&bar[XB_TMO])) break; if (sp > XB_SPIN_CAP) { atomicAdd(&bar[XB_TMO], 1u); break; } }
    }
    nloc = mine > 0u ? mine : 1u; nx = cnt > 0u ? cnt : 1u;
}

__device__ __forceinline__ void xcd_barrier(const XcdBarrier& b) {
    asm volatile("s_waitcnt vmcnt(0)" ::: "memory");
    __syncthreads();
    if (threadIdx.x == 0) {
        unsigned* bar = b.bar;
        __builtin_amdgcn_s_waitcnt(0);
        unsigned nloc = b.st[0], nx = b.st[1];
        if (nloc == 0u) { xcd_barrier_complete(bar, b.x, nloc, nx); b.st[0] = nloc; b.st[1] = nx; }
        const unsigned old = xb_add(&bar[XB_XSUB(b.x)], 1u);
        const unsigned gen = old / nloc;
        if (old + 1u == (gen + 1u) * nloc) {
            __builtin_amdgcn_fence(__ATOMIC_RELEASE, "agent");
            asm volatile("s_waitcnt vmcnt(0)" ::: "memory");
            const unsigned og = xb_add(&bar[XB_TOP], 1u);
            const unsigned tg = og / nx;
            if (og + 1u == (tg + 1u) * nx) xb_add(&bar[XB_TOPGEN], 1u);
            else XB_SPIN(xb_ld(&bar[XB_TOPGEN]) == tg, bar);
            __builtin_amdgcn_fence(__ATOMIC_ACQUIRE, "agent");
            xb_add(&bar[XB_XGEN(b.x)], 1u);
            asm volatile("s_waitcnt vmcnt(0)" ::: "memory");
        } else {
            XB_SPIN(xb_ld(&bar[XB_XGEN(b.x)]) == gen, bar);
            __builtin_amdgcn_fence(__ATOMIC_ACQUIRE, "agent");
            asm volatile("s_waitcnt vmcnt(0)" ::: "memory");
        }
    }
    __syncthreads();
}

__device__ __forceinline__ void p0_transpose_item(const float* W, int K, int N, bf16* WT, LAS float* scr, int k0, int n0, int drow0, int lane) {
    float tv[32];
#pragma unroll
    for (int i = 0; i < 32; ++i) { const int kk = 2 * i + (lane >> 5); tv[i] = W[(size_t)(k0 + kk) * N + n0 + (lane & 31)]; }
#pragma unroll
    for (int i = 0; i < 32; ++i) { const int kk = 2 * i + (lane >> 5); scr[kk * 33 + (lane & 31)] = tv[i]; }
    LDS_WAIT(); asm volatile("" ::: "memory");
    const int c = lane & 7;
#pragma unroll
    for (int j = 0; j < 4; ++j) { const int n = (lane >> 3) + 8 * j; const LAS float* s = scr + (8 * c) * 33 + n;
        v4u o; o.x = pk2(s[0 * 33], s[1 * 33]); o.y = pk2(s[2 * 33], s[3 * 33]); o.z = pk2(s[4 * 33], s[5 * 33]); o.w = pk2(s[6 * 33], s[7 * 33]);
        *(GAS v4u*)(WT + (size_t)(drow0 + n) * K + k0 + 8 * c) = o; }
    LDS_WAIT(); asm volatile("" ::: "memory");
}
__device__ __forceinline__ void gemv33c(int bidx, int bstride, int tid, const LAS float* vec, LAS float* red, const float* W, int N, float* outp, int ostride, const float* addb) {
    const int lane = tid & 63, wave = tid >> 6, kq = lane >> 4, nn = lane & 15, kbase = wave * 128 + 4 * kq;
    typedef float f4 __attribute__((ext_vector_type(4)));
    for (int cb = bidx; cb < N / 16; cb += bstride) {
        const float* Wn = W + 16 * cb + nn;
        float w[8][4];
#pragma unroll
        for (int u = 0; u < 8; ++u)
#pragma unroll
            for (int j = 0; j < 4; ++j) w[u][j] = Wn[(size_t)(kbase + 16 * u + j) * N];
        float acc[33];
#pragma unroll
        for (int s = 0; s < 33; ++s) acc[s] = 0.f;
#pragma unroll
        for (int s = 0; s < 33; ++s) {
#pragma unroll
            for (int u = 0; u < 8; ++u) { const f4 v = *(const LAS f4*)(vec + s * 1024 + kbase + 16 * u); acc[s] += (v.x * w[u][0] + v.y * w[u][1]) + (v.z * w[u][2] + v.w * w[u][3]); }
            asm volatile("" : "+v"(acc[s]) :: "memory"); }
#pragma unroll
        for (int s = 0; s < 33; ++s) { float a = acc[s]; a += __shfl_xor(a, 16); a += __shfl_xor(a, 32); if (kq == 0) red[(wave * 33 + s) * 16 + nn] = a; }
        __syncthreads();
        for (int o = tid; o < 528; o += 512) { const int s = o >> 4, n2 = o & 15; float a = 0.f;
#pragma unroll
            for (int ww = 0; ww < 8; ++ww) a += red[(ww * 33 + s) * 16 + n2];
            outp[(size_t)s * ostride + 16 * cb + n2] = a + (addb ? addb[16 * cb + n2] : 0.f); }
        __syncthreads();
    }
}
struct Args { const float* in[24]; float* out; unsigned char* ws; };

__device__ __forceinline__ void norm_rows(int gw, int NGW, int lane, const float* src_p, const float* src_s, const float* gain, const float* modl, int sh_off, int sc_off, bf16* H) {
    for (int m0 = gw; m0 < MT; m0 += 2 * NGW) {
        const int m1 = m0 + NGW; const bool has1 = m1 < MT; const int m1c = has1 ? m1 : m0;
        const float* s0 = (m0 < MP) ? src_p + (size_t)m0 * DM : src_s + (size_t)(m0 - MP) * DM;
        const float* s1 = (m1c < MP) ? src_p + (size_t)m1c * DM : src_s + (size_t)(m1c - MP) * DM;
        const GAS f32x4* x0 = (const GAS f32x4*)s0 + lane; const GAS f32x4* x1 = (const GAS f32x4*)s1 + lane;
        f32x4 v0[4], v1[4]; float q0 = 0.f, q1 = 0.f;
#pragma unroll
        for (int j = 0; j < 4; ++j) { v0[j] = x0[64 * j]; v1[j] = x1[64 * j]; }
#pragma unroll
        for (int j = 0; j < 4; ++j) { q0 += (v0[j].x * v0[j].x + v0[j].y * v0[j].y) + (v0[j].z * v0[j].z + v0[j].w * v0[j].w); q1 += (v1[j].x * v1[j].x + v1[j].y * v1[j].y) + (v1[j].z * v1[j].z + v1[j].w * v1[j].w); }
        const float r0 = __builtin_amdgcn_rsqf(wave_sum(q0) * (1.f / DM) + EPS), r1 = __builtin_amdgcn_rsqf(wave_sum(q1) * (1.f / DM) + EPS);
        const float* mr0 = modl + (size_t)((m0 < MP) ? (m0 >> 11) : 32) * NMOD; const float* mr1 = modl + (size_t)((m1c < MP) ? (m1c >> 11) : 32) * NMOD;
        GAS unsigned long long* o0 = (GAS unsigned long long*)(H + (size_t)m0 * DM) + lane; GAS unsigned long long* o1 = (GAS unsigned long long*)(H + (size_t)m1c * DM) + lane;
#pragma unroll
        for (int j = 0; j < 4; ++j) { const int col = 4 * lane + 256 * j; const f32x4 g = *(const f32x4*)(gain + col);
            const f32x4 y0 = (v0[j] * r0) * g * (*(const f32x4*)(mr0 + sc_off + col) + 1.0f) + *(const f32x4*)(mr0 + sh_off + col);
            o0[64 * j] = (unsigned long long)pk2(y0.x, y0.y) | ((unsigned long long)pk2(y0.z, y0.w) << 32);
            if (has1) { const f32x4 y1 = (v1[j] * r1) * g * (*(const f32x4*)(mr1 + sc_off + col) + 1.0f) + *(const f32x4*)(mr1 + sh_off + col);
                o1[64 * j] = (unsigned long long)pk2(y1.x, y1.y) | ((unsigned long long)pk2(y1.z, y1.w) << 32); } }
    }
}
__device__ __forceinline__ void qknorm_chunks(int gw, int NGW, int lane, bf16* buf, int nchunks, int row_width_log2, const float* gain, float qscale, bool rope, const float* ropetab) {
    const int d0 = 16 * (lane & 3);
    float g[16];
#pragma unroll
    for (int i = 0; i < 16; ++i) g[i] = gain[d0 + i] * qscale;
    for (int ci = gw; ci < nchunks; ci += NGW) {
        GAS v4u* p = (GAS v4u*)(buf + (size_t)ci * 1024 + 16 * lane);
        const v4u a = p[0], b = p[1];
        float x[16];
        x[0] = bf_lo(a.x); x[1] = bf_hi(a.x); x[2] = bf_lo(a.y); x[3] = bf_hi(a.y); x[4] = bf_lo(a.z); x[5] = bf_hi(a.z); x[6] = bf_lo(a.w); x[7] = bf_hi(a.w);
        x[8] = bf_lo(b.x); x[9] = bf_hi(b.x); x[10] = bf_lo(b.y); x[11] = bf_hi(b.y); x[12] = bf_lo(b.z); x[13] = bf_hi(b.z); x[14] = bf_lo(b.w); x[15] = bf_hi(b.w);
        float ss = 0.f;
#pragma unroll
        for (int i = 0; i < 16; ++i) ss += x[i] * x[i];
        ss += __shfl_xor(ss, 1); ss += __shfl_xor(ss, 2);
        const float r = __builtin_amdgcn_rsqf(ss * (1.f / 64.f) + EPS);
#pragma unroll
        for (int i = 0; i < 16; ++i) x[i] = x[i] * r * g[i];
        if (rope) {
            const int m = (int)((((size_t)ci * 1024 + 16 * lane)) >> row_width_log2);
            const int t = (m < MP) ? (m & (LP - 1)) : (m - MP);
            const int qd = lane & 3; const int pos = (qd < 2) ? (t >> 6) : (t & 63);
            const f32x4* tb = (const f32x4*)(ropetab + (size_t)(pos * 16 + 8 * (qd & 1)) * 2);
#pragma unroll
            for (int j = 0; j < 4; ++j) { const f32x4 cs = tb[j];
                const float a0 = x[4 * j], a1 = x[4 * j + 1], b0 = x[4 * j + 2], b1 = x[4 * j + 3];
                x[4 * j] = a0 * cs.x - a1 * cs.y; x[4 * j + 1] = a0 * cs.y + a1 * cs.x; x[4 * j + 2] = b0 * cs.z - b1 * cs.w; x[4 * j + 3] = b0 * cs.w + b1 * cs.z; }
        }
        v4u oa, ob;
        oa.x = pk2(x[0], x[1]); oa.y = pk2(x[2], x[3]); oa.z = pk2(x[4], x[5]); oa.w = pk2(x[6], x[7]);
        ob.x = pk2(x[8], x[9]); ob.y = pk2(x[10], x[11]); ob.z = pk2(x[12], x[13]); ob.w = pk2(x[14], x[15]);
        p[0] = oa; p[1] = ob;
    }
}
__device__ __forceinline__ void diff_combine(int gw, int NGW, int lane, const bf16* O0, bf16* O1, const float* subg, float lam) {
    const int d0 = 16 * (lane & 7);
    float g[16];
#pragma unroll
    for (int i = 0; i < 16; ++i) g[i] = subg[d0 + i] * (1.0f - LAMBDA_INIT1);
    for (int m = gw; m < MT; m += NGW) {
        const GAS v4u* p0 = (const GAS v4u*)(O0 + (size_t)m * 1024 + 16 * lane);
        GAS v4u* p1 = (GAS v4u*)(O1 + (size_t)m * 1024 + 16 * lane);
        const v4u a0 = p0[0], b0 = p0[1], a1 = p1[0], b1 = p1[1];
        float x[16];
#define DC(i, w0, w1) x[2 * (i)] = bf_lo(w0) - lam * bf_lo(w1); x[2 * (i) + 1] = bf_hi(w0) - lam * bf_hi(w1);
        DC(0, a0.x, a1.x) DC(1, a0.y, a1.y) DC(2, a0.z, a1.z) DC(3, a0.w, a1.w) DC(4, b0.x, b1.x) DC(5, b0.y, b1.y) DC(6, b0.z, b1.z) DC(7, b0.w, b1.w)
#undef DC
        float ss = 0.f;
#pragma unroll
        for (int i = 0; i < 16; ++i) ss += x[i] * x[i];
        ss += __shfl_xor(ss, 1); ss += __shfl_xor(ss, 2); ss += __shfl_xor(ss, 4);
        const float r = __builtin_amdgcn_rsqf(ss * (1.f / 128.f) + EPS);
#pragma unroll
        for (int i = 0; i < 16; ++i) x[i] = x[i] * r * g[i];
        v4u oa, ob;
        oa.x = pk2(x[0], x[1]); oa.y = pk2(x[2], x[3]); oa.z = pk2(x[4], x[5]); oa.w = pk2(x[6], x[7]);
        ob.x = pk2(x[8], x[9]); ob.y = pk2(x[10], x[11]); ob.z = pk2(x[12], x[13]); ob.w = pk2(x[14], x[15]);
        p1[0] = oa; p1[1] = ob;
    }
}

__global__ void __launch_bounds__(NWAVES * 64, 2) mega_fwd(Args args) {
    extern __shared__ __attribute__((aligned(16))) unsigned char lds[];
    cg::grid_group grid = cg::this_grid();
    LAS unsigned char* ldsl = (LAS unsigned char*)lds;
    const int tid = threadIdx.x, lane = tid & 63, wave = __builtin_amdgcn_readfirstlane(tid >> 6);
    const int G = gridDim.x, bx = blockIdx.x;
    const int vcu = (G % 8 == 0) ? (bx % 8) * (G / 8) + bx / 8 : bx;
    const int gw = vcu * NWAVES + wave, NGW = G * NWAVES;
    volatile LAS unsigned* bst = (volatile LAS unsigned*)(ldsl + 155584);
    if (tid < 16) bst[tid] = 0u;
    __syncthreads();
    const XcdBarrier xbar = xcd_barrier_post((unsigned*)(args.ws + WS_BAR), bst);
    typedef __attribute__((address_space(4))) const Args* cargs_t;
    const cargs_t ap0 = (cargs_t)__builtin_amdgcn_kernarg_segment_ptr();
#define AP() cargs_t ap = ap0; asm volatile("" : "+s"(ap))
#define WSP(T, off) ((T*)(ap->ws + (off)))
#define mod WSP(float, WS_MOD)
#define ropetab WSP(float, WS_ROPE)
#define Wqkv_a WSP(bf16, WS_WQKVA)
#define Wo_a WSP(bf16, WS_WOA)
#define Wqkv_b WSP(bf16, WS_WQKVB)
#define Wo_b WSP(bf16, WS_WOB)
#define Wgu WSP(bf16, WS_WGU)
#define Wd WSP(bf16, WS_WD)
#define H WSP(bf16, WS_H)
#define Qb WSP(bf16, WS_Q)
#define Kb WSP(bf16, WS_K)
#define Vb WSP(bf16, WS_V)
#define Ob WSP(bf16, WS_O)
#define ACT WSP(bf16, WS_ACT)
#define OC0 WSP(bf16, WS_OC0)
#define OC1 WSP(bf16, WS_OC1)
#define out (ap->out)
#define x_p (ap->in[0])
#define x_s (ap->in[1])
    {
        AP();
        LAS float* scr = (LAS float*)(ldsl + RING_OFF + wave * 16384);
        constexpr int I_QA = 16 * 48, I_OA = 16 * 32, I_QB = 16 * 96, I_OB = 16 * 32, I_GU = 16 * 176, I_D = 44 * 32;
        constexpr int NITEMS = I_QA + I_OA + I_QB + I_OB + 2 * I_GU + 2 * I_D;
        for (int it = gw; it < NITEMS; it += NGW) {
            int r = it;
            if (r < I_QA) { const int nb = r % 48, kb = r / 48; p0_transpose_item(ap->in[11], 1024, 1536, Wqkv_a, scr, 64 * kb, 32 * nb, 32 * nb, lane); continue; } r -= I_QA;
            if (r < I_OA) { const int nb = r % 32, kb = r / 32; p0_transpose_item(ap->in[12], 1024, 1024, Wo_a, scr, 64 * kb, 32 * nb, 32 * nb, lane); continue; } r -= I_OA;
            if (r < I_QB) { const int nb = r % 96, kb = r / 96; p0_transpose_item(ap->in[15], 1024, 3072, Wqkv_b, scr, 64 * kb, 32 * nb, 32 * nb, lane); continue; } r -= I_QB;
            if (r < I_OB) { const int nb = r % 32, kb = r / 32; p0_transpose_item(ap->in[16], 1024, 1024, Wo_b, scr, 64 * kb, 32 * nb, 32 * nb, lane); continue; } r -= I_OB;
            if (r < 2 * I_GU) { const int l = r / I_GU; r -= l * I_GU; const int nb = r % 176, kb = r / 176; const int n0 = 32 * nb;
                const int drow0 = (n0 < DFF) ? (n0 / 128) * 256 + (n0 % 128) : ((n0 - DFF) / 128) * 256 + 128 + ((n0 - DFF) % 128);
                p0_transpose_item(ap->in[8] + (size_t)l * 1024 * 5632, 1024, 5632, Wgu + (size_t)l * 5632 * 1024, scr, 64 * kb, n0, drow0, lane); continue; } r -= 2 * I_GU;
            { const int l = r / I_D; r -= l * I_D; const int nb = r % 32, kb = r / 32;
                p0_transpose_item(ap->in[9] + (size_t)l * DFF * 1024, DFF, 1024, Wd + (size_t)l * 1024 * DFF, scr, 64 * kb, 32 * nb, 32 * nb, lane); }
        }
        { const int gt = vcu * 512 + tid;
          if (gt < 4096) { const int pos = gt >> 4, f = gt & 15; const float inv = exp2f(-(float)f * (13.287712379549449f / 16.0f)); const float ang = (float)pos * inv;
              const float rev = ang * 0.15915494309189535f; ropetab[2 * gt] = __builtin_amdgcn_cosf(rev); ropetab[2 * gt + 1] = __builtin_amdgcn_sinf(rev); } }
        __syncthreads();
        LAS float* cact = (LAS float*)ldsl;
        for (int i = tid; i < NSEQ * 1024; i += 512) { const int s = i >> 10, k = i & 1023; const float c = (s < 32) ? ap->in[2][s * 1024 + k] : ap->in[3][k];
            cact[i] = c / (1.0f + __expf(-c)); }
        __syncthreads();
        { const int half = G / 2; const int l = (vcu >= half) ? 1 : 0;
          gemv33c(vcu - l * half, half > 0 ? half : 1, tid, cact, (LAS float*)(ldsl + 135168), ap->in[6] + (size_t)l * 1024 * NMOD, NMOD, mod + (size_t)l * NSEQ * NMOD, NMOD, ap->in[7] + l * NMOD); }
        { float* rss = WSP(float, WS_RSS); for (int i = vcu * 512 + tid; i < 3 * MT; i += G * 512) rss[i] = 0.f; }
        __syncthreads();
    }
    grid.sync();

    auto layer_body = [&](auto LC) __attribute__((always_inline)) {
        constexpr int layer = decltype(LC)::value;
        AP();
#define modl (mod + (size_t)layer * NSEQ * NMOD)
        if (layer == 0) {
            norm_rows(gw, NGW, lane, x_p, x_s, ap->in[4], modl, 0, 1024, H);
            LAS float* shv = (LAS float*)ldsl; float* bv = WSP(float, WS_BV);
#pragma unroll 1
            for (int which = 0; which < 3; ++which) {
                const float* shsrc = mod + (size_t)(which == 0 ? 0 : 1) * NSEQ * NMOD + (which == 1 ? 0 : 3072);
                for (int i = tid; i < NSEQ * 1024; i += 512) shv[i] = shsrc[(size_t)(i >> 10) * NMOD + (i & 1023)];
                __syncthreads();
                if (which == 0) gemv33c(vcu, G, tid, shv, (LAS float*)(ldsl + 135168), ap->in[8], 5632, bv + BV_GU0, 5632, nullptr);
                else if (which == 1) gemv33c(vcu, G, tid, shv, (LAS float*)(ldsl + 135168), ap->in[15], 3072, bv + BV_QKV1, 3072, nullptr);
                else gemv33c(vcu, G, tid, shv, (LAS float*)(ldsl + 135168), ap->in[8] + (size_t)1024 * 5632, 5632, bv + BV_GU1, 5632, nullptr);
                __syncthreads();
            }
            xcd_barrier(xbar);
        }
        if (layer == 0) {
            pg8::Gemm g{H, Wqkv_a, MT, 1536, 1024}; pg8::StaticOrder S; S.init(MT, 1536, G, bx);
            pg8::EpiSplit2<false, true> E{Qb, Kb, Vb, 1024, 256, 256, 4, 5, nullptr, nullptr, 0, ap->in[13], ap->in[14], QSCALE, ropetab, (LAS float*)(ldsl + 131072)};
            pg8::gemm_phase<pg8::EpiSplit2<false, true>, pg8::StaticOrder, true, PG8_SP2>(ldsl + RING_OFF, g, S, E);
        } else {
            pg8::Gemm g{H, Wqkv_b, MT, 3072, 1024}; pg8::StaticOrder S; S.init(MT, 3072, G, bx);
            pg8::EpiSplit2<true, false> E{Qb, Kb, Vb, 1024, 1024, 1024, 4, 8, WSP(float, WS_RSS) + MT, WSP(float, WS_BV) + BV_QKV1, 3072, ap->in[17], ap->in[18], QSCALE, ropetab, (LAS float*)(ldsl + 131072)};
            pg8::gemm_phase<pg8::EpiSplit2<true, false>, pg8::StaticOrder, true, PG8_SP2>(ldsl + RING_OFF, g, S, E);
        }
        xcd_barrier(xbar);
        if (layer == 0) {
            for (int idx = vcu; idx < 1024 + 4096; idx += G) {
                size_t tok0; int head, kvh, qb, NT;
                if (idx < 1024) { const int xcd = (idx >> 5) & 7, j = idx & 31, i = idx >> 8; kvh = xcd & 3; const int w = (((xcd >> 2) * 4 + i) << 5) + j; head = kvh * 4 + (w >> 6); qb = w & 63; tok0 = MP; NT = LS / 64; }
                else { const int id2 = idx - 1024; const int xcd = (id2 >> 5) & 7, j = id2 & 31, i = id2 >> 8; const int gq = xcd * 16 + i; kvh = gq & 3; head = kvh * 4 + (j >> 3); qb = j & 7; tok0 = (size_t)(gq >> 2) * LP; NT = LP / 64; }
                attn_body::attn_unit2<1, false, 0>((const attn_body::bf16*)(Qb + tok0 * 1024 + head * 64), 1024, (const attn_body::bf16*)(Kb + tok0 * 256 + kvh * 64), 256,
                    (const attn_body::bf16*)(Vb + tok0 * 256 + kvh * 64), 256, (attn_body::bf16*)(Ob + tok0 * 1024 + head * 64), 1024, qb * 256, NT, nullptr, (char*)lds + RING_OFF, 0.f, nullptr, 0.f); }
        } else {
            const float s1 = wave_sum(ap->in[19][lane] * ap->in[20][lane]), s2 = wave_sum(ap->in[21][lane] * ap->in[22][lane]);
            const float lam = expf(s1) - expf(s2) + LAMBDA_INIT1;
            for (int idx = vcu; idx < 512 + 2048; idx += G) {
                size_t tok0; int h, qb, NT;
                if (idx < 512) { const int xcd = (idx >> 5) & 7, j = idx & 31, i = idx >> 8; h = xcd; qb = (i << 5) + j; tok0 = MP; NT = LS / 64; }
                else { const int id2 = idx - 512; const int xcd = (id2 >> 5) & 7, j = id2 & 31, i = id2 >> 8; const int gq = ((xcd * 8 + i) << 2) + (j >> 3); h = gq & 7; qb = j & 7; tok0 = (size_t)(gq >> 3) * LP; NT = LP / 64; }
                attn_body::attn_unit2<2, true, 1>((const attn_body::bf16*)(Qb + tok0 * 1024 + (2 * h) * 64), 1024, (const attn_body::bf16*)(Kb + tok0 * 1024 + (2 * h) * 64), 1024,
                    (const attn_body::bf16*)(Vb + tok0 * 1024 + h * 128), 1024, (attn_body::bf16*)(Ob + tok0 * 1024 + h * 128), 1024, qb * 256, NT, ap->in[10] + h, (char*)lds + RING_OFF, lam, ap->in[23], 1.0f - LAMBDA_INIT1);
                attn_body::attn_unit2<2, true, 2>((const attn_body::bf16*)(Qb + tok0 * 1024 + (2 * h + 1) * 64), 1024, (const attn_body::bf16*)(Kb + tok0 * 1024 + (2 * h + 1) * 64), 1024,
                    (const attn_body::bf16*)(Vb + tok0 * 1024 + h * 128), 1024, (attn_body::bf16*)(Ob + tok0 * 1024 + h * 128), 1024, qb * 256, NT, ap->in[10] + h, (char*)lds + RING_OFF, lam, ap->in[23], 1.0f - LAMBDA_INIT1); }
        }
        xcd_barrier(xbar);
        {
            pg8::Gemm g{Ob, layer == 0 ? Wo_a : Wo_b, MT, 1024, 1024}; pg8::StaticOrder S; S.init(MT, 1024, G, bx);
            pg8::EpiResid2<true> E{layer == 0 ? x_p : out, layer == 0 ? (x_s - (size_t)MP * DM) : out, out, modl + 2048, ap->in[5] + layer * 1024, modl + 4096, H, WSP(float, WS_RSS) + (layer == 0 ? 0 : 2 * MT)};
            pg8::gemm_phase<pg8::EpiResid2<true>, pg8::StaticOrder, PG8_ALIGN, PG8_SP2>(ldsl + RING_OFF, g, S, E);
        }
        xcd_barrier(xbar);
        {
            pg8::Gemm g{H, Wgu + (size_t)layer * 5632 * 1024, MT, 5632, 1024}; pg8::StaticOrder S; S.init(MT, 5632, G, bx);
            pg8::EpiSwiGLU2 E{ACT, DFF, WSP(float, WS_RSS) + (layer == 0 ? 0 : 2 * MT), WSP(float, WS_BV) + (layer == 0 ? BV_GU0 : BV_GU1)};
            pg8::gemm_phase<pg8::EpiSwiGLU2, pg8::StaticOrder, PG8_ALIGN, PG8_SP2>(ldsl + RING_OFF, g, S, E);
        }
        xcd_barrier(xbar);
        {
            pg8::Gemm g{ACT, Wd + (size_t)layer * 1024 * DFF, MT, 1024, DFF}; pg8::StaticOrder S; S.init(MT, 1024, G, bx);
            if (layer == 0) {
                pg8::EpiResid2<true> E{out, out, out, modl + 5120, ap->in[4] + 1024, mod + (size_t)NSEQ * NMOD + 1024, H, WSP(float, WS_RSS) + MT};
                pg8::gemm_phase<pg8::EpiResid2<true>, pg8::StaticOrder, PG8_ALIGN, PG8_SP2>(ldsl + RING_OFF, g, S, E);
            } else {
                pg8::EpiResid2<false> E{out, out, out, modl + 5120, nullptr, nullptr, nullptr, nullptr};
                pg8::gemm_phase<pg8::EpiResid2<false>, pg8::StaticOrder, PG8_ALIGN, PG8_SP2>(ldsl + RING_OFF, g, S, E);
            }
        }
        if (layer == 0) xcd_barrier(xbar);
    };
    layer_body(std::integral_constant<int, 0>{});
    layer_body(std::integral_constant<int, 1>{});
}

#undef out
#undef H
#undef mod
#undef modl
#undef ACT
#undef Qb
#undef Kb
#undef Vb
#undef Ob
extern "C" void kernel_launch(void* const* d_in, const int* in_sizes, int n_in, void* d_out, int out_size, void* d_ws, size_t ws_size, hipStream_t stream) {
    static int grid = 0;
    if (grid == 0) {
        if (n_in != 24 || out_size != MT * DM || ws_size < WS_END) { fprintf(stderr, "kernel_launch: unexpected shapes (n_in %d, out %d, ws %zu)\n", n_in, out_size, ws_size); grid = -1; return; }
        int dev = 0, cus = 0, per_cu = 0;
        hipGetDevice(&dev); hipDeviceGetAttribute(&cus, hipDeviceAttributeMultiprocessorCount, dev);
        if (hipFuncSetAttribute((const void*)mega_fwd, hipFuncAttributeMaxDynamicSharedMemorySize, LDS_BYTES) != hipSuccess) { fprintf(stderr, "hipFuncSetAttribute failed\n"); grid = -1; return; }
        if (hipOccupancyMaxActiveBlocksPerMultiprocessor(&per_cu, (const void*)mega_fwd, NWAVES * 64, LDS_BYTES) != hipSuccess || per_cu < 1) per_cu = 1;
        (void)hipGetLastError();
        grid = cus;
        if (grid > 256) grid = 256;
    }
    if (grid < 0) return;
    if (hipMemsetAsync((char*)d_ws + WS_BAR, 0, BAR_BYTES, stream) != hipSuccess) { fprintf(stderr, "hipMemsetAsync of the barrier words failed\n"); return; }
    Args a{};
    for (int i = 0; i < 24; ++i) a.in[i] = (const float*)d_in[i];
    a.out = (float*)d_out; a.ws = (unsigned char*)d_ws;
    void* kargs[] = {&a};
    hipError_t e = hipLaunchCooperativeKernel((const void*)mega_fwd, dim3(grid), dim3(NWAVES * 64), kargs, LDS_BYTES, stream);
    if (e != hipSuccess) fprintf(stderr, "cooperative launch failed: %s (grid %d)\n", hipGetErrorString(e), grid);
}
```

```cpp
#include <hip/hip_runtime.h>
#include <hip/hip_cooperative_groups.h>
#include <hip/hip_bf16.h>
#include <cstdio>
#include <cstdint>
#include <cmath>
#include <type_traits>
namespace cg = cooperative_groups;
namespace pg8 {
#define PG8_LAS __attribute__((address_space(3)))
typedef unsigned short bf16_t;
typedef short bf16x8 __attribute__((ext_vector_type(8)));
typedef float f32x4 __attribute__((ext_vector_type(4)));
typedef unsigned u32x4 __attribute__((ext_vector_type(4)));
constexpr int BM = 256, BK = 64, HALF = 128, HTB = HALF * BK * 2  , STAGE_BYTES = 8 * HTB, NXCD = 8, WGM = 8;

__host__ __device__ __forceinline__ int lds_byte(int r, int c) { const int st = (r >> 4) * 2 + (c >> 5), rr = r & 15, cc = c & 31, ob = rr * 64 + cc * 2; return st * 1024 + (ob ^ (((ob >> 9) & 1) << 5)); }
__host__ __device__ __forceinline__ void stage_rc(int b, int& R, int& C) { const int st = b / 1024, sb = b % 1024, swz = sb ^ (((sb >> 9) & 1) << 5); R = (st >> 1) * 16 + swz / 64; C = (st & 1) * 32 + (swz % 64) / 2; }
__host__ __device__ __forceinline__ int perm32(int rho) { const int n = rho >> 4, i = rho & 15; return 8 * (i >> 2) + 4 * n + (i & 3); }

struct Unit { int pm, pn; };
struct Gemm { const bf16_t* A; const bf16_t* Bt; int M, N, K; };

struct StaticOrder {
    int nM, nN, nwg, G, c;
    __host__ __device__ void init(int M, int N, int G_, int c_) { nM = M / BM; nN = N / BM; nwg = nM * nN; G = G_; c = c_; }
    __host__ __device__ bool next(int i, Unit& u) const {
        const long L = (long)i * G + c; if (L >= nwg) return false;
        int wgid = (int)L; { const int q = nwg / NXCD, r = nwg % NXCD, xcd = wgid % NXCD, off = wgid / NXCD; wgid = (xcd < r ? xcd * (q + 1) : r * (q + 1) + (xcd - r) * q) + off; }
        const int nig = WGM * nN, gid = wgid / nig, fm = gid * WGM, gsz = (nM - fm) < WGM ? (nM - fm) : WGM;
        u.pm = fm + ((wgid % nig) % gsz); u.pn = (wgid % nig) / gsz; return true;
    }
    __device__ __forceinline__ void a_ready(const Unit&) const {}
    __device__ __forceinline__ void done(const Unit&) const {}
};

__device__ __forceinline__ unsigned cvt_pk_bf16(float lo, float hi) { unsigned r; asm volatile("v_cvt_pk_bf16_f32 %0, %1, %2" : "=v"(r) : "v"(lo), "v"(hi)); return r; }
typedef float f32x2 __attribute__((ext_vector_type(2)));
__device__ __forceinline__ float silu_mul(float g, float uu) { const float e = __builtin_amdgcn_exp2f(g * -1.4426950408889634f); return g * __builtin_amdgcn_rcpf(1.0f + e) * uu; }
constexpr float EPI_EPS = 1e-6f;
template <bool NEXT> struct EpiResid2 {
    static constexpr bool PERM = true, AFTER_DRAIN = false;
    const float* base_p; const float* base_s; float* out; const float* gate;
    const float* ngain; const float* nsc; bf16_t* Hn; float* rowss;
    __device__ __forceinline__ void prefetch(PG8_LAS unsigned char*, const Unit&, int, int) const {}
    __device__ __forceinline__ void operator()(const f32x4 (&acc)[2][2][4][2], const Unit& u, int wr, int wc, int fr, int fq, PG8_LAS unsigned char*) const {
        const int seq = (u.pm < 256) ? (u.pm >> 3) : 32;
        const float* base = (u.pm < 256) ? base_p : base_s;
        const int col0 = u.pn * BM + wc * 32 + 8 * fq;
        u32x4 dl[2][4][2];
        { f32x4 gv[2][2];
#pragma unroll
          for (int bj = 0; bj < 2; ++bj)
#pragma unroll
            for (int n = 0; n < 2; ++n) gv[bj][n] = *(const f32x4*)(gate + (size_t)seq * 6144 + col0 + bj * HALF + 4 * n);
#pragma unroll
          for (int ai = 0; ai < 2; ++ai)
#pragma unroll
            for (int m = 0; m < 4; ++m)
#pragma unroll
                for (int bj = 0; bj < 2; ++bj) { const f32x4 a = gv[bj][0] * acc[ai][bj][m][0], b = gv[bj][1] * acc[ai][bj][m][1];
                    dl[ai][m][bj].x = cvt_pk_bf16(a[0], a[1]); dl[ai][m][bj].y = cvt_pk_bf16(a[2], a[3]); dl[ai][m][bj].z = cvt_pk_bf16(b[0], b[1]); dl[ai][m][bj].w = cvt_pk_bf16(b[2], b[3]); } }
        f32x4 gm[2][2];
        if (NEXT) {
#pragma unroll
          for (int bj = 0; bj < 2; ++bj)
#pragma unroll
            for (int n = 0; n < 2; ++n) { const int c = col0 + bj * HALF + 4 * n; gm[bj][n] = *(const f32x4*)(ngain + c) * (*(const f32x4*)(nsc + (size_t)seq * 6144 + c) + 1.0f); } }
#define BFLO(w) __builtin_bit_cast(float, (w) << 16)
#define BFHI(w) __builtin_bit_cast(float, (w) & 0xffff0000u)
#pragma unroll
        for (int ai = 0; ai < 2; ++ai) {
            f32x4 bs[4][2][2];
#pragma unroll
            for (int m = 0; m < 4; ++m) { const size_t off = (size_t)(u.pm * BM + ai * HALF + wr * 64 + m * 16 + fr) * 1024 + col0;
#pragma unroll
                for (int bj = 0; bj < 2; ++bj) { bs[m][bj][0] = *(const f32x4*)(base + off + bj * HALF); bs[m][bj][1] = *(const f32x4*)(base + off + bj * HALF + 4); } }
#pragma unroll
            for (int m = 0; m < 4; ++m) { const int row = u.pm * BM + ai * HALF + wr * 64 + m * 16 + fr; const size_t off = (size_t)row * 1024 + col0; float ss = 0.f;
#pragma unroll
                for (int bj = 0; bj < 2; ++bj) { const u32x4 d = dl[ai][m][bj];
                    const f32x4 o0 = bs[m][bj][0] + (f32x4){BFLO(d.x), BFHI(d.x), BFLO(d.y), BFHI(d.y)}, o1 = bs[m][bj][1] + (f32x4){BFLO(d.z), BFHI(d.z), BFLO(d.w), BFHI(d.w)};
                    *(f32x4*)(out + off + bj * HALF) = o0; *(f32x4*)(out + off + bj * HALF + 4) = o1;
                    if (NEXT) { ss += (o0[0] * o0[0] + o0[1] * o0[1]) + (o0[2] * o0[2] + o0[3] * o0[3]) + (o1[0] * o1[0] + o1[1] * o1[1]) + (o1[2] * o1[2] + o1[3] * o1[3]);
                        const f32x4 h0 = o0 * gm[bj][0], h1 = o1 * gm[bj][1];
                        u32x4 w; w.x = cvt_pk_bf16(h0[0], h0[1]); w.y = cvt_pk_bf16(h0[2], h0[3]); w.z = cvt_pk_bf16(h1[0], h1[1]); w.w = cvt_pk_bf16(h1[2], h1[3]);
                        *(u32x4*)(Hn + off + bj * HALF) = w; } }
                if (NEXT) { ss += __shfl_xor(ss, 16); ss += __shfl_xor(ss, 32); if (fq == 0) __hip_atomic_fetch_add(rowss + row, ss, __ATOMIC_RELAXED, __HIP_MEMORY_SCOPE_AGENT); } }
            asm volatile("" ::: "memory"); }
#undef BFLO
#undef BFHI
    }
};
struct EpiSwiGLU2 {
    static constexpr bool PERM = true, AFTER_DRAIN = false;
    bf16_t* O; int ldc; const float* rowss; const float* bias;
    __device__ __forceinline__ void prefetch(PG8_LAS unsigned char* sp, const Unit& u, int wid, int lane) const {
        const int seq = (u.pm < 256) ? (u.pm >> 3) : 32;
        const float* src = (wid < 4) ? rowss + u.pm * BM + wid * 64 : bias + (size_t)seq * 5632 + u.pn * HALF + (wid < 6 ? (wid - 4) * 64 : 2816 + (wid - 6) * 64);
        __builtin_amdgcn_global_load_lds((const unsigned*)(src + lane), (PG8_LAS unsigned*)(sp + wid * 256), 4, 0, 0);
    }
    __device__ __forceinline__ void operator()(const f32x4 (&acc)[2][2][4][2], const Unit& u, int wr, int wc, int fr, int fq, PG8_LAS unsigned char* sp) const {
        const int row0 = u.pm * BM + wr * 64 + fr; const int col0 = u.pn * HALF + wc * 32 + 8 * fq;
        const PG8_LAS float* spf = (const PG8_LAS float*)sp;
        const f32x4 bg0 = *(const PG8_LAS f32x4*)(spf + 256 + wc * 32 + 8 * fq), bg1 = *(const PG8_LAS f32x4*)(spf + 256 + wc * 32 + 8 * fq + 4);
        const f32x4 bu0 = *(const PG8_LAS f32x4*)(spf + 384 + wc * 32 + 8 * fq), bu1 = *(const PG8_LAS f32x4*)(spf + 384 + wc * 32 + 8 * fq + 4);
#pragma unroll
        for (int ai = 0; ai < 2; ++ai)
#pragma unroll
            for (int m = 0; m < 4; ++m) { const int row = row0 + ai * HALF + m * 16; const float rr = __builtin_amdgcn_rsqf(spf[ai * HALF + wr * 64 + m * 16 + fr] * (1.0f / 1024.0f) + EPI_EPS);
                const f32x4 g0 = acc[ai][0][m][0] * rr + bg0, g1 = acc[ai][0][m][1] * rr + bg1, u0 = acc[ai][1][m][0] * rr + bu0, u1 = acc[ai][1][m][1] * rr + bu1;
                u32x4 w; w.x = cvt_pk_bf16(silu_mul(g0[0], u0[0]), silu_mul(g0[1], u0[1])); w.y = cvt_pk_bf16(silu_mul(g0[2], u0[2]), silu_mul(g0[3], u0[3]));
                w.z = cvt_pk_bf16(silu_mul(g1[0], u1[0]), silu_mul(g1[1], u1[1])); w.w = cvt_pk_bf16(silu_mul(g1[2], u1[2]), silu_mul(g1[3], u1[3]));
                *(u32x4*)(O + (size_t)row * ldc + col0) = w; }
    }
};
template <bool PRE, bool ROPE> struct EpiSplit2 {
    static constexpr bool PERM = true, AFTER_DRAIN = false;
    bf16_t* p0; bf16_t* p1; bf16_t* p2; int ld0, ld1, ld2, n0, n1;
    const float* rowss; const float* bias; int N;
    const float* qgain; const float* kgain; float qscale; const float* ropetab; PG8_LAS float* xch;
    __device__ __forceinline__ void prefetch(PG8_LAS unsigned char* sp, const Unit& u, int wid, int lane) const {
        if (PRE) { const int seq = (u.pm < 256) ? (u.pm >> 3) : 32;
            const float* src = (wid < 4) ? rowss + u.pm * BM + wid * 64 : bias + (size_t)seq * N + u.pn * BM + (wid - 4) * 64;
            __builtin_amdgcn_global_load_lds((const unsigned*)(src + lane), (PG8_LAS unsigned*)(sp + wid * 256), 4, 0, 0); }
    }
    __device__ __forceinline__ void operator()(f32x4 (&acc)[2][2][4][2], const Unit& u, int wr, int wc, int fr, int fq, PG8_LAS unsigned char* sp) const {
        bf16_t* base; int ldc, colt;
        if (u.pn < n0) { base = p0; ldc = ld0; colt = u.pn * BM; }
        else if (u.pn < n1) { base = p1; ldc = ld1; colt = (u.pn - n0) * BM; }
        else { base = p2; ldc = ld2; colt = (u.pn - n1) * BM; }
        const bool isv = (u.pn >= n1), isq = (u.pn < n0);
        const int wid = wr * 4 + wc;
        const int row0 = u.pm * BM + wr * 64 + fr; const int col0 = colt + wc * 32 + 8 * fq;
        if (PRE) { const PG8_LAS float* spf = (const PG8_LAS float*)sp; const PG8_LAS float* bp = spf + 256 + wc * 32 + 8 * fq;
            const f32x4 b00 = *(const PG8_LAS f32x4*)(bp), b01 = *(const PG8_LAS f32x4*)(bp + 4), b10 = *(const PG8_LAS f32x4*)(bp + HALF), b11 = *(const PG8_LAS f32x4*)(bp + HALF + 4);
#pragma unroll
            for (int ai = 0; ai < 2; ++ai)
#pragma unroll
                for (int m = 0; m < 4; ++m) { const float rr = __builtin_amdgcn_rsqf(spf[ai * HALF + wr * 64 + m * 16 + fr] * (1.0f / 1024.0f) + EPI_EPS);
                    acc[ai][0][m][0] = acc[ai][0][m][0] * rr + b00; acc[ai][0][m][1] = acc[ai][0][m][1] * rr + b01; acc[ai][1][m][0] = acc[ai][1][m][0] * rr + b10; acc[ai][1][m][1] = acc[ai][1][m][1] * rr + b11; } }
        float part[16];
        if (!isv) {
#pragma unroll
            for (int ai = 0; ai < 2; ++ai)
#pragma unroll
                for (int m = 0; m < 4; ++m)
#pragma unroll
                    for (int bj = 0; bj < 2; ++bj) { const f32x4 a = acc[ai][bj][m][0], b = acc[ai][bj][m][1];
                        float s = (a[0] * a[0] + a[1] * a[1]) + (a[2] * a[2] + a[3] * a[3]) + (b[0] * b[0] + b[1] * b[1]) + (b[2] * b[2] + b[3] * b[3]);
                        s += __shfl_xor(s, 16); s += __shfl_xor(s, 32); const int idx = (ai * 4 + m) * 2 + bj; part[idx] = s;
                        if (fq == 0) xch[wid * 256 + idx * 16 + fr] = s; }
        }
        asm volatile("s_waitcnt lgkmcnt(0)" ::: "memory"); __builtin_amdgcn_s_barrier(); asm volatile("" ::: "memory");
        if (!isv) {
            const float* gp = (isq ? qgain : kgain) + 32 * (wc & 1) + 8 * fq; const float gs = isq ? qscale : 1.0f;
            const f32x4 gl0 = *(const f32x4*)(gp) * gs, gl1 = *(const f32x4*)(gp + 4) * gs;
#pragma unroll
            for (int ai = 0; ai < 2; ++ai)
#pragma unroll
                for (int m = 0; m < 4; ++m) { const int row = row0 + ai * HALF + m * 16;
                    f32x4 cs0 = {1.f, 0.f, 1.f, 0.f}, cs1 = {1.f, 0.f, 1.f, 0.f};
                    if (ROPE) { const int t = (row < 65536) ? (row & 2047) : (row - 65536); const int pos = (wc & 1) ? (t & 63) : (t >> 6);
                        const float* tp = ropetab + (size_t)(pos * 16 + 4 * fq) * 2; cs0 = *(const f32x4*)(tp); cs1 = *(const f32x4*)(tp + 4); }
                    bf16_t* rowp = base + (size_t)row * ldc + col0;
#pragma unroll
                    for (int bj = 0; bj < 2; ++bj) { const int idx = (ai * 4 + m) * 2 + bj;
                        const float tot = part[idx] + xch[(wid ^ 1) * 256 + idx * 16 + fr]; const float rinv = __builtin_amdgcn_rsqf(tot * (1.0f / 64.0f) + EPI_EPS);
                        f32x4 v0 = acc[ai][bj][m][0] * rinv * gl0, v1 = acc[ai][bj][m][1] * rinv * gl1;
                        if (ROPE) { const f32x4 a = v0, b = v1;
                            v0[0] = a[0] * cs0[0] - a[1] * cs0[1]; v0[1] = a[0] * cs0[1] + a[1] * cs0[0]; v0[2] = a[2] * cs0[2] - a[3] * cs0[3]; v0[3] = a[2] * cs0[3] + a[3] * cs0[2];
                            v1[0] = b[0] * cs1[0] - b[1] * cs1[1]; v1[1] = b[0] * cs1[1] + b[1] * cs1[0]; v1[2] = b[2] * cs1[2] - b[3] * cs1[3]; v1[3] = b[2] * cs1[3] + b[3] * cs1[2]; }
                        u32x4 w; w.x = cvt_pk_bf16(v0[0], v0[1]); w.y = cvt_pk_bf16(v0[2], v0[3]); w.z = cvt_pk_bf16(v1[0], v1[1]); w.w = cvt_pk_bf16(v1[2], v1[3]);
                        *(u32x4*)(rowp + bj * HALF) = w; } }
        } else {
#pragma unroll
            for (int ai = 0; ai < 2; ++ai)
#pragma unroll
                for (int m = 0; m < 4; ++m) { bf16_t* rowp = base + (size_t)(row0 + ai * HALF + m * 16) * ldc + col0;
#pragma unroll
                    for (int bj = 0; bj < 2; ++bj) { const f32x4 v0 = acc[ai][bj][m][0], v1 = acc[ai][bj][m][1];
                        u32x4 w; w.x = cvt_pk_bf16(v0[0], v0[1]); w.y = cvt_pk_bf16(v0[2], v0[3]); w.z = cvt_pk_bf16(v1[0], v1[1]); w.w = cvt_pk_bf16(v1[2], v1[3]);
                        *(u32x4*)(rowp + bj * HALF) = w; } }
        }
    }
};
template <class Epi, class Sched, bool ALIGN_EPI = false, bool SP2 = false>
__device__ __forceinline__ void gemm_phase(PG8_LAS unsigned char* lds, const Gemm g, const Sched& S, const Epi& E) {
    int tid_ = threadIdx.x; asm volatile("" : "+v"(tid_));
    const int tid = tid_, wid = __builtin_amdgcn_readfirstlane(tid >> 6), lane = tid & 63, wr = wid >> 2, wc = wid & 3, fr = lane & 15, fq = lane >> 4;
    const int K = g.K, nt = K / BK;
    unsigned voffA[2], voffB[2];
#pragma unroll
    for (int i = 0; i < 2; ++i) { int R, C; stage_rc(tid * 16 + i * 8192, R, C); const int Rb = Epi::PERM ? ((R & ~31) + perm32(R & 31)) : R;
        voffA[i] = (unsigned)(R * K + C) * 2u; voffB[i] = (unsigned)(Rb * K + C) * 2u; }
    const size_t kstep = (size_t)(BK * 2);
    const size_t hstep = (size_t)HALF * K * 2;
    const size_t tstep = 2 * hstep;
    const unsigned ldsw = (unsigned)wid * 1024u;
    const int aoff = lds_byte(wr * 64 + fr, fq * 8), boff = lds_byte(wc * 32 + fr, fq * 8);
#define PG8_SA(b, h) (((b) * 2 + (h)) * HTB)
#define PG8_SB(b, h) ((4 + (b) * 2 + (h)) * HTB)
#define PG8_STAGE(bufoff, gbase, voff) do { _Pragma("unroll") for (int _i = 0; _i < 2; ++_i) \
        __builtin_amdgcn_global_load_lds((const unsigned*)((const char*)(gbase) + (voff)[_i]), (PG8_LAS unsigned*)(lds + (bufoff) + ldsw + _i * 8192), 16, 0, 0); } while (0)
#define PG8_LDA(dst, b, h) do { _Pragma("unroll") for (int m = 0; m < 4; ++m) _Pragma("unroll") for (int k = 0; k < 2; ++k) dst[m][k] = *(const PG8_LAS bf16x8*)(lds + PG8_SA(b, h) + aoff + m * 2048 + k * 1024); } while (0)
#define PG8_LDB(dst, b, h) do { _Pragma("unroll") for (int n = 0; n < 2; ++n) _Pragma("unroll") for (int k = 0; k < 2; ++k) dst[n][k] = *(const PG8_LAS bf16x8*)(lds + PG8_SB(b, h) + boff + n * 2048 + k * 1024); } while (0)
#define PG8_MMA(ai, bj, At, Bt) do { __builtin_amdgcn_s_setprio(1); _Pragma("unroll") for (int m = 0; m < 4; ++m) _Pragma("unroll") for (int n = 0; n < 2; ++n) _Pragma("unroll") for (int k = 0; k < 2; ++k) \
        acc[ai][bj][m][n] = __builtin_amdgcn_mfma_f32_16x16x32_bf16(Bt[n][k], At[m][k], acc[ai][bj][m][n], 0, 0, 0); __builtin_amdgcn_s_setprio(0); } while (0)
#define PG8_WAIT_V(n) asm volatile("s_waitcnt vmcnt(" #n ")" ::: "memory")
#define PG8_WAIT_L(n) asm volatile("s_waitcnt lgkmcnt(" #n ")" ::: "memory")
#define PG8_BAR __builtin_amdgcn_s_barrier()
#define PG8_SCHED __builtin_amdgcn_sched_barrier(0)
    Unit cur, nxt; int ui = 0;
    if (!S.next(0, cur)) return;
    f32x4 acc[2][2][4][2];
#pragma unroll
    for (int a = 0; a < 2; ++a)
#pragma unroll
        for (int b = 0; b < 2; ++b)
#pragma unroll
            for (int m = 0; m < 4; ++m)
#pragma unroll
                for (int n = 0; n < 2; ++n) acc[a][b][m][n] = (f32x4){0.f, 0.f, 0.f, 0.f};
    bf16x8 At[4][2], B0[2][2], B1[2][2];
    const char* cA = (const char*)g.A + (size_t)cur.pm * tstep; const char* cB = (const char*)g.Bt + (size_t)cur.pn * tstep;
    S.a_ready(cur);
    if constexpr (SP2) {
        PG8_STAGE(PG8_SB(0, 0), cB, voffB); PG8_STAGE(PG8_SB(0, 1), cB + hstep, voffB); PG8_STAGE(PG8_SA(0, 0), cA, voffA); PG8_STAGE(PG8_SA(0, 1), cA + hstep, voffA);
        if (wr == 1) PG8_BAR;
        PG8_WAIT_V(2); PG8_BAR;
        PG8_STAGE(PG8_SB(1, 0), cB + kstep, voffB); PG8_STAGE(PG8_SA(1, 0), cA + kstep, voffA); PG8_STAGE(PG8_SB(1, 1), cB + hstep + kstep, voffB);
        PG8_WAIT_V(6); PG8_BAR;
    } else {
        PG8_STAGE(PG8_SB(0, 0), cB, voffB); PG8_STAGE(PG8_SA(0, 0), cA, voffA); PG8_STAGE(PG8_SB(0, 1), cB + hstep, voffB); PG8_STAGE(PG8_SA(0, 1), cA + hstep, voffA);
        if (wr == 1) PG8_BAR;
        PG8_WAIT_V(4); PG8_BAR;
        PG8_STAGE(PG8_SB(1, 0), cB + kstep, voffB); PG8_STAGE(PG8_SA(1, 0), cA + kstep, voffA); PG8_STAGE(PG8_SB(1, 1), cB + hstep + kstep, voffB);
        PG8_WAIT_V(6); PG8_BAR;
    }
    for (;;) {
        const bool has_next = S.next(ui + 1, nxt);
        const char* nA = has_next ? (const char*)g.A + (size_t)nxt.pm * tstep : cA; const char* nB = has_next ? (const char*)g.Bt + (size_t)nxt.pn * tstep : cB;
        for (int t = 0; t < nt; t += 2) {
            const bool last = (t == nt - 2);
            const char* a1 = cA + (size_t)(t + 1) * kstep;
            const char* a2 = last ? nA : cA + (size_t)(t + 2) * kstep; const char* b2 = last ? nB : cB + (size_t)(t + 2) * kstep;
            const char* a3 = a2 + kstep; const char* b3 = b2 + kstep;
            if (last && has_next) S.a_ready(nxt);
            if (last) E.prefetch(lds + 139264, cur, wid, lane);
            if constexpr (SP2) {
            PG8_LDB(B0, 0, 0); PG8_LDB(B1, 0, 1); PG8_SCHED; PG8_LDA(At, 0, 0); PG8_STAGE(PG8_SA(1, 1), a1 + hstep, voffA);
            PG8_WAIT_V(8); PG8_WAIT_L(0); PG8_BAR; PG8_MMA(0, 0, At, B0); PG8_MMA(0, 1, At, B1); PG8_BAR; PG8_SCHED;
            PG8_LDA(At, 0, 1); PG8_STAGE(PG8_SB(0, 0), b2, voffB); PG8_STAGE(PG8_SB(0, 1), b2 + hstep, voffB); PG8_STAGE(PG8_SA(0, 0), a2, voffA);
            PG8_WAIT_V(8); PG8_WAIT_L(0); PG8_BAR; PG8_MMA(1, 0, At, B0); PG8_MMA(1, 1, At, B1); PG8_BAR; PG8_SCHED;
            PG8_LDB(B0, 1, 0); PG8_LDB(B1, 1, 1); PG8_SCHED; PG8_LDA(At, 1, 0); PG8_STAGE(PG8_SA(0, 1), a2 + hstep, voffA);
            PG8_WAIT_V(8); PG8_WAIT_L(0); PG8_BAR; PG8_MMA(0, 0, At, B0); PG8_MMA(0, 1, At, B1); PG8_BAR; PG8_SCHED;
            PG8_LDA(At, 1, 1); PG8_STAGE(PG8_SB(1, 0), b3, voffB); PG8_STAGE(PG8_SB(1, 1), b3 + hstep, voffB); PG8_STAGE(PG8_SA(1, 0), a3, voffA);
            PG8_WAIT_V(8); PG8_WAIT_L(0); PG8_BAR; PG8_MMA(1, 0, At, B0); PG8_MMA(1, 1, At, B1); PG8_BAR; PG8_SCHED;
            } else {
            PG8_LDB(B0, 0, 0); PG8_SCHED; PG8_LDA(At, 0, 0); PG8_STAGE(PG8_SA(1, 1), a1 + hstep, voffA);
            PG8_WAIT_L(8); PG8_BAR; PG8_WAIT_L(0); PG8_MMA(0, 0, At, B0); PG8_BAR; PG8_SCHED;
            PG8_LDB(B1, 0, 1); PG8_STAGE(PG8_SB(0, 0), b2, voffB);
            PG8_BAR; PG8_WAIT_L(0); PG8_MMA(0, 1, At, B1); PG8_BAR;
            PG8_LDA(At, 0, 1); PG8_STAGE(PG8_SA(0, 0), a2, voffA);
            PG8_BAR; PG8_WAIT_L(0); PG8_MMA(1, 0, At, B0); PG8_BAR; PG8_SCHED;
            PG8_STAGE(PG8_SB(0, 1), b2 + hstep, voffB);
            PG8_WAIT_V(6); PG8_BAR; PG8_MMA(1, 1, At, B1); PG8_BAR;
            PG8_LDB(B0, 1, 0); PG8_SCHED; PG8_LDA(At, 1, 0); PG8_STAGE(PG8_SA(0, 1), a2 + hstep, voffA);
            PG8_WAIT_L(8); PG8_BAR; PG8_WAIT_L(0); PG8_MMA(0, 0, At, B0); PG8_BAR; PG8_SCHED;
            PG8_LDB(B1, 1, 1); PG8_STAGE(PG8_SB(1, 0), b3, voffB);
            PG8_BAR; PG8_WAIT_L(0); PG8_MMA(0, 1, At, B1); PG8_BAR;
            PG8_LDA(At, 1, 1); PG8_STAGE(PG8_SA(1, 0), a3, voffA);
            PG8_BAR; PG8_WAIT_L(0); PG8_MMA(1, 0, At, B0); PG8_BAR; PG8_SCHED;
            PG8_STAGE(PG8_SB(1, 1), b3 + hstep, voffB);
            PG8_WAIT_V(6); PG8_BAR; PG8_MMA(1, 1, At, B1); PG8_BAR;
            }
        }
        if constexpr (ALIGN_EPI) { if (wr == 0) PG8_BAR; }
        if constexpr (!Epi::AFTER_DRAIN) { E(acc, cur, wr, wc, fr, fq, lds + 139264); S.done(cur); }
        if (!has_next) break;
#pragma unroll
        for (int a = 0; a < 2; ++a)
#pragma unroll
            for (int b = 0; b < 2; ++b)
#pragma unroll
                for (int m = 0; m < 4; ++m)
#pragma unroll
                    for (int n = 0; n < 2; ++n) acc[a][b][m][n] = (f32x4){0.f, 0.f, 0.f, 0.f};
        cur = nxt; cA = nA; cB = nB; ++ui;
        if constexpr (ALIGN_EPI) { if (wr == 1) PG8_BAR; }
    }
    PG8_WAIT_V(0);
    if constexpr (!ALIGN_EPI) { if (wr == 0) PG8_BAR; }
    PG8_BAR;
    if constexpr (Epi::AFTER_DRAIN) { E.fused(acc, cur, wr, wc, fr, fq, lds, wid, lane); S.done(cur); }
#undef PG8_SA
#undef PG8_SB
#undef PG8_STAGE
#undef PG8_LDA
#undef PG8_LDB
#undef PG8_MMA
#undef PG8_WAIT_V
#undef PG8_WAIT_L
#undef PG8_BAR
#undef PG8_SCHED
}
}
#ifndef PG8_SP2
#define PG8_SP2 true
#endif
#ifndef PG8_ALIGN
#define PG8_ALIGN true
#endif
#include <hip/hip_bf16.h>
#include <cmath>
namespace attn_body {
using bf16=__hip_bfloat16;
using bf16x8=__attribute__((ext_vector_type(8)))short;
using s16x4=__attribute__((ext_vector_type(4)))short;
using f32x16=__attribute__((ext_vector_type(16)))float;
using u32x4=__attribute__((ext_vector_type(4)))unsigned;
constexpr int D=64;
constexpr int NW=8,QBLK=32,QB=QBLK*NW,KVBLK=64;
constexpr int ATTN_UNIT_ROWS=QB;
__device__ __forceinline__ int crow(int r,int hi){return (r&3)+8*(r>>2)+4*hi;}
#define SBAR() __builtin_amdgcn_sched_barrier(0)
constexpr int NSLOT=3, SLOTB=8192;
constexpr int LDS_K=0, LDS_V=NSLOT*SLOTB, LDS_WS=2*NSLOT*SLOTB, LDS_OST=LDS_WS+NW*64*4, LDS_BT=LDS_OST+NW*4096, LDS_BYTES=LDS_BT+768*4;
constexpr float C2=0.125f*1.4426950408889634f;
__device__ __forceinline__ void glds16(const void*gsrc,unsigned lds_dst){unsigned keep;
  asm volatile("s_mov_b32 %0, m0\n\ts_mov_b32 m0, %2\n\ts_nop 0\n\tglobal_load_lds_dwordx4 %1, off\n\ts_mov_b32 m0, %0":"=&s"(keep):"v"(gsrc),"s"(lds_dst):"memory");}
__device__ __forceinline__ void glds16s(const void*sbase,unsigned voff,unsigned lds_dst){unsigned keep;
  asm volatile("s_mov_b32 %0, m0\n\ts_mov_b32 m0, %3\n\ts_nop 0\n\tglobal_load_lds_dwordx4 %1, %2\n\ts_mov_b32 m0, %0":"=&s"(keep):"v"(voff),"s"(sbase),"s"(lds_dst):"memory");}
__device__ __forceinline__ float max3f(float a,float b,float c){float r;asm("v_max3_f32 %0, %1, %2, %3":"=v"(r):"v"(a),"v"(b),"v"(c));return r;}
__device__ __forceinline__ float max2f(float a,float b){float r;asm("v_max_f32_e32 %0, %1, %2":"=v"(r):"v"(a),"v"(b));return r;}
__device__ __forceinline__ float fadd_s(float a,float b){float r;asm("v_add_f32_e32 %0, %1, %2":"=v"(r):"v"(a),"v"(b));return r;}
__device__ __forceinline__ float fsub_s(float a,float b){float r;asm("v_sub_f32_e32 %0, %1, %2":"=v"(r):"v"(a),"v"(b));return r;}
typedef float f32x2_t __attribute__((ext_vector_type(2))); typedef __bf16 bf16x2_t __attribute__((ext_vector_type(2)));
__device__ __forceinline__ unsigned cvtpk_s(float lo,float hi){f32x2_t v={lo,hi};bf16x2_t b=__builtin_convertvector(v,bf16x2_t);return __builtin_bit_cast(unsigned,b);}
#define WAIT_BAR(N) asm volatile("s_waitcnt vmcnt(" #N ") lgkmcnt(0)\n\ts_barrier":::"memory")

__device__ __forceinline__ void qkt(f32x16&p0,f32x16&p1,const char*Kslot,const bf16x8*qr,const f32x16&negm,int r32,int hi){
  const char*kb=Kslot+hi*1024+r32*16;
  #pragma unroll
  for(int d0=0;d0<4;++d0){
    const bf16x8 b0=*reinterpret_cast<const bf16x8*>(kb+d0*2048);
    const bf16x8 b1=*reinterpret_cast<const bf16x8*>(kb+d0*2048+512);
    if(d0==0){p0=__builtin_amdgcn_mfma_f32_32x32x16_bf16(b0,qr[0],negm,0,0,0);p1=__builtin_amdgcn_mfma_f32_32x32x16_bf16(b1,qr[0],negm,0,0,0);}
    else{p0=__builtin_amdgcn_mfma_f32_32x32x16_bf16(b0,qr[d0],p0,0,0,0);p1=__builtin_amdgcn_mfma_f32_32x32x16_bf16(b1,qr[d0],p1,0,0,0);}}
}
typedef __attribute__((address_space(3))) const char* lds_cptr;
typedef short v4i16_t __attribute__((ext_vector_type(4)));
__device__ __forceinline__ void kload8(bf16x8*kf,lds_cptr kp){
  kf[0]=*(const __attribute__((address_space(3))) bf16x8*)(kp);      kf[1]=*(const __attribute__((address_space(3))) bf16x8*)(kp+512);
  kf[2]=*(const __attribute__((address_space(3))) bf16x8*)(kp+2048); kf[3]=*(const __attribute__((address_space(3))) bf16x8*)(kp+2560);
  kf[4]=*(const __attribute__((address_space(3))) bf16x8*)(kp+4096); kf[5]=*(const __attribute__((address_space(3))) bf16x8*)(kp+4608);
  kf[6]=*(const __attribute__((address_space(3))) bf16x8*)(kp+6144); kf[7]=*(const __attribute__((address_space(3))) bf16x8*)(kp+6656);
}
__device__ __forceinline__ void kload2(bf16x8*kf,lds_cptr kp,int j){ kf[2*j]=*(const __attribute__((address_space(3))) bf16x8*)(kp+j*2048); kf[2*j+1]=*(const __attribute__((address_space(3))) bf16x8*)(kp+j*2048+512); }
__device__ __forceinline__ s16x4 vtr(lds_cptr p){ return __builtin_bit_cast(s16x4,__builtin_amdgcn_ds_read_tr16_b64_v4i16((__attribute__((address_space(3))) v4i16_t*)p)); }
__device__ __forceinline__ float rowmax(const f32x16&p0,const f32x16&p1){
  float a=max3f(p0[0],p0[1],p1[0]),b=max3f(p0[2],p0[3],p1[1]);a=max3f(a,p1[2],p1[3]);
  #pragma unroll
  for(int r=4;r<16;r+=4){a=max3f(a,p0[r],p0[r+1]);b=max3f(b,p0[r+2],p0[r+3]);a=max3f(a,p1[r],p1[r+1]);b=max3f(b,p1[r+2],p1[r+3]);}
  const float m=max2f(a,b);
  auto rr=__builtin_amdgcn_permlane32_swap(__float_as_uint(m),__float_as_uint(m),false,false);
  return max2f(__uint_as_float(rr[0]),__uint_as_float(rr[1]));
}
__device__ __forceinline__ void pv(f32x16*o,int vb,bf16x8 pa0,bf16x8 pa1,bf16x8 pa2,bf16x8 pa3){
  #pragma unroll
  for(int d0=0;d0<2;++d0){s16x4 lo[4],hi[4];
    #pragma unroll
    for(int ks=0;ks<4;++ks){
      asm volatile("ds_read_b64_tr_b16 %0,%1 offset:%c2":"=&v"(lo[ks]):"v"(vb),"i"(d0*4096+ks*1024):"memory");
      asm volatile("ds_read_b64_tr_b16 %0,%1 offset:%c2":"=&v"(hi[ks]):"v"(vb),"i"(d0*4096+ks*1024+512):"memory");}
    asm volatile("s_waitcnt lgkmcnt(0)":::"memory");SBAR();
    #define PK(k) (bf16x8){lo[k][0],lo[k][1],lo[k][2],lo[k][3],hi[k][0],hi[k][1],hi[k][2],hi[k][3]}
    o[d0]=__builtin_amdgcn_mfma_f32_32x32x16_bf16(pa0,PK(0),o[d0],0,0,0);
    o[d0]=__builtin_amdgcn_mfma_f32_32x32x16_bf16(pa1,PK(1),o[d0],0,0,0);
    o[d0]=__builtin_amdgcn_mfma_f32_32x32x16_bf16(pa2,PK(2),o[d0],0,0,0);
    o[d0]=__builtin_amdgcn_mfma_f32_32x32x16_bf16(pa3,PK(3),o[d0],0,0,0);
    #undef PK
  }
}

#ifndef ATTN_STORE16
#define ATTN_STORE16(p,v) (*(u32x4*)(p)=(v))
#endif
template<int VH> struct AttnLds { static constexpr int KSL=8192, VSL=8192*VH, L_K=0, L_V=4*KSL, L_WS=L_V+3*VSL, L_BT=L_WS+NW*64*4, BYTES=L_BT+768*4; };
template<int VH,bool HAS_BIAS,int MODE> __device__ __forceinline__ void attn_unit2(const bf16*Qb,int qp,const bf16*__restrict__ Kb,int kp,const bf16*__restrict__ Vb,int vp,bf16*Ob,int op,int q0,int NT,const float*relb,char*shm,float lam,const float*subg,float gmul){
  typedef AttnLds<VH> LM; constexpr int KSL=LM::KSL, VSL=LM::VSL;
  int tid_=threadIdx.x; asm volatile("":"+v"(tid_));
  const int tid=tid_,lane=tid&63,r32=lane&31,hi=lane>>5; const int wid=__builtin_amdgcn_readfirstlane(tid>>6);
  const bf16*Qw=Qb+(long)(q0+wid*QBLK)*qp;
  const unsigned lds0=(unsigned)(uintptr_t)shm;
  const lds_cptr shm3=(lds_cptr)shm;
  float*wsf=(float*)(shm+LM::L_WS)+wid*64;
  const unsigned ksrc=(unsigned)(lane*kp+wid*8)*2u;
  const unsigned vsrc=(unsigned)((16*(wid&3)+(lane>>2))*vp+(wid>>2)*32+(lane&3)*8)*2u;
  const unsigned kdst=lds0+LM::L_K+wid*1024, vdst=lds0+LM::L_V+wid*1024;
  #define DMA_K(t,slot) glds16s(Kb+(long)(t)*KVBLK*kp,ksrc,(unsigned)__builtin_amdgcn_readfirstlane(kdst+(slot)))
  #define DMA_V(t,slot) do{ glds16s(Vb+(long)(t)*KVBLK*vp,vsrc,(unsigned)__builtin_amdgcn_readfirstlane(vdst+(slot))); \
      if(VH==2) glds16s(Vb+(long)(t)*KVBLK*vp+64,vsrc,(unsigned)__builtin_amdgcn_readfirstlane(vdst+(slot)+8192)); }while(0)
  const int vb0=(int)(lds0+LM::L_V)+((lane>>4)&1)*32+(lane&3)*8+(4*hi+((lane&15)>>2))*64;
  const lds_cptr kp0=shm3+LM::L_K+hi*1024+r32*16;
  const lds_cptr vp0=shm3+LM::L_V+((lane>>4)&1)*32+(lane&3)*8+(4*hi+((lane&15)>>2))*64;
  const int qw_=q0+32*wid; const int tn0=HAS_BIAS?(qw_>=90?((qw_-90)>>6):0):0, tn1=HAS_BIAS?(((qw_+185)>>6)<NT?((qw_+185)>>6):NT):0;
  float cb=0.f,ca=0.f;
  typedef __attribute__((address_space(3))) float lds_f32;
  typedef __attribute__((address_space(3))) char* lds_ptr_;
  lds_f32* btab=(lds_f32*)((lds_ptr_)shm)+LM::L_BT/4;
  if(HAS_BIAS){ const float L2E=1.4426950408889634f; cb=L2E*relb[15*8]; ca=L2E*relb[31*8];
    for(int i=tid;i<768;i+=512){ const int rel=i-384; const int n=rel<0?-rel:rel; int bk=n<8?n:(8+(31-__builtin_clz((unsigned)(n*n)))-6); if(n>=8&&bk>15)bk=15; if(rel>0)bk+=16; btab[i]=L2E*relb[bk*8]; } }
  const int lanebias=-q0-32*wid-r32+4*hi+384;
  #define CREG(tt) (HAS_BIAS?(((tt)<tn0)?cb:(((tt)<tn1)?0.f:ca)):0.f)
  #define BIASADD(P0,P1,t) do{ if(HAS_BIAS&&(t)>=tn0&&(t)<tn1){ const lds_f32*bp_=btab+(64*(t)+lanebias); \
    _Pragma("unroll") for(int r=0;r<16;++r){ P0[r]+=bp_[(r&3)+8*(r>>2)]; P1[r]+=bp_[(r&3)+8*(r>>2)+32]; } } }while(0)
  #define RSCALE(t) do{ if(HAS_BIAS&&((t)==tn0||(t)==tn1)){ const float f_=__builtin_amdgcn_exp2f(CREG((t)-1)-CREG(t)); l_reg*=f_; \
    _Pragma("unroll") for(int d_=0;d_<2*VH;++d_) _Pragma("unroll") for(int r=0;r<16;++r)o[d_][r]*=f_; } }while(0)
  DMA_K(0,0);DMA_V(0,0);DMA_K(1,KSL);
  bf16x8 qr[4];
  #pragma unroll
  for(int d0=0;d0<4;++d0)qr[d0]=*reinterpret_cast<const bf16x8*>(&Qw[(long)r32*qp+d0*16+hi*8]);
  DMA_K(2,2*KSL);
  float l_reg=0.f;f32x16 o[2*VH];
  #pragma unroll
  for(int d_=0;d_<2*VH;++d_)o[d_]=f32x16{};
  const f32x16 zero16=f32x16{};
  f32x16 pA0,pA1,pB0,pB1; bf16x8 kf[4];
  int sv_prev=0,sv_cur=0,sv_next=VSL;
  #define ROT() do{sv_prev=sv_cur;sv_cur=sv_next;sv_next=(sv_next==2*VSL)?0:sv_next+VSL;}while(0)
  #define KLD(p) (*(const __attribute__((address_space(3))) bf16x8*)(p))
  #define KPRE(tn) do{ const lds_cptr kn_=kp0+(((tn)&3)*KSL); kf[0]=KLD(kn_); kf[1]=KLD(kn_+512); kf[2]=KLD(kn_+2048); kf[3]=KLD(kn_+2560); }while(0)
  if(VH==1){WAIT_BAR(3);}else{WAIT_BAR(4);}
  qkt(pA0,pA1,shm+LM::L_K,qr,zero16,r32,hi);
  BIASADD(pA0,pA1,0);
  _Pragma("unroll") for(int r=0;r<16;++r){pA0[r]=__builtin_amdgcn_exp2f(pA0[r]);pA1[r]=__builtin_amdgcn_exp2f(pA1[r]);}
  WAIT_BAR(0);
  DMA_K(3,3*KSL);DMA_V(1,VSL);
  ROT();
  KPRE(1);
  s16x4 vlo[8],vhi[8]; u32x4 pw0,pw1,pw2,pw3;
  #define PKW(P,B) cvtpk_s(P[B],P[B+1])
  #define PAF(k) __builtin_bit_cast(bf16x8,pw##k)
  #define VFR(i) (bf16x8){vlo[i][0],vlo[i][1],vlo[i][2],vlo[i][3],vhi[i][0],vhi[i][1],vhi[i][2],vhi[i][3]}
  #define PIN(x) asm volatile("":"+v"(x))
  #define MF(a,b,c) __builtin_amdgcn_mfma_f32_32x32x16_bf16(a,b,c,0,0,0)
  #define GAPA(MFX,A0,A1,A2,A3,W0,W1,PW) do{ MFX; sacc+=A0; sacc+=A1; sacc+=A2; sacc+=A3; PIN(sacc); W0; W1; PIN(PW); SBAR(); }while(0)
  #define EX(v) __builtin_amdgcn_exp2f(v)
  #define GAPB4(MFX,X,B) do{ MFX; X[B]=EX(X[B]); X[B+1]=EX(X[B+1]); X[B+2]=EX(X[B+2]); X[B+3]=EX(X[B+3]); PIN(X); SBAR(); }while(0)
  #define GAPB2(MFX,X,B) do{ MFX; X[B]=EX(X[B]); X[B+1]=EX(X[B+1]); PIN(X); SBAR(); }while(0)
  #define VRD(i,hv) do{ vlo[i]=vtr(vp_+((hv)*8192+((i)>>2)*4096+((i)&3)*1024)); vhi[i]=vtr(vp_+((hv)*8192+((i)>>2)*4096+((i)&3)*1024+512)); }while(0)
  #define STEP(C0,C1,P0,P1,t,GK,GV,GL) do{ SBAR(); \
    const lds_cptr vp_=vp0+sv_prev; const lds_cptr kq_=kp0+(((t)&3)*KSL); \
    VRD(0,0); SBAR(); float sacc=(P0[0]+P0[1]); \
    GAPA(C0=MF(kf[0],qr[0],zero16), P0[2],P0[3],P0[4],P0[5],     pw0[0]=PKW(P0,0), pw0[1]=PKW(P0,2), pw0); \
    VRD(4,0); SBAR(); GAPA(C1=MF(kf[1],qr[0],zero16), P0[6],P0[7],P0[8],P0[9],     pw0[2]=PKW(P0,4), pw0[3]=PKW(P0,6), pw0); \
    kf[0]=KLD(kq_+4096); kf[1]=KLD(kq_+4608); SBAR(); \
    VRD(1,0); SBAR(); GAPA(C0=MF(kf[2],qr[1],C0),   P0[10],P0[11],P0[12],P0[13], pw1[0]=PKW(P0,8), pw1[1]=PKW(P0,10), pw1); \
    VRD(5,0); SBAR(); GAPA(C1=MF(kf[3],qr[1],C1),   P0[14],P0[15],P1[0],P1[1],   pw1[2]=PKW(P0,12),pw1[3]=PKW(P0,14), pw1); \
    kf[2]=KLD(kq_+6144); kf[3]=KLD(kq_+6656); SBAR(); \
    VRD(2,0); SBAR(); GAPA(C0=MF(kf[0],qr[2],C0),   P1[2],P1[3],P1[4],P1[5],     pw2[0]=PKW(P1,0), pw2[1]=PKW(P1,2), pw2); \
    VRD(6,0); SBAR(); GAPA(C1=MF(kf[1],qr[2],C1),   P1[6],P1[7],P1[8],P1[9],     pw2[2]=PKW(P1,4), pw2[3]=PKW(P1,6), pw2); \
    VRD(3,0); SBAR(); GAPA(C0=MF(kf[2],qr[3],C0),   P1[10],P1[11],P1[12],P1[13], pw3[0]=PKW(P1,8), pw3[1]=PKW(P1,10), pw3); \
    VRD(7,0); SBAR(); GAPA(C1=MF(kf[3],qr[3],C1),   P1[14],P1[15],0.f,0.f,       pw3[2]=PKW(P1,12),pw3[3]=PKW(P1,14), pw3); \
    l_reg+=sacc; \
    if(GK){DMA_K((t)+3,(((t)+3)&3)*KSL);} if(GV){DMA_V((t)+1,sv_next);} \
    BIASADD(C0,C1,t); SBAR(); \
    if(VH==1){ \
      GAPB4(o[0]=MF(PAF(0),VFR(0),o[0]), C0,0); \
      GAPB4(o[1]=MF(PAF(0),VFR(4),o[1]), C0,4); \
      GAPB4(o[0]=MF(PAF(1),VFR(1),o[0]), C0,8); \
      GAPB4(o[1]=MF(PAF(1),VFR(5),o[1]), C0,12); \
      if(GL){ KPRE((t)+1); SBAR(); } \
      GAPB4(o[0]=MF(PAF(2),VFR(2),o[0]), C1,0); \
      GAPB4(o[1]=MF(PAF(2),VFR(6),o[1]), C1,4); \
      GAPB4(o[0]=MF(PAF(3),VFR(3),o[0]), C1,8); \
      GAPB4(o[1]=MF(PAF(3),VFR(7),o[1]), C1,12); \
    } else { \
      GAPB2(o[0]=MF(PAF(0),VFR(0),o[0]), C0,0);  VRD(0,1); SBAR(); \
      GAPB2(o[1]=MF(PAF(0),VFR(4),o[1]), C0,2);  VRD(4,1); SBAR(); \
      GAPB2(o[0]=MF(PAF(1),VFR(1),o[0]), C0,4);  VRD(1,1); SBAR(); \
      GAPB2(o[1]=MF(PAF(1),VFR(5),o[1]), C0,6);  VRD(5,1); SBAR(); \
      GAPB2(o[0]=MF(PAF(2),VFR(2),o[0]), C0,8);  VRD(2,1); SBAR(); \
      GAPB2(o[1]=MF(PAF(2),VFR(6),o[1]), C0,10); VRD(6,1); SBAR(); \
      GAPB2(o[0]=MF(PAF(3),VFR(3),o[0]), C0,12); VRD(3,1); SBAR(); \
      GAPB2(o[1]=MF(PAF(3),VFR(7),o[1]), C0,14); VRD(7,1); SBAR(); \
      if(GL){ KPRE((t)+1); SBAR(); } \
      GAPB2(o[2*(VH-1)]=MF(PAF(0),VFR(0),o[2*(VH-1)]), C1,0); \
      GAPB2(o[2*(VH-1)+1]=MF(PAF(0),VFR(4),o[2*(VH-1)+1]), C1,2); \
      GAPB2(o[2*(VH-1)]=MF(PAF(1),VFR(1),o[2*(VH-1)]), C1,4); \
      GAPB2(o[2*(VH-1)+1]=MF(PAF(1),VFR(5),o[2*(VH-1)+1]), C1,6); \
      GAPB2(o[2*(VH-1)]=MF(PAF(2),VFR(2),o[2*(VH-1)]), C1,8); \
      GAPB2(o[2*(VH-1)+1]=MF(PAF(2),VFR(6),o[2*(VH-1)+1]), C1,10); \
      GAPB2(o[2*(VH-1)]=MF(PAF(3),VFR(3),o[2*(VH-1)]), C1,12); \
      GAPB2(o[2*(VH-1)+1]=MF(PAF(3),VFR(7),o[2*(VH-1)+1]), C1,14); \
    } \
    }while(0)
  #define WAITFULL() do{ if(VH==1){WAIT_BAR(2);}else{WAIT_BAR(3);} }while(0)
  #define ENDW(tt) do{ if((tt)+3<NT){WAITFULL();} else if((tt)+2<NT){ if(VH==1){WAIT_BAR(1);}else{WAIT_BAR(2);} } else {WAIT_BAR(0);} }while(0)
  int t=1;
  for(;t+5<NT;t+=2){
    STEP(pB0,pB1,pA0,pA1,t,true,true,true);     WAITFULL(); RSCALE(t);   ROT();
    STEP(pA0,pA1,pB0,pB1,t+1,true,true,true);   WAITFULL(); RSCALE(t+1); ROT();
  }
  for(;t+1<NT;t+=2){
    STEP(pB0,pB1,pA0,pA1,t,(t+3<NT),(t+1<NT),(t+1<NT));       ENDW(t);   RSCALE(t);   ROT();
    STEP(pA0,pA1,pB0,pB1,t+1,(t+4<NT),(t+2<NT),(t+2<NT));     ENDW(t+1); RSCALE(t+1); ROT();
  }
  STEP(pB0,pB1,pA0,pA1,NT-1,false,false,false); RSCALE(NT-1);
  { float sacc=pB0[0]+pB0[1]; _Pragma("unroll") for(int r=2;r<16;++r)sacc+=pB0[r]; _Pragma("unroll") for(int r=0;r<16;++r)sacc+=pB1[r]; l_reg+=sacc;
    pw0=(u32x4){PKW(pB0,0),PKW(pB0,2),PKW(pB0,4),PKW(pB0,6)};pw1=(u32x4){PKW(pB0,8),PKW(pB0,10),PKW(pB0,12),PKW(pB0,14)};pw2=(u32x4){PKW(pB1,0),PKW(pB1,2),PKW(pB1,4),PKW(pB1,6)};pw3=(u32x4){PKW(pB1,8),PKW(pB1,10),PKW(pB1,12),PKW(pB1,14)};
    SBAR(); pv(o,vb0+sv_cur,PAF(0),PAF(1),PAF(2),PAF(3)); if(VH==2){ SBAR(); pv(o+2*(VH-1),vb0+sv_cur+8192,PAF(0),PAF(1),PAF(2),PAF(3)); } }
  #undef PKW
  #undef PAF
  #undef VFR
  #undef PIN
  #undef MF
  #undef GAPA
  #undef GAPB4
  #undef GAPB2
  #undef EX
  #undef VRD
  #undef STEP
  #undef ENDW
  #undef WAITFULL
  #undef KLD
  #undef KPRE
  {auto rr=__builtin_amdgcn_permlane32_swap(__float_as_uint(l_reg),__float_as_uint(l_reg),false,false);l_reg=__uint_as_float(rr[0])+__uint_as_float(rr[1]);}
  if(hi==0)wsf[32+r32]=l_reg;
  asm volatile("s_waitcnt lgkmcnt(0)\n\ts_barrier":::"memory");
  float rli[16];
  #pragma unroll
  for(int r=0;r<16;++r)rli[r]=__builtin_amdgcn_rcpf(wsf[32+crow(r,hi)]);
  bf16*Ow=Ob+(long)(q0+wid*QBLK)*op;
  typedef __attribute__((address_space(3))) unsigned lds_u32;
  lds_u32* park=(lds_u32*)((lds_ptr_)shm+LM::BYTES)+tid;
  if(MODE==1){
    #pragma unroll
    for(int d0=0;d0<2*VH;++d0)
      #pragma unroll
      for(int r=0;r<16;r+=2)park[(d0*8+(r>>1))*512]=cvtpk_s(o[d0][r]*rli[r],o[d0][r+1]*rli[r+1]);
  } else {
    if(MODE==2){
      #pragma unroll
      for(int d0=0;d0<2*VH;++d0)
        #pragma unroll
        for(int r=0;r<16;r+=2){ const unsigned w_=park[(d0*8+(r>>1))*512];
          o[d0][r]=__uint_as_float(w_<<16)-lam*(o[d0][r]*rli[r]); o[d0][r+1]=__uint_as_float(w_&0xffff0000u)-lam*(o[d0][r+1]*rli[r+1]); }
      float gsub[2*VH];
      #pragma unroll
      for(int d0=0;d0<2*VH;++d0)gsub[d0]=subg[d0*32+r32]*gmul;
      #pragma unroll
      for(int r=0;r<16;++r){ float ss=0.f;
        #pragma unroll
        for(int d0=0;d0<2*VH;++d0)ss+=o[d0][r]*o[d0][r];
        ss+=__shfl_xor(ss,1);ss+=__shfl_xor(ss,2);ss+=__shfl_xor(ss,4);ss+=__shfl_xor(ss,8);ss+=__shfl_xor(ss,16);
        const float rs=__builtin_amdgcn_rsqf(ss*(1.0f/(64.f*VH))+1e-6f);
        #pragma unroll
        for(int d0=0;d0<2*VH;++d0)o[d0][r]=o[d0][r]*rs*gsub[d0];
        rli[r]=1.0f; }
    }
    { bf16*stg=(bf16*)(shm)+wid*(2048*VH);
      #pragma unroll
      for(int r=0;r<16;++r){const int orow=crow(r,hi);
        #pragma unroll
        for(int d0=0;d0<2*VH;++d0)stg[orow*(64*VH)+d0*32+r32]=__float2bfloat16(o[d0][r]*rli[r]);}
      asm volatile("s_waitcnt lgkmcnt(0)":::"memory");
      #pragma unroll
      for(int i=0;i<4*VH;++i){const int row=(VH==1)?(i*8+(lane>>3)):(i*4+(lane>>4)),ch=(VH==1)?(lane&7):(lane&15); const u32x4 v=*(const u32x4*)(stg+row*(64*VH)+ch*8); ATTN_STORE16(Ow+(long)row*op+ch*8,v);} }
  }
  asm volatile("s_waitcnt lgkmcnt(0)\n\ts_barrier":::"memory");
  #undef DMA_K
  #undef DMA_V
  #undef BIASADD
  #undef CREG
  #undef RSCALE
  #undef ROT
}
#undef SBAR
#undef WAIT_BAR
}
constexpr int NWAVES = 8;
constexpr int DM = 1024, MP = 65536, MS = 16384, MT = MP + MS, NSEQ = 33, LP = 2048, LS = 16384, DFF = 2816, NMOD = 6144;
constexpr float EPS = 1e-6f;
constexpr float LAMBDA_INIT1 = 0.35550907f;
constexpr float QSCALE = 0.125f * 1.4426950408889634f;
constexpr size_t MiB = 1u << 20;
constexpr size_t WS_BAR = 0, BAR_BYTES = 16384;
constexpr size_t WS_MOD = 1 * MiB;
constexpr size_t WS_ROPE = 3 * MiB;
constexpr size_t WS_WQKVA = 4 * MiB, WS_WOA = 7 * MiB, WS_WQKVB = 9 * MiB, WS_WOB = 15 * MiB, WS_WGU = 17 * MiB  , WS_WD = 39 * MiB  ;
constexpr size_t WS_BV = 51 * MiB;
constexpr size_t WS_RSS = 54 * MiB;
constexpr int BV_GU0 = 0, BV_QKV1 = 33 * 5632, BV_GU1 = 33 * 5632 + 33 * 3072;
constexpr size_t WS_H = 64 * MiB, WS_Q = 224 * MiB, WS_K = 384 * MiB, WS_V = 544 * MiB, WS_O = 704 * MiB, WS_END = 864 * MiB;
constexpr size_t WS_ACT = WS_Q;
constexpr size_t WS_OC0 = WS_H, WS_OC1 = WS_O;
static_assert(WS_WD + 2 * (size_t)DM * DFF * 2 <= WS_H && WS_ACT + (size_t)MT * DFF * 2 <= WS_O, "ws map");
constexpr int RING_OFF = 0;
constexpr int LDS_BYTES = 155648;

#define GAS __attribute__((address_space(1)))
#define LAS __attribute__((address_space(3)))
typedef unsigned short bf16;
typedef unsigned v4u __attribute__((ext_vector_type(4)));
typedef float f32x4 __attribute__((ext_vector_type(4)));
#define LDS_WAIT() asm volatile("s_waitcnt lgkmcnt(0)" ::: "memory")
__device__ __forceinline__ unsigned f2bf(float f) { unsigned u = __builtin_bit_cast(unsigned, f); return (u + 0x7fffu + ((u >> 16) & 1u)) >> 16; }
__device__ __forceinline__ unsigned pk2(float lo, float hi) { return f2bf(lo) | (f2bf(hi) << 16); }
__device__ __forceinline__ float bf_lo(unsigned w) { return __builtin_bit_cast(float, w << 16); }
__device__ __forceinline__ float bf_hi(unsigned w) { return __builtin_bit_cast(float, w & 0xffff0000u); }
__device__ __forceinline__ float wave_sum(float v) {
#pragma unroll
    for (int o = 1; o < 64; o <<= 1) v += __shfl_xor(v, o);
    return v;
}
#define XB_TMO      128
#define XB_XCNT(j)  (256  + 64 * (j))
#define XB_XSUB(j)  (1280 + 64 * (j))
#define XB_XGEN(j)  (2304 + 64 * (j))
#define XB_TOP      3328
#define XB_TOPGEN   3392
#define XCD_BAR_WORDS 3456
#define XB_SPIN_CAP (1u << 18)

__device__ __forceinline__ unsigned xb_ld(unsigned* p)              { return __hip_atomic_load(p, __ATOMIC_RELAXED, __HIP_MEMORY_SCOPE_AGENT); }
__device__ __forceinline__ unsigned xb_add(unsigned* p, unsigned v) { return __hip_atomic_fetch_add(p, v, __ATOMIC_RELAXED, __HIP_MEMORY_SCOPE_AGENT); }
__device__ __forceinline__ unsigned xb_xcc_id() { return (unsigned)__builtin_amdgcn_s_getreg((3 << 11) | 20) & 0xFu; }
#define XB_SPIN(cond, bar) do { unsigned _sp = 0; while (cond) { __builtin_amdgcn_s_sleep(1); \
    if ((++_sp & 255u) == 0u) { if (xb_ld(&(bar)[XB_TMO])) break; if (_sp > XB_SPIN_CAP) { atomicAdd(&(bar)[XB_TMO], 1u); break; } } } } while (0)

struct XcdBarrier {
    unsigned* bar; unsigned x;
    volatile LAS unsigned* st;
};

__device__ __forceinline__ XcdBarrier xcd_barrier_post(unsigned* bar, volatile LAS unsigned* st) {
    XcdBarrier b; b.bar = bar; b.x = xb_xcc_id(); b.st = st;
    if (threadIdx.x == 0) (void)xb_add(&bar[XB_XCNT(b.x)], 1u);
    return b;
}
__device__ __forceinline__ void xcd_barrier_complete(unsigned* bar, unsigned x, unsigned& nloc, unsigned& nx) {
    const unsigned G = gridDim.x * gridDim.y * gridDim.z;
    unsigned sum, cnt, mine, sp = 0u;
    for (;;) {
        sum = 0u; cnt = 0u; mine = 0u;
#pragma unroll
        for (unsigned j = 0; j < 16; ++j) { const unsigned c = xb_ld(&bar[XB_XCNT(j)]); sum += c; cnt += (c > 0u) ? 1u : 0u; mine = (j == x) ? c : mine; }
        if (sum == G) break;
        __builtin_amdgcn_s_sleep(1);
        if ((++sp & 255u) == 0u) { if (xb_ld(&bar[XB_TMO])) break; if (sp > XB_SPIN_CAP) { atomicAdd(&bar[XB_TMO], 1u); break; } }
    }
    nloc = mine > 0u ? mine : 1u; nx = cnt > 0u ? cnt : 1u;
}

__device__ __forceinline__ void xcd_barrier(const XcdBarrier& b) {
    asm volatile("s_waitcnt vmcnt(0)" ::: "memory");
    __syncthreads();
    if (threadIdx.x == 0) {
        unsigned* bar = b.bar;
        __builtin_amdgcn_s_waitcnt(0);
        unsigned nloc = b.st[0], nx = b.st[1];
        if (nloc == 0u) { xcd_barrier_complete(bar, b.x, nloc, nx); b.st[0] = nloc; b.st[1] = nx; }
        const unsigned old = xb_add(&bar[XB_XSUB(b.x)], 1u);
        const unsigned gen = old / nloc;
        if (old + 1u == (gen + 1u) * nloc) {
            __builtin_amdgcn_fence(__ATOMIC_RELEASE, "agent");
            asm volatile("s_waitcnt vmcnt(0)" ::: "memory");
            const unsigned og = xb_add(&bar[XB_TOP], 1u);
            const unsigned tg = og / nx;
            if (og + 1u == (tg + 1u) * nx) xb_add(&bar[XB_TOPGEN], 1u);
            else XB_SPIN(xb_ld(&bar[XB_TOPGEN]) == tg, bar);
            __builtin_amdgcn_fence(__ATOMIC_ACQUIRE, "agent");
            xb_add(&bar[XB_XGEN(b.x)], 1u);
            asm volatile("s_waitcnt vmcnt(0)" ::: "memory");
        } else {
            XB_SPIN(xb_ld(&bar[XB_XGEN(b.x)]) == gen, bar);
            __builtin_amdgcn_fence(__ATOMIC_ACQUIRE, "agent");
            asm volatile("s_waitcnt vmcnt(0)" ::: "memory");
        }
    }
    __syncthreads();
}

__device__ __forceinline__ void p0_transpose_item(const float* W, int K, int N, bf16* WT, LAS float* scr, int k0, int n0, int drow0, int lane) {
    float tv[32];
#pragma unroll
    for (int i = 0; i < 32; ++i) { const int kk = 2 * i + (lane >> 5); tv[i] = W[(size_t)(k0 + kk) * N + n0 + (lane & 31)]; }
#pragma unroll
    for (int i = 0; i < 32; ++i) { const int kk = 2 * i + (lane >> 5); scr[kk * 33 + (lane & 31)] = tv[i]; }
    LDS_WAIT(); asm volatile("" ::: "memory");
    const int c = lane & 7;
#pragma unroll
    for (int j = 0; j < 4; ++j) { const int n = (lane >> 3) + 8 * j; const LAS float* s = scr + (8 * c) * 33 + n;
        v4u o; o.x = pk2(s[0 * 33], s[1 * 33]); o.y = pk2(s[2 * 33], s[3 * 33]); o.z = pk2(s[4 * 33], s[5 * 33]); o.w = pk2(s[6 * 33], s[7 * 33]);
        *(GAS v4u*)(WT + (size_t)(drow0 + n) * K + k0 + 8 * c) = o; }
    LDS_WAIT(); asm volatile("" ::: "memory");
}
__device__ __forceinline__ void gemv33c(int bidx, int bstride, int tid, const LAS float* vec, LAS float* red, const float* W, int N, float* outp, int ostride, const float* addb) {
    const int lane = tid & 63, wave = tid >> 6, kq = lane >> 4, nn = lane & 15, kbase = wave * 128 + 4 * kq;
    typedef float f4 __attribute__((ext_vector_type(4)));
    for (int cb = bidx; cb < N / 16; cb += bstride) {
        const float* Wn = W + 16 * cb + nn;
        float w[8][4];
#pragma unroll
        for (int u = 0; u < 8; ++u)
#pragma unroll
            for (int j = 0; j < 4; ++j) w[u][j] = Wn[(size_t)(kbase + 16 * u + j) * N];
        float acc[33];
#pragma unroll
        for (int s = 0; s < 33; ++s) acc[s] = 0.f;
#pragma unroll
        for (int s = 0; s < 33; ++s) {
#pragma unroll
            for (int u = 0; u < 8; ++u) { const f4 v = *(const LAS f4*)(vec + s * 1024 + kbase + 16 * u); acc[s] += (v.x * w[u][0] + v.y * w[u][1]) + (v.z * w[u][2] + v.w * w[u][3]); }
            asm volatile("" : "+v"(acc[s]) :: "memory"); }
#pragma unroll
        for (int s = 0; s < 33; ++s) { float a = acc[s]; a += __shfl_xor(a, 16); a += __shfl_xor(a, 32); if (kq == 0) red[(wave * 33 + s) * 16 + nn] = a; }
        __syncthreads();
        for (int o = tid; o < 528; o += 512) { const int s = o >> 4, n2 = o & 15; float a = 0.f;
#pragma unroll
            for (int ww = 0; ww < 8; ++ww) a += red[(ww * 33 + s) * 16 + n2];
            outp[(size_t)s * ostride + 16 * cb + n2] = a + (addb ? addb[16 * cb + n2] : 0.f); }
        __syncthreads();
    }
}
struct Args { const float* in[24]; float* out; unsigned char* ws; };

__device__ __forceinline__ void norm_rows(int gw, int NGW, int lane, const float* src_p, const float* src_s, const float* gain, const float* modl, int sh_off, int sc_off, bf16* H) {
    for (int m0 = gw; m0 < MT; m0 += 2 * NGW) {
        const int m1 = m0 + NGW; const bool has1 = m1 < MT; const int m1c = has1 ? m1 : m0;
        const float* s0 = (m0 < MP) ? src_p + (size_t)m0 * DM : src_s + (size_t)(m0 - MP) * DM;
        const float* s1 = (m1c < MP) ? src_p + (size_t)m1c * DM : src_s + (size_t)(m1c - MP) * DM;
        const GAS f32x4* x0 = (const GAS f32x4*)s0 + lane; const GAS f32x4* x1 = (const GAS f32x4*)s1 + lane;
        f32x4 v0[4], v1[4]; float q0 = 0.f, q1 = 0.f;
#pragma unroll
        for (int j = 0; j < 4; ++j) { v0[j] = x0[64 * j]; v1[j] = x1[64 * j]; }
#pragma unroll
        for (int j = 0; j < 4; ++j) { q0 += (v0[j].x * v0[j].x + v0[j].y * v0[j].y) + (v0[j].z * v0[j].z + v0[j].w * v0[j].w); q1 += (v1[j].x * v1[j].x + v1[j].y * v1[j].y) + (v1[j].z * v1[j].z + v1[j].w * v1[j].w); }
        const float r0 = __builtin_amdgcn_rsqf(wave_sum(q0) * (1.f / DM) + EPS), r1 = __builtin_amdgcn_rsqf(wave_sum(q1) * (1.f / DM) + EPS);
        const float* mr0 = modl + (size_t)((m0 < MP) ? (m0 >> 11) : 32) * NMOD; const float* mr1 = modl + (size_t)((m1c < MP) ? (m1c >> 11) : 32) * NMOD;
        GAS unsigned long long* o0 = (GAS unsigned long long*)(H + (size_t)m0 * DM) + lane; GAS unsigned long long* o1 = (GAS unsigned long long*)(H + (size_t)m1c * DM) + lane;
#pragma unroll
        for (int j = 0; j < 4; ++j) { const int col = 4 * lane + 256 * j; const f32x4 g = *(const f32x4*)(gain + col);
            const f32x4 y0 = (v0[j] * r0) * g * (*(const f32x4*)(mr0 + sc_off + col) + 1.0f) + *(const f32x4*)(mr0 + sh_off + col);
            o0[64 * j] = (unsigned long long)pk2(y0.x, y0.y) | ((unsigned long long)pk2(y0.z, y0.w) << 32);
            if (has1) { const f32x4 y1 = (v1[j] * r1) * g * (*(const f32x4*)(mr1 + sc_off + col) + 1.0f) + *(const f32x4*)(mr1 + sh_off + col);
                o1[64 * j] = (unsigned long long)pk2(y1.x, y1.y) | ((unsigned long long)pk2(y1.z, y1.w) << 32); } }
    }
}
__device__ __forceinline__ void qknorm_chunks(int gw, int NGW, int lane, bf16* buf, int nchunks, int row_width_log2, const float* gain, float qscale, bool rope, const float* ropetab) {
    const int d0 = 16 * (lane & 3);
    float g[16];
#pragma unroll
    for (int i = 0; i < 16; ++i) g[i] = gain[d0 + i] * qscale;
    for (int ci = gw; ci < nchunks; ci += NGW) {
        GAS v4u* p = (GAS v4u*)(buf + (size_t)ci * 1024 + 16 * lane);
        const v4u a = p[0], b = p[1];
        float x[16];
        x[0] = bf_lo(a.x); x[1] = bf_hi(a.x); x[2] = bf_lo(a.y); x[3] = bf_hi(a.y); x[4] = bf_lo(a.z); x[5] = bf_hi(a.z); x[6] = bf_lo(a.w); x[7] = bf_hi(a.w);
        x[8] = bf_lo(b.x); x[9] = bf_hi(b.x); x[10] = bf_lo(b.y); x[11] = bf_hi(b.y); x[12] = bf_lo(b.z); x[13] = bf_hi(b.z); x[14] = bf_lo(b.w); x[15] = bf_hi(b.w);
        float ss = 0.f;
#pragma unroll
        for (int i = 0; i < 16; ++i) ss += x[i] * x[i];
        ss += __shfl_xor(ss, 1); ss += __shfl_xor(ss, 2);
        const float r = __builtin_amdgcn_rsqf(ss * (1.f / 64.f) + EPS);
#pragma unroll
        for (int i = 0; i < 16; ++i) x[i] = x[i] * r * g[i];
        if (rope) {
            const int m = (int)((((size_t)ci * 1024 + 16 * lane)) >> row_width_log2);
            const int t = (m < MP) ? (m & (LP - 1)) : (m - MP);
            const int qd = lane & 3; const int pos = (qd < 2) ? (t >> 6) : (t & 63);
            const f32x4* tb = (const f32x4*)(ropetab + (size_t)(pos * 16 + 8 * (qd & 1)) * 2);
#pragma unroll
            for (int j = 0; j < 4; ++j) { const f32x4 cs = tb[j];
                const float a0 = x[4 * j], a1 = x[4 * j + 1], b0 = x[4 * j + 2], b1 = x[4 * j + 3];
                x[4 * j] = a0 * cs.x - a1 * cs.y; x[4 * j + 1] = a0 * cs.y + a1 * cs.x; x[4 * j + 2] = b0 * cs.z - b1 * cs.w; x[4 * j + 3] = b0 * cs.w + b1 * cs.z; }
        }
        v4u oa, ob;
        oa.x = pk2(x[0], x[1]); oa.y = pk2(x[2], x[3]); oa.z = pk2(x[4], x[5]); oa.w = pk2(x[6], x[7]);
        ob.x = pk2(x[8], x[9]); ob.y = pk2(x[10], x[11]); ob.z = pk2(x[12], x[13]); ob.w = pk2(x[14], x[15]);
        p[0] = oa; p[1] = ob;
    }
}
__device__ __forceinline__ void diff_combine(int gw, int NGW, int lane, const bf16* O0, bf16* O1, const float* subg, float lam) {
    const int d0 = 16 * (lane & 7);
    float g[16];
#pragma unroll
    for (int i = 0; i < 16; ++i) g[i] = subg[d0 + i] * (1.0f - LAMBDA_INIT1);
    for (int m = gw; m < MT; m += NGW) {
        const GAS v4u* p0 = (const GAS v4u*)(O0 + (size_t)m * 1024 + 16 * lane);
        GAS v4u* p1 = (GAS v4u*)(O1 + (size_t)m * 1024 + 16 * lane);
        const v4u a0 = p0[0], b0 = p0[1], a1 = p1[0], b1 = p1[1];
        float x[16];
#define DC(i, w0, w1) x[2 * (i)] = bf_lo(w0) - lam * bf_lo(w1); x[2 * (i) + 1] = bf_hi(w0) - lam * bf_hi(w1);
        DC(0, a0.x, a1.x) DC(1, a0.y, a1.y) DC(2, a0.z, a1.z) DC(3, a0.w, a1.w) DC(4, b0.x, b1.x) DC(5, b0.y, b1.y) DC(6, b0.z, b1.z) DC(7, b0.w, b1.w)
#undef DC
        float ss = 0.f;
#pragma unroll
        for (int i = 0; i < 16; ++i) ss += x[i] * x[i];
        ss += __shfl_xor(ss, 1); ss += __shfl_xor(ss, 2); ss += __shfl_xor(ss, 4);
        const float r = __builtin_amdgcn_rsqf(ss * (1.f / 128.f) + EPS);
#pragma unroll
        for (int i = 0; i < 16; ++i) x[i] = x[i] * r * g[i];
        v4u oa, ob;
        oa.x = pk2(x[0], x[1]); oa.y = pk2(x[2], x[3]); oa.z = pk2(x[4], x[5]); oa.w = pk2(x[6], x[7]);
        ob.x = pk2(x[8], x[9]); ob.y = pk2(x[10], x[11]); ob.z = pk2(x[12], x[13]); ob.w = pk2(x[14], x[15]);
        p1[0] = oa; p1[1] = ob;
    }
}

__global__ void __launch_bounds__(NWAVES * 64, 2) mega_fwd(Args args) {
    extern __shared__ __attribute__((aligned(16))) unsigned char lds[];
    cg::grid_group grid = cg::this_grid();
    LAS unsigned char* ldsl = (LAS unsigned char*)lds;
    const int tid = threadIdx.x, lane = tid & 63, wave = __builtin_amdgcn_readfirstlane(tid >> 6);
    const int G = gridDim.x;
    volatile LAS unsigned* bst = (volatile LAS unsigned*)(ldsl + 155584);
    if (tid < 16) bst[tid] = 0u;
    __syncthreads();
    XcdBarrier xbar; xbar.bar = (unsigned*)(args.ws + WS_BAR); xbar.x = xb_xcc_id(); xbar.st = bst;
    if (tid == 0) bst[4] = xb_add(&xbar.bar[XB_XCNT(xbar.x)], 1u);
    __syncthreads();
    const int lidx = __builtin_amdgcn_readfirstlane((int)bst[4]), xq = G >> 3;
    const bool hwmap = (G % 8 == 0) && ((int)xbar.x < 8) && (lidx < xq);
    const int bx = hwmap ? lidx * 8 + (int)xbar.x : (int)blockIdx.x;
    const int vcu = hwmap ? (int)xbar.x * xq + lidx : bx;
    const int gw = vcu * NWAVES + wave, NGW = G * NWAVES;
    typedef __attribute__((address_space(4))) const Args* cargs_t;
    const cargs_t ap0 = (cargs_t)__builtin_amdgcn_kernarg_segment_ptr();
#define AP() cargs_t ap = ap0; asm volatile("" : "+s"(ap))
#define WSP(T, off) ((T*)(ap->ws + (off)))
#define mod WSP(float, WS_MOD)
#define ropetab WSP(float, WS_ROPE)
#define Wqkv_a WSP(bf16, WS_WQKVA)
#define Wo_a WSP(bf16, WS_WOA)
#define Wqkv_b WSP(bf16, WS_WQKVB)
#define Wo_b WSP(bf16, WS_WOB)
#define Wgu WSP(bf16, WS_WGU)
#define Wd WSP(bf16, WS_WD)
#define H WSP(bf16, WS_H)
#define Qb WSP(bf16, WS_Q)
#define Kb WSP(bf16, WS_K)
#define Vb WSP(bf16, WS_V)
#define Ob WSP(bf16, WS_O)
#define ACT WSP(bf16, WS_ACT)
#define OC0 WSP(bf16, WS_OC0)
#define OC1 WSP(bf16, WS_OC1)
#define out (ap->out)
#define x_p (ap->in[0])
#define x_s (ap->in[1])
    {
        AP();
        LAS float* scr = (LAS float*)(ldsl + RING_OFF + wave * 16384);
        constexpr int I_QA = 16 * 48, I_OA = 16 * 32, I_QB = 16 * 96, I_OB = 16 * 32, I_GU = 16 * 176, I_D = 44 * 32;
        constexpr int NITEMS = I_QA + I_OA + I_QB + I_OB + 2 * I_GU + 2 * I_D;
        for (int it = gw; it < NITEMS; it += NGW) {
            int r = it;
            if (r < I_QA) { const int nb = r % 48, kb = r / 48; p0_transpose_item(ap->in[11], 1024, 1536, Wqkv_a, scr, 64 * kb, 32 * nb, 32 * nb, lane); continue; } r -= I_QA;
            if (r < I_OA) { const int nb = r % 32, kb = r / 32; p0_transpose_item(ap->in[12], 1024, 1024, Wo_a, scr, 64 * kb, 32 * nb, 32 * nb, lane); continue; } r -= I_OA;
            if (r < I_QB) { const int nb = r % 96, kb = r / 96; p0_transpose_item(ap->in[15], 1024, 3072, Wqkv_b, scr, 64 * kb, 32 * nb, 32 * nb, lane); continue; } r -= I_QB;
            if (r < I_OB) { const int nb = r % 32, kb = r / 32; p0_transpose_item(ap->in[16], 1024, 1024, Wo_b, scr, 64 * kb, 32 * nb, 32 * nb, lane); continue; } r -= I_OB;
            if (r < 2 * I_GU) { const int l = r / I_GU; r -= l * I_GU; const int nb = r % 176, kb = r / 176; const int n0 = 32 * nb;
                const int drow0 = (n0 < DFF) ? (n0 / 128) * 256 + (n0 % 128) : ((n0 - DFF) / 128) * 256 + 128 + ((n0 - DFF) % 128);
                p0_transpose_item(ap->in[8] + (size_t)l * 1024 * 5632, 1024, 5632, Wgu + (size_t)l * 5632 * 1024, scr, 64 * kb, n0, drow0, lane); continue; } r -= 2 * I_GU;
            { const int l = r / I_D; r -= l * I_D; const int nb = r % 32, kb = r / 32;
                p0_transpose_item(ap->in[9] + (size_t)l * DFF * 1024, DFF, 1024, Wd + (size_t)l * 1024 * DFF, scr, 64 * kb, 32 * nb, 32 * nb, lane); }
        }
        { const int gt = vcu * 512 + tid;
          if (gt < 4096) { const int pos = gt >> 4, f = gt & 15; const float inv = exp2f(-(float)f * (13.287712379549449f / 16.0f)); const float ang = (float)pos * inv;
              const float rev = ang * 0.15915494309189535f; ropetab[2 * gt] = __builtin_amdgcn_cosf(rev); ropetab[2 * gt + 1] = __builtin_amdgcn_sinf(rev); } }
        __syncthreads();
        LAS float* cact = (LAS float*)ldsl;
        for (int i = tid; i < NSEQ * 1024; i += 512) { const int s = i >> 10, k = i & 1023; const float c = (s < 32) ? ap->in[2][s * 1024 + k] : ap->in[3][k];
            cact[i] = c / (1.0f + __expf(-c)); }
        __syncthreads();
        { const int half = G / 2; const int l = (vcu >= half) ? 1 : 0;
          gemv33c(vcu - l * half, half > 0 ? half : 1, tid, cact, (LAS float*)(ldsl + 135168), ap->in[6] + (size_t)l * 1024 * NMOD, NMOD, mod + (size_t)l * NSEQ * NMOD, NMOD, ap->in[7] + l * NMOD); }
        { float* rss = WSP(float, WS_RSS); for (int i = vcu * 512 + tid; i < 3 * MT; i += G * 512) rss[i] = 0.f; }
        __syncthreads();
    }
    grid.sync();

    auto layer_body = [&](auto LC) __attribute__((always_inline)) {
        constexpr int layer = decltype(LC)::value;
        AP();
#define modl (mod + (size_t)layer * NSEQ * NMOD)
        if (layer == 0) {
            norm_rows(gw, NGW, lane, x_p, x_s, ap->in[4], modl, 0, 1024, H);
            LAS float* shv = (LAS float*)ldsl; float* bv = WSP(float, WS_BV);
#pragma unroll 1
            for (int which = 0; which < 3; ++which) {
                const float* shsrc = mod + (size_t)(which == 0 ? 0 : 1) * NSEQ * NMOD + (which == 1 ? 0 : 3072);
                for (int i = tid; i < NSEQ * 1024; i += 512) shv[i] = shsrc[(size_t)(i >> 10) * NMOD + (i & 1023)];
                __syncthreads();
                if (which == 0) gemv33c(vcu, G, tid, shv, (LAS float*)(ldsl + 135168), ap->in[8], 5632, bv + BV_GU0, 5632, nullptr);
                else if (which == 1) gemv33c(vcu, G, tid, shv, (LAS float*)(ldsl + 135168), ap->in[15], 3072, bv + BV_QKV1, 3072, nullptr);
                else gemv33c(vcu, G, tid, shv, (LAS float*)(ldsl + 135168), ap->in[8] + (size_t)1024 * 5632, 5632, bv + BV_GU1, 5632, nullptr);
                __syncthreads();
            }
            xcd_barrier(xbar);
        }
        if (layer == 0) {
            pg8::Gemm g{H, Wqkv_a, MT, 1536, 1024}; pg8::StaticOrder S; S.init(MT, 1536, G, bx);
            pg8::EpiSplit2<false, true> E{Qb, Kb, Vb, 1024, 256, 256, 4, 5, nullptr, nullptr, 0, ap->in[13], ap->in[14], QSCALE, ropetab, (LAS float*)(ldsl + 131072)};
            pg8::gemm_phase<pg8::EpiSplit2<false, true>, pg8::StaticOrder, true, PG8_SP2>(ldsl + RING_OFF, g, S, E);
        } else {
            pg8::Gemm g{H, Wqkv_b, MT, 3072, 1024}; pg8::StaticOrder S; S.init(MT, 3072, G, bx);
            pg8::EpiSplit2<true, false> E{Qb, Kb, Vb, 1024, 1024, 1024, 4, 8, WSP(float, WS_RSS) + MT, WSP(float, WS_BV) + BV_QKV1, 3072, ap->in[17], ap->in[18], QSCALE, ropetab, (LAS float*)(ldsl + 131072)};
            pg8::gemm_phase<pg8::EpiSplit2<true, false>, pg8::StaticOrder, true, PG8_SP2>(ldsl + RING_OFF, g, S, E);
        }
        xcd_barrier(xbar);
        if (layer == 0) {
            for (int idx = vcu; idx < 1024 + 4096; idx += G) {
                size_t tok0; int head, kvh, qb, NT;
                if (idx < 1024) { const int xcd = (idx >> 5) & 7, j = idx & 31, i = idx >> 8; kvh = xcd & 3; const int w = (((xcd >> 2) * 4 + i) << 5) + j; head = kvh * 4 + (w >> 6); qb = w & 63; tok0 = MP; NT = LS / 64; }
                else { const int id2 = idx - 1024; const int xcd = (id2 >> 5) & 7, j = id2 & 31, i = id2 >> 8; const int gq = xcd * 16 + i; kvh = gq & 3; head = kvh * 4 + (j >> 3); qb = j & 7; tok0 = (size_t)(gq >> 2) * LP; NT = LP / 64; }
                attn_body::attn_unit2<1, false, 0>((const attn_body::bf16*)(Qb + tok0 * 1024 + head * 64), 1024, (const attn_body::bf16*)(Kb + tok0 * 256 + kvh * 64), 256,
                    (const attn_body::bf16*)(Vb + tok0 * 256 + kvh * 64), 256, (attn_body::bf16*)(Ob + tok0 * 1024 + head * 64), 1024, qb * 256, NT, nullptr, (char*)lds + RING_OFF, 0.f, nullptr, 0.f); }
        } else {
            const float s1 = wave_sum(ap->in[19][lane] * ap->in[20][lane]), s2 = wave_sum(ap->in[21][lane] * ap->in[22][lane]);
            const float lam = expf(s1) - expf(s2) + LAMBDA_INIT1;
            for (int idx = vcu; idx < 512 + 2048; idx += G) {
                size_t tok0; int h, qb, NT;
                if (idx < 512) { const int xcd = (idx >> 5) & 7, j = idx & 31, i = idx >> 8; h = xcd; qb = (i << 5) + j; tok0 = MP; NT = LS / 64; }
                else { const int id2 = idx - 512; const int xcd = (id2 >> 5) & 7, j = id2 & 31, i = id2 >> 8; const int gq = ((xcd * 8 + i) << 2) + (j >> 3); h = gq & 7; qb = j & 7; tok0 = (size_t)(gq >> 3) * LP; NT = LP / 64; }
                attn_body::attn_unit2<2, true, 1>((const attn_body::bf16*)(Qb + tok0 * 1024 + (2 * h) * 64), 1024, (const attn_body::bf16*)(Kb + tok0 * 1024 + (2 * h) * 64), 1024,
                    (const attn_body::bf16*)(Vb + tok0 * 1024 + h * 128), 1024, (attn_body::bf16*)(Ob + tok0 * 1024 + h * 128), 1024, qb * 256, NT, ap->in[10] + h, (char*)lds + RING_OFF, lam, ap->in[23], 1.0f - LAMBDA_INIT1);
                attn_body::attn_unit2<2, true, 2>((const attn_body::bf16*)(Qb + tok0 * 1024 + (2 * h + 1) * 64), 1024, (const attn_body::bf16*)(Kb + tok0 * 1024 + (2 * h + 1) * 64), 1024,
                    (const attn_body::bf16*)(Vb + tok0 * 1024 + h * 128), 1024, (attn_body::bf16*)(Ob + tok0 * 1024 + h * 128), 1024, qb * 256, NT, ap->in[10] + h, (char*)lds + RING_OFF, lam, ap->in[23], 1.0f - LAMBDA_INIT1); }
        }
        xcd_barrier(xbar);
        {
            pg8::Gemm g{Ob, layer == 0 ? Wo_a : Wo_b, MT, 1024, 1024}; pg8::StaticOrder S; S.init(MT, 1024, G, bx);
            pg8::EpiResid2<true> E{layer == 0 ? x_p : out, layer == 0 ? (x_s - (size_t)MP * DM) : out, out, modl + 2048, ap->in[5] + layer * 1024, modl + 4096, H, WSP(float, WS_RSS) + (layer == 0 ? 0 : 2 * MT)};
            pg8::gemm_phase<pg8::EpiResid2<true>, pg8::StaticOrder, PG8_ALIGN, PG8_SP2>(ldsl + RING_OFF, g, S, E);
        }
        xcd_barrier(xbar);
        {
            pg8::Gemm g{H, Wgu + (size_t)layer * 5632 * 1024, MT, 5632, 1024}; pg8::StaticOrder S; S.init(MT, 5632, G, bx);
            pg8::EpiSwiGLU2 E{ACT, DFF, WSP(float, WS_RSS) + (layer == 0 ? 0 : 2 * MT), WSP(float, WS_BV) + (layer == 0 ? BV_GU0 : BV_GU1)};
            pg8::gemm_phase<pg8::EpiSwiGLU2, pg8::StaticOrder, PG8_ALIGN, PG8_SP2>(ldsl + RING_OFF, g, S, E);
        }
        xcd_barrier(xbar);
        {
            pg8::Gemm g{ACT, Wd + (size_t)layer * 1024 * DFF, MT, 1024, DFF}; pg8::StaticOrder S; S.init(MT, 1024, G, bx);
            if (layer == 0) {
                pg8::EpiResid2<true> E{out, out, out, modl + 5120, ap->in[4] + 1024, mod + (size_t)NSEQ * NMOD + 1024, H, WSP(float, WS_RSS) + MT};
                pg8::gemm_phase<pg8::EpiResid2<true>, pg8::StaticOrder, PG8_ALIGN, PG8_SP2>(ldsl + RING_OFF, g, S, E);
            } else {
                pg8::EpiResid2<false> E{out, out, out, modl + 5120, nullptr, nullptr, nullptr, nullptr};
                pg8::gemm_phase<pg8::EpiResid2<false>, pg8::StaticOrder, PG8_ALIGN, PG8_SP2>(ldsl + RING_OFF, g, S, E);
            }
        }
        if (layer == 0) xcd_barrier(xbar);
    };
    layer_body(std::integral_constant<int, 0>{});
    layer_body(std::integral_constant<int, 1>{});
}

#undef out
#undef H
#undef mod
#undef modl
#undef ACT
#undef Qb
#undef Kb
#undef Vb
#undef Ob
extern "C" void kernel_launch(void* const* d_in, const int* in_sizes, int n_in, void* d_out, int out_size, void* d_ws, size_t ws_size, hipStream_t stream) {
    static int grid = 0;
    if (grid == 0) {
        if (n_in != 24 || out_size != MT * DM || ws_size < WS_END) { fprintf(stderr, "kernel_launch: unexpected shapes (n_in %d, out %d, ws %zu)\n", n_in, out_size, ws_size); grid = -1; return; }
        int dev = 0, cus = 0, per_cu = 0;
        hipGetDevice(&dev); hipDeviceGetAttribute(&cus, hipDeviceAttributeMultiprocessorCount, dev);
        if (hipFuncSetAttribute((const void*)mega_fwd, hipFuncAttributeMaxDynamicSharedMemorySize, LDS_BYTES) != hipSuccess) { fprintf(stderr, "hipFuncSetAttribute failed\n"); grid = -1; return; }
        if (hipOccupancyMaxActiveBlocksPerMultiprocessor(&per_cu, (const void*)mega_fwd, NWAVES * 64, LDS_BYTES) != hipSuccess || per_cu < 1) per_cu = 1;
        (void)hipGetLastError();
        grid = cus;
        if (grid > 256) grid = 256;
    }
    if (grid < 0) return;
    if (hipMemsetAsync((char*)d_ws + WS_BAR, 0, BAR_BYTES, stream) != hipSuccess) { fprintf(stderr, "hipMemsetAsync of the barrier words failed\n"); return; }
    Args a{};
    for (int i = 0; i < 24; ++i) a.in[i] = (const float*)d_in[i];
    a.out = (float*)d_out; a.ws = (unsigned char*)d_ws;
    void* kargs[] = {&a};
    hipError_t e = hipLaunchCooperativeKernel((const void*)mega_fwd, dim3(grid), dim3(NWAVES * 64), kargs, LDS_BYTES, stream);
    if (e != hipSuccess) fprintf(stderr, "cooperative launch failed: %s (grid %d)\n", hipGetErrorString(e), grid);
}
```

```cpp
#include <hip/hip_runtime.h>
#include <hip/hip_cooperative_groups.h>
#include <hip/hip_bf16.h>
#include <cstdio>
#include <cstdint>
#include <cmath>
#include <type_traits>
namespace cg = cooperative_groups;
namespace pg8 {
#define PG8_LAS __attribute__((address_space(3)))
typedef unsigned short bf16_t;
typedef short bf16x8 __attribute__((ext_vector_type(8)));
typedef float f32x4 __attribute__((ext_vector_type(4)));
typedef unsigned u32x4 __attribute__((ext_vector_type(4)));
constexpr int BM = 256, BK = 64, HALF = 128, HTB = HALF * BK * 2  , STAGE_BYTES = 8 * HTB, NXCD = 8, WGM = 8;

__host__ __device__ __forceinline__ int lds_byte(int r, int c) { const int st = (r >> 4) * 2 + (c >> 5), rr = r & 15, cc = c & 31, ob = rr * 64 + cc * 2; return st * 1024 + (ob ^ (((ob >> 9) & 1) << 5)); }
__host__ __device__ __forceinline__ void stage_rc(int b, int& R, int& C) { const int st = b / 1024, sb = b % 1024, swz = sb ^ (((sb >> 9) & 1) << 5); R = (st >> 1) * 16 + swz / 64; C = (st & 1) * 32 + (swz % 64) / 2; }
__host__ __device__ __forceinline__ int perm32(int rho) { const int n = rho >> 4, i = rho & 15; return 8 * (i >> 2) + 4 * n + (i & 3); }

struct Unit { int pm, pn; };
struct Gemm { const bf16_t* A; const bf16_t* Bt; int M, N, K; };

struct StaticOrder {
    int nM, nN, nwg, G, c;
    __host__ __device__ void init(int M, int N, int G_, int c_) { nM = M / BM; nN = N / BM; nwg = nM * nN; G = G_; c = c_; }
    __host__ __device__ bool next(int i, Unit& u) const {
        const long L = (long)i * G + c; if (L >= nwg) return false;
        int wgid = (int)L; { const int q = nwg / NXCD, r = nwg % NXCD, xcd = wgid % NXCD, off = wgid / NXCD; wgid = (xcd < r ? xcd * (q + 1) : r * (q + 1) + (xcd - r) * q) + off; }
        const int nig = WGM * nN, gid = wgid / nig, fm = gid * WGM, gsz = (nM - fm) < WGM ? (nM - fm) : WGM;
        u.pm = fm + ((wgid % nig) % gsz); u.pn = (wgid % nig) / gsz; return true;
    }
    __device__ __forceinline__ void a_ready(const Unit&) const {}
    __device__ __forceinline__ void done(const Unit&) const {}
};

__device__ __forceinline__ unsigned cvt_pk_bf16(float lo, float hi) { unsigned r; asm volatile("v_cvt_pk_bf16_f32 %0, %1, %2" : "=v"(r) : "v"(lo), "v"(hi)); return r; }
typedef float f32x2 __attribute__((ext_vector_type(2)));
__device__ __forceinline__ float silu_mul(float g, float uu) { const float e = __builtin_amdgcn_exp2f(g * -1.4426950408889634f); return g * __builtin_amdgcn_rcpf(1.0f + e) * uu; }
constexpr float EPI_EPS = 1e-6f;
template <bool NEXT> struct EpiResid2 {
    static constexpr bool PERM = true, AFTER_DRAIN = false;
    const float* base_p; const float* base_s; float* out; const float* gate;
    const float* ngain; const float* nsc; bf16_t* Hn; float* rowss;
    __device__ __forceinline__ void prefetch(PG8_LAS unsigned char*, const Unit&, int, int) const {}
    __device__ __forceinline__ void operator()(const f32x4 (&acc)[2][2][4][2], const Unit& u, int wr, int wc, int fr, int fq, PG8_LAS unsigned char*) const {
        const int seq = (u.pm < 256) ? (u.pm >> 3) : 32;
        const float* base = (u.pm < 256) ? base_p : base_s;
        const int col0 = u.pn * BM + wc * 32 + 8 * fq;
        u32x4 dl[2][4][2];
        { f32x4 gv[2][2];
#pragma unroll
          for (int bj = 0; bj < 2; ++bj)
#pragma unroll
            for (int n = 0; n < 2; ++n) gv[bj][n] = *(const f32x4*)(gate + (size_t)seq * 6144 + col0 + bj * HALF + 4 * n);
#pragma unroll
          for (int ai = 0; ai < 2; ++ai)
#pragma unroll
            for (int m = 0; m < 4; ++m)
#pragma unroll
                for (int bj = 0; bj < 2; ++bj) { const f32x4 a = gv[bj][0] * acc[ai][bj][m][0], b = gv[bj][1] * acc[ai][bj][m][1];
                    dl[ai][m][bj].x = cvt_pk_bf16(a[0], a[1]); dl[ai][m][bj].y = cvt_pk_bf16(a[2], a[3]); dl[ai][m][bj].z = cvt_pk_bf16(b[0], b[1]); dl[ai][m][bj].w = cvt_pk_bf16(b[2], b[3]); } }
        f32x4 gm[2][2];
        if (NEXT) {
#pragma unroll
          for (int bj = 0; bj < 2; ++bj)
#pragma unroll
            for (int n = 0; n < 2; ++n) { const int c = col0 + bj * HALF + 4 * n; gm[bj][n] = *(const f32x4*)(ngain + c) * (*(const f32x4*)(nsc + (size_t)seq * 6144 + c) + 1.0f); } }
#define BFLO(w) __builtin_bit_cast(float, (w) << 16)
#define BFHI(w) __builtin_bit_cast(float, (w) & 0xffff0000u)
#pragma unroll
        for (int ai = 0; ai < 2; ++ai) {
            f32x4 bs[4][2][2];
#pragma unroll
            for (int m = 0; m < 4; ++m) { const size_t off = (size_t)(u.pm * BM + ai * HALF + wr * 64 + m * 16 + fr) * 1024 + col0;
#pragma unroll
                for (int bj = 0; bj < 2; ++bj) { bs[m][bj][0] = *(const f32x4*)(base + off + bj * HALF); bs[m][bj][1] = *(const f32x4*)(base + off + bj * HALF + 4); } }
#pragma unroll
            for (int m = 0; m < 4; ++m) { const int row = u.pm * BM + ai * HALF + wr * 64 + m * 16 + fr; const size_t off = (size_t)row * 1024 + col0; float ss = 0.f;
#pragma unroll
                for (int bj = 0; bj < 2; ++bj) { const u32x4 d = dl[ai][m][bj];
                    const f32x4 o0 = bs[m][bj][0] + (f32x4){BFLO(d.x), BFHI(d.x), BFLO(d.y), BFHI(d.y)}, o1 = bs[m][bj][1] + (f32x4){BFLO(d.z), BFHI(d.z), BFLO(d.w), BFHI(d.w)};
                    *(f32x4*)(out + off + bj * HALF) = o0; *(f32x4*)(out + off + bj * HALF + 4) = o1;
                    if (NEXT) { ss += (o0[0] * o0[0] + o0[1] * o0[1]) + (o0[2] * o0[2] + o0[3] * o0[3]) + (o1[0] * o1[0] + o1[1] * o1[1]) + (o1[2] * o1[2] + o1[3] * o1[3]);
                        const f32x4 h0 = o0 * gm[bj][0], h1 = o1 * gm[bj][1];
                        u32x4 w; w.x = cvt_pk_bf16(h0[0], h0[1]); w.y = cvt_pk_bf16(h0[2], h0[3]); w.z = cvt_pk_bf16(h1[0], h1[1]); w.w = cvt_pk_bf16(h1[2], h1[3]);
                        *(u32x4*)(Hn + off + bj * HALF) = w; } }
                if (NEXT) { ss += __shfl_xor(ss, 16); ss += __shfl_xor(ss, 32); if (fq == 0) __hip_atomic_fetch_add(rowss + row, ss, __ATOMIC_RELAXED, __HIP_MEMORY_SCOPE_AGENT); } }
            asm volatile("" ::: "memory"); }
#undef BFLO
#undef BFHI
    }
};

typedef _Float16 h16x2 __attribute__((ext_vector_type(2)));
__device__ __forceinline__ unsigned pk_h2(float a, float b) { const f32x2 v = {a, b}; return __builtin_bit_cast(unsigned, __builtin_convertvector(v, h16x2)); }
__device__ __forceinline__ f32x2 un_h2(unsigned w) { return __builtin_convertvector(__builtin_bit_cast(h16x2, w), f32x2); }
template <bool NEXT, bool BIN, bool BOUT> struct EpiResid4 {
    static constexpr bool PERM = true, AFTER_DRAIN = false;
    const float* base_p; const float* base_s; float* out; const unsigned short* base_h; unsigned short* out_h; const float* gate;
    const float* ngain; const float* nsc; bf16_t* Hn; float* rowss;
    __device__ __forceinline__ void prefetch(PG8_LAS unsigned char*, const Unit&, int, int) const {}
    __device__ __forceinline__ void operator()(const f32x4 (&acc)[2][2][4][2], const Unit& u, int wr, int wc, int fr, int fq, PG8_LAS unsigned char*) const {
        const int seq = (u.pm < 256) ? (u.pm >> 3) : 32;
        const float* base = (u.pm < 256) ? base_p : base_s;
        const int col0 = u.pn * BM + wc * 32 + 8 * fq;
        u32x4 dl[2][4][2];
        { f32x4 gv[2][2];
#pragma unroll
          for (int bj = 0; bj < 2; ++bj)
#pragma unroll
            for (int n = 0; n < 2; ++n) gv[bj][n] = *(const f32x4*)(gate + (size_t)seq * 6144 + col0 + bj * HALF + 4 * n);
#pragma unroll
          for (int ai = 0; ai < 2; ++ai)
#pragma unroll
            for (int m = 0; m < 4; ++m)
#pragma unroll
                for (int bj = 0; bj < 2; ++bj) { const f32x4 a = gv[bj][0] * acc[ai][bj][m][0], b = gv[bj][1] * acc[ai][bj][m][1];
                    dl[ai][m][bj].x = cvt_pk_bf16(a[0], a[1]); dl[ai][m][bj].y = cvt_pk_bf16(a[2], a[3]); dl[ai][m][bj].z = cvt_pk_bf16(b[0], b[1]); dl[ai][m][bj].w = cvt_pk_bf16(b[2], b[3]); } }
        f32x4 gm[2][2];
        if (NEXT) {
#pragma unroll
          for (int bj = 0; bj < 2; ++bj)
#pragma unroll
            for (int n = 0; n < 2; ++n) { const int c = col0 + bj * HALF + 4 * n; gm[bj][n] = *(const f32x4*)(ngain + c) * (*(const f32x4*)(nsc + (size_t)seq * 6144 + c) + 1.0f); } }
#define BFLO4(w) __builtin_bit_cast(float, (w) << 16)
#define BFHI4(w) __builtin_bit_cast(float, (w) & 0xffff0000u)
#pragma unroll
        for (int ai = 0; ai < 2; ++ai) {
            f32x4 bs[4][2][2]; u32x4 bh[4][2];
#pragma unroll
            for (int m = 0; m < 4; ++m) { const size_t off = (size_t)(u.pm * BM + ai * HALF + wr * 64 + m * 16 + fr) * 1024 + col0;
#pragma unroll
                for (int bj = 0; bj < 2; ++bj) {
                    if (BIN) bh[m][bj] = *(const u32x4*)(base_h + off + bj * HALF);
                    else { bs[m][bj][0] = *(const f32x4*)(base + off + bj * HALF); bs[m][bj][1] = *(const f32x4*)(base + off + bj * HALF + 4); } } }
#pragma unroll
            for (int m = 0; m < 4; ++m) { const int row = u.pm * BM + ai * HALF + wr * 64 + m * 16 + fr; const size_t off = (size_t)row * 1024 + col0; float ss = 0.f;
#pragma unroll
                for (int bj = 0; bj < 2; ++bj) { const u32x4 d = dl[ai][m][bj];
                    f32x4 b0, b1;
                    if (BIN) { const u32x4 hh = bh[m][bj]; const f32x2 p0 = un_h2(hh.x), p1 = un_h2(hh.y), p2 = un_h2(hh.z), p3 = un_h2(hh.w); b0 = (f32x4){p0.x, p0.y, p1.x, p1.y}; b1 = (f32x4){p2.x, p2.y, p3.x, p3.y}; }
                    else { b0 = bs[m][bj][0]; b1 = bs[m][bj][1]; }
                    const f32x4 o0 = b0 + (f32x4){BFLO4(d.x), BFHI4(d.x), BFLO4(d.y), BFHI4(d.y)}, o1 = b1 + (f32x4){BFLO4(d.z), BFHI4(d.z), BFLO4(d.w), BFHI4(d.w)};
                    if (BOUT) { u32x4 w; w.x = pk_h2(o0[0], o0[1]); w.y = pk_h2(o0[2], o0[3]); w.z = pk_h2(o1[0], o1[1]); w.w = pk_h2(o1[2], o1[3]); *(u32x4*)(out_h + off + bj * HALF) = w; }
                    else { *(f32x4*)(out + off + bj * HALF) = o0; *(f32x4*)(out + off + bj * HALF + 4) = o1; }
                    if (NEXT) { ss += (o0[0] * o0[0] + o0[1] * o0[1]) + (o0[2] * o0[2] + o0[3] * o0[3]) + (o1[0] * o1[0] + o1[1] * o1[1]) + (o1[2] * o1[2] + o1[3] * o1[3]);
                        const f32x4 h0 = o0 * gm[bj][0], h1 = o1 * gm[bj][1];
                        u32x4 w; w.x = cvt_pk_bf16(h0[0], h0[1]); w.y = cvt_pk_bf16(h0[2], h0[3]); w.z = cvt_pk_bf16(h1[0], h1[1]); w.w = cvt_pk_bf16(h1[2], h1[3]);
                        *(u32x4*)(Hn + off + bj * HALF) = w; } }
                if (NEXT) { ss += __shfl_xor(ss, 16); ss += __shfl_xor(ss, 32); if (fq == 0) __hip_atomic_fetch_add(rowss + row, ss, __ATOMIC_RELAXED, __HIP_MEMORY_SCOPE_AGENT); } }
            asm volatile("" ::: "memory"); }
#undef BFLO4
#undef BFHI4
    }
};
struct EpiSwiGLU2 {
    static constexpr bool PERM = true, AFTER_DRAIN = false;
    bf16_t* O; int ldc; const float* rowss; const float* bias;
    __device__ __forceinline__ void prefetch(PG8_LAS unsigned char* sp, const Unit& u, int wid, int lane) const {
        const int seq = (u.pm < 256) ? (u.pm >> 3) : 32;
        const float* src = (wid < 4) ? rowss + u.pm * BM + wid * 64 : bias + (size_t)seq * 5632 + u.pn * HALF + (wid < 6 ? (wid - 4) * 64 : 2816 + (wid - 6) * 64);
        __builtin_amdgcn_global_load_lds((const unsigned*)(src + lane), (PG8_LAS unsigned*)(sp + wid * 256), 4, 0, 0);
    }
    __device__ __forceinline__ void operator()(const f32x4 (&acc)[2][2][4][2], const Unit& u, int wr, int wc, int fr, int fq, PG8_LAS unsigned char* sp) const {
        const int row0 = u.pm * BM + wr * 64 + fr; const int col0 = u.pn * HALF + wc * 32 + 8 * fq;
        const PG8_LAS float* spf = (const PG8_LAS float*)sp;
        const f32x4 bg0 = *(const PG8_LAS f32x4*)(spf + 256 + wc * 32 + 8 * fq), bg1 = *(const PG8_LAS f32x4*)(spf + 256 + wc * 32 + 8 * fq + 4);
        const f32x4 bu0 = *(const PG8_LAS f32x4*)(spf + 384 + wc * 32 + 8 * fq), bu1 = *(const PG8_LAS f32x4*)(spf + 384 + wc * 32 + 8 * fq + 4);
#pragma unroll
        for (int ai = 0; ai < 2; ++ai)
#pragma unroll
            for (int m = 0; m < 4; ++m) { const int row = row0 + ai * HALF + m * 16; const float rr = __builtin_amdgcn_rsqf(spf[ai * HALF + wr * 64 + m * 16 + fr] * (1.0f / 1024.0f) + EPI_EPS);
                const f32x4 g0 = acc[ai][0][m][0] * rr + bg0, g1 = acc[ai][0][m][1] * rr + bg1, u0 = acc[ai][1][m][0] * rr + bu0, u1 = acc[ai][1][m][1] * rr + bu1;
                u32x4 w; w.x = cvt_pk_bf16(silu_mul(g0[0], u0[0]), silu_mul(g0[1], u0[1])); w.y = cvt_pk_bf16(silu_mul(g0[2], u0[2]), silu_mul(g0[3], u0[3]));
                w.z = cvt_pk_bf16(silu_mul(g1[0], u1[0]), silu_mul(g1[1], u1[1])); w.w = cvt_pk_bf16(silu_mul(g1[2], u1[2]), silu_mul(g1[3], u1[3]));
                *(u32x4*)(O + (size_t)row * ldc + col0) = w; }
    }
};
template <bool PRE, bool ROPE> struct EpiSplit2 {
    static constexpr bool PERM = true, AFTER_DRAIN = false;
    bf16_t* p0; bf16_t* p1; bf16_t* p2; int ld0, ld1, ld2, n0, n1;
    const float* rowss; const float* bias; int N;
    const float* qgain; const float* kgain; float qscale; const float* ropetab; PG8_LAS float* xch;
    __device__ __forceinline__ void prefetch(PG8_LAS unsigned char* sp, const Unit& u, int wid, int lane) const {
        if (PRE) { const int seq = (u.pm < 256) ? (u.pm >> 3) : 32;
            const float* src = (wid < 4) ? rowss + u.pm * BM + wid * 64 : bias + (size_t)seq * N + u.pn * BM + (wid - 4) * 64;
            __builtin_amdgcn_global_load_lds((const unsigned*)(src + lane), (PG8_LAS unsigned*)(sp + wid * 256), 4, 0, 0); }
    }
    __device__ __forceinline__ void operator()(f32x4 (&acc)[2][2][4][2], const Unit& u, int wr, int wc, int fr, int fq, PG8_LAS unsigned char* sp) const {
        bf16_t* base; int ldc, colt;
        if (u.pn < n0) { base = p0; ldc = ld0; colt = u.pn * BM; }
        else if (u.pn < n1) { base = p1; ldc = ld1; colt = (u.pn - n0) * BM; }
        else { base = p2; ldc = ld2; colt = (u.pn - n1) * BM; }
        const bool isv = (u.pn >= n1), isq = (u.pn < n0);
        const int wid = wr * 4 + wc;
        const int row0 = u.pm * BM + wr * 64 + fr; const int col0 = colt + wc * 32 + 8 * fq;
        if (PRE) { const PG8_LAS float* spf = (const PG8_LAS float*)sp; const PG8_LAS float* bp = spf + 256 + wc * 32 + 8 * fq;
            const f32x4 b00 = *(const PG8_LAS f32x4*)(bp), b01 = *(const PG8_LAS f32x4*)(bp + 4), b10 = *(const PG8_LAS f32x4*)(bp + HALF), b11 = *(const PG8_LAS f32x4*)(bp + HALF + 4);
#pragma unroll
            for (int ai = 0; ai < 2; ++ai)
#pragma unroll
                for (int m = 0; m < 4; ++m) { const float rr = __builtin_amdgcn_rsqf(spf[ai * HALF + wr * 64 + m * 16 + fr] * (1.0f / 1024.0f) + EPI_EPS);
                    acc[ai][0][m][0] = acc[ai][0][m][0] * rr + b00; acc[ai][0][m][1] = acc[ai][0][m][1] * rr + b01; acc[ai][1][m][0] = acc[ai][1][m][0] * rr + b10; acc[ai][1][m][1] = acc[ai][1][m][1] * rr + b11; } }
        float part[16];
        if (!isv) {
#pragma unroll
            for (int ai = 0; ai < 2; ++ai)
#pragma unroll
                for (int m = 0; m < 4; ++m)
#pragma unroll
                    for (int bj = 0; bj < 2; ++bj) { const f32x4 a = acc[ai][bj][m][0], b = acc[ai][bj][m][1];
                        float s = (a[0] * a[0] + a[1] * a[1]) + (a[2] * a[2] + a[3] * a[3]) + (b[0] * b[0] + b[1] * b[1]) + (b[2] * b[2] + b[3] * b[3]);
                        s += __shfl_xor(s, 16); s += __shfl_xor(s, 32); const int idx = (ai * 4 + m) * 2 + bj; part[idx] = s;
                        if (fq == 0) xch[wid * 256 + idx * 16 + fr] = s; }
        }
        asm volatile("s_waitcnt lgkmcnt(0)" ::: "memory"); __builtin_amdgcn_s_barrier(); asm volatile("" ::: "memory");
        if (!isv) {
            const float* gp = (isq ? qgain : kgain) + 32 * (wc & 1) + 8 * fq; const float gs = isq ? qscale : 1.0f;
            const f32x4 gl0 = *(const f32x4*)(gp) * gs, gl1 = *(const f32x4*)(gp + 4) * gs;
#pragma unroll
            for (int ai = 0; ai < 2; ++ai)
#pragma unroll
                for (int m = 0; m < 4; ++m) { const int row = row0 + ai * HALF + m * 16;
                    f32x4 cs0 = {1.f, 0.f, 1.f, 0.f}, cs1 = {1.f, 0.f, 1.f, 0.f};
                    if (ROPE) { const int t = (row < 65536) ? (row & 2047) : (row - 65536); const int pos = (wc & 1) ? (t & 63) : (t >> 6);
                        const float* tp = ropetab + (size_t)(pos * 16 + 4 * fq) * 2; cs0 = *(const f32x4*)(tp); cs1 = *(const f32x4*)(tp + 4); }
                    bf16_t* rowp = base + (size_t)row * ldc + col0;
#pragma unroll
                    for (int bj = 0; bj < 2; ++bj) { const int idx = (ai * 4 + m) * 2 + bj;
                        const float tot = part[idx] + xch[(wid ^ 1) * 256 + idx * 16 + fr]; const float rinv = __builtin_amdgcn_rsqf(tot * (1.0f / 64.0f) + EPI_EPS);
                        f32x4 v0 = acc[ai][bj][m][0] * rinv * gl0, v1 = acc[ai][bj][m][1] * rinv * gl1;
                        if (ROPE) { const f32x4 a = v0, b = v1;
                            v0[0] = a[0] * cs0[0] - a[1] * cs0[1]; v0[1] = a[0] * cs0[1] + a[1] * cs0[0]; v0[2] = a[2] * cs0[2] - a[3] * cs0[3]; v0[3] = a[2] * cs0[3] + a[3] * cs0[2];
                            v1[0] = b[0] * cs1[0] - b[1] * cs1[1]; v1[1] = b[0] * cs1[1] + b[1] * cs1[0]; v1[2] = b[2] * cs1[2] - b[3] * cs1[3]; v1[3] = b[2] * cs1[3] + b[3] * cs1[2]; }
                        u32x4 w; w.x = cvt_pk_bf16(v0[0], v0[1]); w.y = cvt_pk_bf16(v0[2], v0[3]); w.z = cvt_pk_bf16(v1[0], v1[1]); w.w = cvt_pk_bf16(v1[2], v1[3]);
                        *(u32x4*)(rowp + bj * HALF) = w; } }
        } else {
#pragma unroll
            for (int ai = 0; ai < 2; ++ai)
#pragma unroll
                for (int m = 0; m < 4; ++m) { bf16_t* rowp = base + (size_t)(row0 + ai * HALF + m * 16) * ldc + col0;
#pragma unroll
                    for (int bj = 0; bj < 2; ++bj) { const f32x4 v0 = acc[ai][bj][m][0], v1 = acc[ai][bj][m][1];
                        u32x4 w; w.x = cvt_pk_bf16(v0[0], v0[1]); w.y = cvt_pk_bf16(v0[2], v0[3]); w.z = cvt_pk_bf16(v1[0], v1[1]); w.w = cvt_pk_bf16(v1[2], v1[3]);
                        *(u32x4*)(rowp + bj * HALF) = w; } }
        }
    }
};
template <class Epi, class Sched, bool ALIGN_EPI = false, bool SP2 = false>
__device__ __forceinline__ void gemm_phase(PG8_LAS unsigned char* lds, const Gemm g, const Sched& S, const Epi& E) {
    int tid_ = threadIdx.x; asm volatile("" : "+v"(tid_));
    const int tid = tid_, wid = __builtin_amdgcn_readfirstlane(tid >> 6), lane = tid & 63, wr = wid >> 2, wc = wid & 3, fr = lane & 15, fq = lane >> 4;
    const int K = g.K, nt = K / BK;
    unsigned voffA[2], voffB[2];
#pragma unroll
    for (int i = 0; i < 2; ++i) { int R, C; stage_rc(tid * 16 + i * 8192, R, C); const int Rb = Epi::PERM ? ((R & ~31) + perm32(R & 31)) : R;
        voffA[i] = (unsigned)(R * K + C) * 2u; voffB[i] = (unsigned)(Rb * K + C) * 2u; }
    const size_t kstep = (size_t)(BK * 2);
    const size_t hstep = (size_t)HALF * K * 2;
    const size_t tstep = 2 * hstep;
    const unsigned ldsw = (unsigned)wid * 1024u;
    const int aoff = lds_byte(wr * 64 + fr, fq * 8), boff = lds_byte(wc * 32 + fr, fq * 8);
#define PG8_SA(b, h) (((b) * 2 + (h)) * HTB)
#define PG8_SB(b, h) ((4 + (b) * 2 + (h)) * HTB)
#define PG8_STAGE(bufoff, gbase, voff) do { _Pragma("unroll") for (int _i = 0; _i < 2; ++_i) \
        __builtin_amdgcn_global_load_lds((const unsigned*)((const char*)(gbase) + (voff)[_i]), (PG8_LAS unsigned*)(lds + (bufoff) + ldsw + _i * 8192), 16, 0, 0); } while (0)
#define PG8_LDA(dst, b, h) do { _Pragma("unroll") for (int m = 0; m < 4; ++m) _Pragma("unroll") for (int k = 0; k < 2; ++k) dst[m][k] = *(const PG8_LAS bf16x8*)(lds + PG8_SA(b, h) + aoff + m * 2048 + k * 1024); } while (0)
#define PG8_LDB(dst, b, h) do { _Pragma("unroll") for (int n = 0; n < 2; ++n) _Pragma("unroll") for (int k = 0; k < 2; ++k) dst[n][k] = *(const PG8_LAS bf16x8*)(lds + PG8_SB(b, h) + boff + n * 2048 + k * 1024); } while (0)
#define PG8_MMA(ai, bj, At, Bt) do { __builtin_amdgcn_s_setprio(1); _Pragma("unroll") for (int m = 0; m < 4; ++m) _Pragma("unroll") for (int n = 0; n < 2; ++n) _Pragma("unroll") for (int k = 0; k < 2; ++k) \
        acc[ai][bj][m][n] = __builtin_amdgcn_mfma_f32_16x16x32_bf16(Bt[n][k], At[m][k], acc[ai][bj][m][n], 0, 0, 0); __builtin_amdgcn_s_setprio(0); } while (0)
#define PG8_WAIT_V(n) asm volatile("s_waitcnt vmcnt(" #n ")" ::: "memory")
#define PG8_WAIT_L(n) asm volatile("s_waitcnt lgkmcnt(" #n ")" ::: "memory")
#define PG8_BAR __builtin_amdgcn_s_barrier()
#define PG8_SCHED __builtin_amdgcn_sched_barrier(0)
    Unit cur, nxt; int ui = 0;
    if (!S.next(0, cur)) return;
    f32x4 acc[2][2][4][2];
#pragma unroll
    for (int a = 0; a < 2; ++a)
#pragma unroll
        for (int b = 0; b < 2; ++b)
#pragma unroll
            for (int m = 0; m < 4; ++m)
#pragma unroll
                for (int n = 0; n < 2; ++n) acc[a][b][m][n] = (f32x4){0.f, 0.f, 0.f, 0.f};
    bf16x8 At[4][2], B0[2][2], B1[2][2];
    const char* cA = (const char*)g.A + (size_t)cur.pm * tstep; const char* cB = (const char*)g.Bt + (size_t)cur.pn * tstep;
    S.a_ready(cur);
    if constexpr (SP2) {
        PG8_STAGE(PG8_SB(0, 0), cB, voffB); PG8_STAGE(PG8_SB(0, 1), cB + hstep, voffB); PG8_STAGE(PG8_SA(0, 0), cA, voffA); PG8_STAGE(PG8_SA(0, 1), cA + hstep, voffA);
        if (wr == 1) PG8_BAR;
        PG8_WAIT_V(2); PG8_BAR;
        PG8_STAGE(PG8_SB(1, 0), cB + kstep, voffB); PG8_STAGE(PG8_SA(1, 0), cA + kstep, voffA); PG8_STAGE(PG8_SB(1, 1), cB + hstep + kstep, voffB);
        PG8_WAIT_V(6); PG8_BAR;
    } else {
        PG8_STAGE(PG8_SB(0, 0), cB, voffB); PG8_STAGE(PG8_SA(0, 0), cA, voffA); PG8_STAGE(PG8_SB(0, 1), cB + hstep, voffB); PG8_STAGE(PG8_SA(0, 1), cA + hstep, voffA);
        if (wr == 1) PG8_BAR;
        PG8_WAIT_V(4); PG8_BAR;
        PG8_STAGE(PG8_SB(1, 0), cB + kstep, voffB); PG8_STAGE(PG8_SA(1, 0), cA + kstep, voffA); PG8_STAGE(PG8_SB(1, 1), cB + hstep + kstep, voffB);
        PG8_WAIT_V(6); PG8_BAR;
    }
    for (;;) {
        const bool has_next = S.next(ui + 1, nxt);
        const char* nA = has_next ? (const char*)g.A + (size_t)nxt.pm * tstep : cA; const char* nB = has_next ? (const char*)g.Bt + (size_t)nxt.pn * tstep : cB;
        for (int t = 0; t < nt; t += 2) {
            const bool last = (t == nt - 2);
            const char* a1 = cA + (size_t)(t + 1) * kstep;
            const char* a2 = last ? nA : cA + (size_t)(t + 2) * kstep; const char* b2 = last ? nB : cB + (size_t)(t + 2) * kstep;
            const char* a3 = a2 + kstep; const char* b3 = b2 + kstep;
            if (last && has_next) S.a_ready(nxt);
            if (last) E.prefetch(lds + 139264, cur, wid, lane);
            if constexpr (SP2) {
            PG8_LDB(B0, 0, 0); PG8_LDB(B1, 0, 1); PG8_SCHED; PG8_LDA(At, 0, 0); PG8_STAGE(PG8_SA(1, 1), a1 + hstep, voffA);
            PG8_WAIT_V(8); PG8_WAIT_L(0); PG8_BAR; PG8_MMA(0, 0, At, B0); PG8_MMA(0, 1, At, B1); PG8_BAR; PG8_SCHED;
            PG8_LDA(At, 0, 1); PG8_STAGE(PG8_SB(0, 0), b2, voffB); PG8_STAGE(PG8_SB(0, 1), b2 + hstep, voffB); PG8_STAGE(PG8_SA(0, 0), a2, voffA);
            PG8_WAIT_V(8); PG8_WAIT_L(0); PG8_BAR; PG8_MMA(1, 0, At, B0); PG8_MMA(1, 1, At, B1); PG8_BAR; PG8_SCHED;
            PG8_LDB(B0, 1, 0); PG8_LDB(B1, 1, 1); PG8_SCHED; PG8_LDA(At, 1, 0); PG8_STAGE(PG8_SA(0, 1), a2 + hstep, voffA);
            PG8_WAIT_V(8); PG8_WAIT_L(0); PG8_BAR; PG8_MMA(0, 0, At, B0); PG8_MMA(0, 1, At, B1); PG8_BAR; PG8_SCHED;
            PG8_LDA(At, 1, 1); PG8_STAGE(PG8_SB(1, 0), b3, voffB); PG8_STAGE(PG8_SB(1, 1), b3 + hstep, voffB); PG8_STAGE(PG8_SA(1, 0), a3, voffA);
            PG8_WAIT_V(8); PG8_WAIT_L(0); PG8_BAR; PG8_MMA(1, 0, At, B0); PG8_MMA(1, 1, At, B1); PG8_BAR; PG8_SCHED;
            } else {
            PG8_LDB(B0, 0, 0); PG8_SCHED; PG8_LDA(At, 0, 0); PG8_STAGE(PG8_SA(1, 1), a1 + hstep, voffA);
            PG8_WAIT_L(8); PG8_BAR; PG8_WAIT_L(0); PG8_MMA(0, 0, At, B0); PG8_BAR; PG8_SCHED;
            PG8_LDB(B1, 0, 1); PG8_STAGE(PG8_SB(0, 0), b2, voffB);
            PG8_BAR; PG8_WAIT_L(0); PG8_MMA(0, 1, At, B1); PG8_BAR;
            PG8_LDA(At, 0, 1); PG8_STAGE(PG8_SA(0, 0), a2, voffA);
            PG8_BAR; PG8_WAIT_L(0); PG8_MMA(1, 0, At, B0); PG8_BAR; PG8_SCHED;
            PG8_STAGE(PG8_SB(0, 1), b2 + hstep, voffB);
            PG8_WAIT_V(6); PG8_BAR; PG8_MMA(1, 1, At, B1); PG8_BAR;
            PG8_LDB(B0, 1, 0); PG8_SCHED; PG8_LDA(At, 1, 0); PG8_STAGE(PG8_SA(0, 1), a2 + hstep, voffA);
            PG8_WAIT_L(8); PG8_BAR; PG8_WAIT_L(0); PG8_MMA(0, 0, At, B0); PG8_BAR; PG8_SCHED;
            PG8_LDB(B1, 1, 1); PG8_STAGE(PG8_SB(1, 0), b3, voffB);
            PG8_BAR; PG8_WAIT_L(0); PG8_MMA(0, 1, At, B1); PG8_BAR;
            PG8_LDA(At, 1, 1); PG8_STAGE(PG8_SA(1, 0), a3, voffA);
            PG8_BAR; PG8_WAIT_L(0); PG8_MMA(1, 0, At, B0); PG8_BAR; PG8_SCHED;
            PG8_STAGE(PG8_SB(1, 1), b3 + hstep, voffB);
            PG8_WAIT_V(6); PG8_BAR; PG8_MMA(1, 1, At, B1); PG8_BAR;
            }
        }
        if constexpr (ALIGN_EPI) { if (wr == 0) PG8_BAR; }
        if constexpr (!Epi::AFTER_DRAIN) { E(acc, cur, wr, wc, fr, fq, lds + 139264); S.done(cur); }
        if (!has_next) break;
#pragma unroll
        for (int a = 0; a < 2; ++a)
#pragma unroll
            for (int b = 0; b < 2; ++b)
#pragma unroll
                for (int m = 0; m < 4; ++m)
#pragma unroll
                    for (int n = 0; n < 2; ++n) acc[a][b][m][n] = (f32x4){0.f, 0.f, 0.f, 0.f};
        cur = nxt; cA = nA; cB = nB; ++ui;
        if constexpr (ALIGN_EPI) { if (wr == 1) PG8_BAR; }
    }
    PG8_WAIT_V(0);
    if constexpr (!ALIGN_EPI) { if (wr == 0) PG8_BAR; }
    PG8_BAR;
    if constexpr (Epi::AFTER_DRAIN) { E.fused(acc, cur, wr, wc, fr, fq, lds, wid, lane); S.done(cur); }
#undef PG8_SA
#undef PG8_SB
#undef PG8_STAGE
#undef PG8_LDA
#undef PG8_LDB
#undef PG8_MMA
#undef PG8_WAIT_V
#undef PG8_WAIT_L
#undef PG8_BAR
#undef PG8_SCHED
}
}
#ifndef PG8_SP2
#define PG8_SP2 true
#endif
#ifndef PG8_ALIGN
#define PG8_ALIGN true
#endif
#include <hip/hip_bf16.h>
#include <cmath>
namespace attn_body {
using bf16=__hip_bfloat16;
using bf16x8=__attribute__((ext_vector_type(8)))short;
using s16x4=__attribute__((ext_vector_type(4)))short;
using f32x16=__attribute__((ext_vector_type(16)))float;
using u32x4=__attribute__((ext_vector_type(4)))unsigned;
constexpr int D=64;
constexpr int NW=8,QBLK=32,QB=QBLK*NW,KVBLK=64;
constexpr int ATTN_UNIT_ROWS=QB;
__device__ __forceinline__ int crow(int r,int hi){return (r&3)+8*(r>>2)+4*hi;}
#define SBAR() __builtin_amdgcn_sched_barrier(0)
constexpr int NSLOT=3, SLOTB=8192;
constexpr int LDS_K=0, LDS_V=NSLOT*SLOTB, LDS_WS=2*NSLOT*SLOTB, LDS_OST=LDS_WS+NW*64*4, LDS_BT=LDS_OST+NW*4096, LDS_BYTES=LDS_BT+768*4;
constexpr float C2=0.125f*1.4426950408889634f;
__device__ __forceinline__ void glds16(const void*gsrc,unsigned lds_dst){unsigned keep;
  asm volatile("s_mov_b32 %0, m0\n\ts_mov_b32 m0, %2\n\ts_nop 0\n\tglobal_load_lds_dwordx4 %1, off\n\ts_mov_b32 m0, %0":"=&s"(keep):"v"(gsrc),"s"(lds_dst):"memory");}
__device__ __forceinline__ void glds16s(const void*sbase,unsigned voff,unsigned lds_dst){unsigned keep;
  asm volatile("s_mov_b32 %0, m0\n\ts_mov_b32 m0, %3\n\ts_nop 0\n\tglobal_load_lds_dwordx4 %1, %2\n\ts_mov_b32 m0, %0":"=&s"(keep):"v"(voff),"s"(sbase),"s"(lds_dst):"memory");}
__device__ __forceinline__ float max3f(float a,float b,float c){float r;asm("v_max3_f32 %0, %1, %2, %3":"=v"(r):"v"(a),"v"(b),"v"(c));return r;}
__device__ __forceinline__ float max2f(float a,float b){float r;asm("v_max_f32_e32 %0, %1, %2":"=v"(r):"v"(a),"v"(b));return r;}
__device__ __forceinline__ float fadd_s(float a,float b){float r;asm("v_add_f32_e32 %0, %1, %2":"=v"(r):"v"(a),"v"(b));return r;}
__device__ __forceinline__ float fsub_s(float a,float b){float r;asm("v_sub_f32_e32 %0, %1, %2":"=v"(r):"v"(a),"v"(b));return r;}
typedef float f32x2_t __attribute__((ext_vector_type(2))); typedef __bf16 bf16x2_t __attribute__((ext_vector_type(2)));
__device__ __forceinline__ unsigned cvtpk_s(float lo,float hi){f32x2_t v={lo,hi};bf16x2_t b=__builtin_convertvector(v,bf16x2_t);return __builtin_bit_cast(unsigned,b);}
#define WAIT_BAR(N) asm volatile("s_waitcnt vmcnt(" #N ") lgkmcnt(0)\n\ts_barrier":::"memory")

__device__ __forceinline__ void qkt(f32x16&p0,f32x16&p1,const char*Kslot,const bf16x8*qr,const f32x16&negm,int r32,int hi){
  const char*kb=Kslot+hi*1024+r32*16;
  #pragma unroll
  for(int d0=0;d0<4;++d0){
    const bf16x8 b0=*reinterpret_cast<const bf16x8*>(kb+d0*2048);
    const bf16x8 b1=*reinterpret_cast<const bf16x8*>(kb+d0*2048+512);
    if(d0==0){p0=__builtin_amdgcn_mfma_f32_32x32x16_bf16(b0,qr[0],negm,0,0,0);p1=__builtin_amdgcn_mfma_f32_32x32x16_bf16(b1,qr[0],negm,0,0,0);}
    else{p0=__builtin_amdgcn_mfma_f32_32x32x16_bf16(b0,qr[d0],p0,0,0,0);p1=__builtin_amdgcn_mfma_f32_32x32x16_bf16(b1,qr[d0],p1,0,0,0);}}
}
typedef __attribute__((address_space(3))) const char* lds_cptr;
typedef short v4i16_t __attribute__((ext_vector_type(4)));
__device__ __forceinline__ void kload8(bf16x8*kf,lds_cptr kp){
  kf[0]=*(const __attribute__((address_space(3))) bf16x8*)(kp);      kf[1]=*(const __attribute__((address_space(3))) bf16x8*)(kp+512);
  kf[2]=*(const __attribute__((address_space(3))) bf16x8*)(kp+2048); kf[3]=*(const __attribute__((address_space(3))) bf16x8*)(kp+2560);
  kf[4]=*(const __attribute__((address_space(3))) bf16x8*)(kp+4096); kf[5]=*(const __attribute__((address_space(3))) bf16x8*)(kp+4608);
  kf[6]=*(const __attribute__((address_space(3))) bf16x8*)(kp+6144); kf[7]=*(const __attribute__((address_space(3))) bf16x8*)(kp+6656);
}
__device__ __forceinline__ void kload2(bf16x8*kf,lds_cptr kp,int j){ kf[2*j]=*(const __attribute__((address_space(3))) bf16x8*)(kp+j*2048); kf[2*j+1]=*(const __attribute__((address_space(3))) bf16x8*)(kp+j*2048+512); }
__device__ __forceinline__ s16x4 vtr(lds_cptr p){ return __builtin_bit_cast(s16x4,__builtin_amdgcn_ds_read_tr16_b64_v4i16((__attribute__((address_space(3))) v4i16_t*)p)); }
__device__ __forceinline__ float rowmax(const f32x16&p0,const f32x16&p1){
  float a=max3f(p0[0],p0[1],p1[0]),b=max3f(p0[2],p0[3],p1[1]);a=max3f(a,p1[2],p1[3]);
  #pragma unroll
  for(int r=4;r<16;r+=4){a=max3f(a,p0[r],p0[r+1]);b=max3f(b,p0[r+2],p0[r+3]);a=max3f(a,p1[r],p1[r+1]);b=max3f(b,p1[r+2],p1[r+3]);}
  const float m=max2f(a,b);
  auto rr=__builtin_amdgcn_permlane32_swap(__float_as_uint(m),__float_as_uint(m),false,false);
  return max2f(__uint_as_float(rr[0]),__uint_as_float(rr[1]));
}
__device__ __forceinline__ void pv(f32x16*o,int vb,bf16x8 pa0,bf16x8 pa1,bf16x8 pa2,bf16x8 pa3){
  #pragma unroll
  for(int d0=0;d0<2;++d0){s16x4 lo[4],hi[4];
    #pragma unroll
    for(int ks=0;ks<4;++ks){
      asm volatile("ds_read_b64_tr_b16 %0,%1 offset:%c2":"=&v"(lo[ks]):"v"(vb),"i"(d0*4096+ks*1024):"memory");
      asm volatile("ds_read_b64_tr_b16 %0,%1 offset:%c2":"=&v"(hi[ks]):"v"(vb),"i"(d0*4096+ks*1024+512):"memory");}
    asm volatile("s_waitcnt lgkmcnt(0)":::"memory");SBAR();
    #define PK(k) (bf16x8){lo[k][0],lo[k][1],lo[k][2],lo[k][3],hi[k][0],hi[k][1],hi[k][2],hi[k][3]}
    o[d0]=__builtin_amdgcn_mfma_f32_32x32x16_bf16(pa0,PK(0),o[d0],0,0,0);
    o[d0]=__builtin_amdgcn_mfma_f32_32x32x16_bf16(pa1,PK(1),o[d0],0,0,0);
    o[d0]=__builtin_amdgcn_mfma_f32_32x32x16_bf16(pa2,PK(2),o[d0],0,0,0);
    o[d0]=__builtin_amdgcn_mfma_f32_32x32x16_bf16(pa3,PK(3),o[d0],0,0,0);
    #undef PK
  }
}

#ifndef ATTN_STORE16
#define ATTN_STORE16(p,v) (*(u32x4*)(p)=(v))
#endif
template<int VH> struct AttnLds { static constexpr int KSL=8192, VSL=8192*VH, L_K=0, L_V=4*KSL, L_WS=L_V+3*VSL, L_BT=L_WS+NW*64*4, BYTES=L_BT+768*4; };
template<int VH,bool HAS_BIAS,int MODE> __device__ __forceinline__ void attn_unit2(const bf16*Qb,int qp,const bf16*__restrict__ Kb,int kp,const bf16*__restrict__ Vb,int vp,bf16*Ob,int op,int q0,int NT,const float*relb,char*shm,float lam,const float*subg,float gmul){
  typedef AttnLds<VH> LM; constexpr int KSL=LM::KSL, VSL=LM::VSL;
  int tid_=threadIdx.x; asm volatile("":"+v"(tid_));
  const int tid=tid_,lane=tid&63,r32=lane&31,hi=lane>>5; const int wid=__builtin_amdgcn_readfirstlane(tid>>6);
  const bf16*Qw=Qb+(long)(q0+wid*QBLK)*qp;
  const unsigned lds0=(unsigned)(uintptr_t)shm;
  const lds_cptr shm3=(lds_cptr)shm;
  float*wsf=(float*)(shm+LM::L_WS)+wid*64;
  const unsigned ksrc=(unsigned)(lane*kp+wid*8)*2u;
  const unsigned vsrc=(unsigned)((16*(wid&3)+(lane>>2))*vp+(wid>>2)*32+(lane&3)*8)*2u;
  const unsigned kdst=lds0+LM::L_K+wid*1024, vdst=lds0+LM::L_V+wid*1024;
  #define DMA_K(t,slot) glds16s(Kb+(long)(t)*KVBLK*kp,ksrc,(unsigned)__builtin_amdgcn_readfirstlane(kdst+(slot)))
  #define DMA_V(t,slot) do{ glds16s(Vb+(long)(t)*KVBLK*vp,vsrc,(unsigned)__builtin_amdgcn_readfirstlane(vdst+(slot))); \
      if(VH==2) glds16s(Vb+(long)(t)*KVBLK*vp+64,vsrc,(unsigned)__builtin_amdgcn_readfirstlane(vdst+(slot)+8192)); }while(0)
  const int vb0=(int)(lds0+LM::L_V)+((lane>>4)&1)*32+(lane&3)*8+(4*hi+((lane&15)>>2))*64;
  const lds_cptr kp0=shm3+LM::L_K+hi*1024+r32*16;
  const lds_cptr vp0=shm3+LM::L_V+((lane>>4)&1)*32+(lane&3)*8+(4*hi+((lane&15)>>2))*64;
  const int qw_=q0+32*wid; const int tn0=HAS_BIAS?(qw_>=90?((qw_-90)>>6):0):0, tn1=HAS_BIAS?(((qw_+185)>>6)<NT?((qw_+185)>>6):NT):0;
  float cb=0.f,ca=0.f;
  typedef __attribute__((address_space(3))) float lds_f32;
  typedef __attribute__((address_space(3))) char* lds_ptr_;
  lds_f32* btab=(lds_f32*)((lds_ptr_)shm)+LM::L_BT/4;
  if(HAS_BIAS){ const float L2E=1.4426950408889634f; cb=L2E*relb[15*8]; ca=L2E*relb[31*8];
    for(int i=tid;i<768;i+=512){ const int rel=i-384; const int n=rel<0?-rel:rel; int bk=n<8?n:(8+(31-__builtin_clz((unsigned)(n*n)))-6); if(n>=8&&bk>15)bk=15; if(rel>0)bk+=16; btab[i]=L2E*relb[bk*8]; } }
  const int lanebias=-q0-32*wid-r32+4*hi+384;
  #define CREG(tt) (HAS_BIAS?(((tt)<tn0)?cb:(((tt)<tn1)?0.f:ca)):0.f)
  #define BIASADD(P0,P1,t) do{ if(HAS_BIAS&&(t)>=tn0&&(t)<tn1){ const lds_f32*bp_=btab+(64*(t)+lanebias); \
    _Pragma("unroll") for(int r=0;r<16;++r){ P0[r]+=bp_[(r&3)+8*(r>>2)]; P1[r]+=bp_[(r&3)+8*(r>>2)+32]; } } }while(0)
  #define RSCALE(t) do{ if(HAS_BIAS&&((t)==tn0||(t)==tn1)){ const float f_=__builtin_amdgcn_exp2f(CREG((t)-1)-CREG(t)); l_reg*=f_; \
    _Pragma("unroll") for(int d_=0;d_<2*VH;++d_) _Pragma("unroll") for(int r=0;r<16;++r)o[d_][r]*=f_; } }while(0)
  DMA_K(0,0);DMA_V(0,0);DMA_K(1,KSL);
  bf16x8 qr[4];
  #pragma unroll
  for(int d0=0;d0<4;++d0)qr[d0]=*reinterpret_cast<const bf16x8*>(&Qw[(long)r32*qp+d0*16+hi*8]);
  DMA_K(2,2*KSL);
  float l_reg=0.f;f32x16 o[2*VH];
  #pragma unroll
  for(int d_=0;d_<2*VH;++d_)o[d_]=f32x16{};
  const f32x16 zero16=f32x16{};
  f32x16 pA0,pA1,pB0,pB1; bf16x8 kf[4];
  int sv_prev=0,sv_cur=0,sv_next=VSL;
  #define ROT() do{sv_prev=sv_cur;sv_cur=sv_next;sv_next=(sv_next==2*VSL)?0:sv_next+VSL;}while(0)
  #define KLD(p) (*(const __attribute__((address_space(3))) bf16x8*)(p))
  #define KPRE(tn) do{ const lds_cptr kn_=kp0+(((tn)&3)*KSL); kf[0]=KLD(kn_); kf[1]=KLD(kn_+512); kf[2]=KLD(kn_+2048); kf[3]=KLD(kn_+2560); }while(0)
  if(VH==1){WAIT_BAR(3);}else{WAIT_BAR(4);}
  qkt(pA0,pA1,shm+LM::L_K,qr,zero16,r32,hi);
  BIASADD(pA0,pA1,0);
  _Pragma("unroll") for(int r=0;r<16;++r){pA0[r]=__builtin_amdgcn_exp2f(pA0[r]);pA1[r]=__builtin_amdgcn_exp2f(pA1[r]);}
  WAIT_BAR(0);
  DMA_K(3,3*KSL);DMA_V(1,VSL);
  ROT();
  KPRE(1);
  s16x4 vlo[8],vhi[8]; u32x4 pw0,pw1,pw2,pw3;
  #define PKW(P,B) cvtpk_s(P[B],P[B+1])
  #define PAF(k) __builtin_bit_cast(bf16x8,pw##k)
  #define VFR(i) (bf16x8){vlo[i][0],vlo[i][1],vlo[i][2],vlo[i][3],vhi[i][0],vhi[i][1],vhi[i][2],vhi[i][3]}
  #define PIN(x) asm volatile("":"+v"(x))
  #define MF(a,b,c) __builtin_amdgcn_mfma_f32_32x32x16_bf16(a,b,c,0,0,0)
  #define GAPA(MFX,A0,A1,A2,A3,W0,W1,PW) do{ MFX; sacc+=A0; sacc+=A1; sacc+=A2; sacc+=A3; PIN(sacc); W0; W1; PIN(PW); SBAR(); }while(0)
  #define EX(v) __builtin_amdgcn_exp2f(v)
  #define GAPB4(MFX,X,B) do{ MFX; X[B]=EX(X[B]); X[B+1]=EX(X[B+1]); X[B+2]=EX(X[B+2]); X[B+3]=EX(X[B+3]); PIN(X); SBAR(); }while(0)
  #define GAPB2(MFX,X,B) do{ MFX; X[B]=EX(X[B]); X[B+1]=EX(X[B+1]); PIN(X); SBAR(); }while(0)
  #define VRD(i,hv) do{ vlo[i]=vtr(vp_+((hv)*8192+((i)>>2)*4096+((i)&3)*1024)); vhi[i]=vtr(vp_+((hv)*8192+((i)>>2)*4096+((i)&3)*1024+512)); }while(0)
  #define STEP(C0,C1,P0,P1,t,GK,GV,GL) do{ SBAR(); \
    const lds_cptr vp_=vp0+sv_prev; const lds_cptr kq_=kp0+(((t)&3)*KSL); \
    VRD(0,0); SBAR(); float sacc=(P0[0]+P0[1]); \
    GAPA(C0=MF(kf[0],qr[0],zero16), P0[2],P0[3],P0[4],P0[5],     pw0[0]=PKW(P0,0), pw0[1]=PKW(P0,2), pw0); \
    VRD(4,0); SBAR(); GAPA(C1=MF(kf[1],qr[0],zero16), P0[6],P0[7],P0[8],P0[9],     pw0[2]=PKW(P0,4), pw0[3]=PKW(P0,6), pw0); \
    kf[0]=KLD(kq_+4096); kf[1]=KLD(kq_+4608); SBAR(); \
    VRD(1,0); SBAR(); GAPA(C0=MF(kf[2],qr[1],C0),   P0[10],P0[11],P0[12],P0[13], pw1[0]=PKW(P0,8), pw1[1]=PKW(P0,10), pw1); \
    VRD(5,0); SBAR(); GAPA(C1=MF(kf[3],qr[1],C1),   P0[14],P0[15],P1[0],P1[1],   pw1[2]=PKW(P0,12),pw1[3]=PKW(P0,14), pw1); \
    kf[2]=KLD(kq_+6144); kf[3]=KLD(kq_+6656); SBAR(); \
    VRD(2,0); SBAR(); GAPA(C0=MF(kf[0],qr[2],C0),   P1[2],P1[3],P1[4],P1[5],     pw2[0]=PKW(P1,0), pw2[1]=PKW(P1,2), pw2); \
    VRD(6,0); SBAR(); GAPA(C1=MF(kf[1],qr[2],C1),   P1[6],P1[7],P1[8],P1[9],     pw2[2]=PKW(P1,4), pw2[3]=PKW(P1,6), pw2); \
    VRD(3,0); SBAR(); GAPA(C0=MF(kf[2],qr[3],C0),   P1[10],P1[11],P1[12],P1[13], pw3[0]=PKW(P1,8), pw3[1]=PKW(P1,10), pw3); \
    VRD(7,0); SBAR(); GAPA(C1=MF(kf[3],qr[3],C1),   P1[14],P1[15],0.f,0.f,       pw3[2]=PKW(P1,12),pw3[3]=PKW(P1,14), pw3); \
    l_reg+=sacc; \
    if(GK){DMA_K((t)+3,(((t)+3)&3)*KSL);} if(GV){DMA_V((t)+1,sv_next);} \
    BIASADD(C0,C1,t); SBAR(); \
    if(VH==1){ \
      GAPB4(o[0]=MF(PAF(0),VFR(0),o[0]), C0,0); \
      GAPB4(o[1]=MF(PAF(0),VFR(4),o[1]), C0,4); \
      GAPB4(o[0]=MF(PAF(1),VFR(1),o[0]), C0,8); \
      GAPB4(o[1]=MF(PAF(1),VFR(5),o[1]), C0,12); \
      if(GL){ KPRE((t)+1); SBAR(); } \
      GAPB4(o[0]=MF(PAF(2),VFR(2),o[0]), C1,0); \
      GAPB4(o[1]=MF(PAF(2),VFR(6),o[1]), C1,4); \
      GAPB4(o[0]=MF(PAF(3),VFR(3),o[0]), C1,8); \
      GAPB4(o[1]=MF(PAF(3),VFR(7),o[1]), C1,12); \
    } else { \
      GAPB2(o[0]=MF(PAF(0),VFR(0),o[0]), C0,0);  VRD(0,1); SBAR(); \
      GAPB2(o[1]=MF(PAF(0),VFR(4),o[1]), C0,2);  VRD(4,1); SBAR(); \
      GAPB2(o[0]=MF(PAF(1),VFR(1),o[0]), C0,4);  VRD(1,1); SBAR(); \
      GAPB2(o[1]=MF(PAF(1),VFR(5),o[1]), C0,6);  VRD(5,1); SBAR(); \
      GAPB2(o[0]=MF(PAF(2),VFR(2),o[0]), C0,8);  VRD(2,1); SBAR(); \
      GAPB2(o[1]=MF(PAF(2),VFR(6),o[1]), C0,10); VRD(6,1); SBAR(); \
      GAPB2(o[0]=MF(PAF(3),VFR(3),o[0]), C0,12); VRD(3,1); SBAR(); \
      GAPB2(o[1]=MF(PAF(3),VFR(7),o[1]), C0,14); VRD(7,1); SBAR(); \
      if(GL){ KPRE((t)+1); SBAR(); } \
      GAPB2(o[2*(VH-1)]=MF(PAF(0),VFR(0),o[2*(VH-1)]), C1,0); \
      GAPB2(o[2*(VH-1)+1]=MF(PAF(0),VFR(4),o[2*(VH-1)+1]), C1,2); \
      GAPB2(o[2*(VH-1)]=MF(PAF(1),VFR(1),o[2*(VH-1)]), C1,4); \
      GAPB2(o[2*(VH-1)+1]=MF(PAF(1),VFR(5),o[2*(VH-1)+1]), C1,6); \
      GAPB2(o[2*(VH-1)]=MF(PAF(2),VFR(2),o[2*(VH-1)]), C1,8); \
      GAPB2(o[2*(VH-1)+1]=MF(PAF(2),VFR(6),o[2*(VH-1)+1]), C1,10); \
      GAPB2(o[2*(VH-1)]=MF(PAF(3),VFR(3),o[2*(VH-1)]), C1,12); \
      GAPB2(o[2*(VH-1)+1]=MF(PAF(3),VFR(7),o[2*(VH-1)+1]), C1,14); \
    } \
    }while(0)
  #define WAITFULL() do{ if(VH==1){WAIT_BAR(2);}else{WAIT_BAR(3);} }while(0)
  #define ENDW(tt) do{ if((tt)+3<NT){WAITFULL();} else if((tt)+2<NT){ if(VH==1){WAIT_BAR(1);}else{WAIT_BAR(2);} } else {WAIT_BAR(0);} }while(0)
  int t=1;
  for(;t+5<NT;t+=2){
    STEP(pB0,pB1,pA0,pA1,t,true,true,true);     WAITFULL(); RSCALE(t);   ROT();
    STEP(pA0,pA1,pB0,pB1,t+1,true,true,true);   WAITFULL(); RSCALE(t+1); ROT();
  }
  for(;t+1<NT;t+=2){
    STEP(pB0,pB1,pA0,pA1,t,(t+3<NT),(t+1<NT),(t+1<NT));       ENDW(t);   RSCALE(t);   ROT();
    STEP(pA0,pA1,pB0,pB1,t+1,(t+4<NT),(t+2<NT),(t+2<NT));     ENDW(t+1); RSCALE(t+1); ROT();
  }
  STEP(pB0,pB1,pA0,pA1,NT-1,false,false,false); RSCALE(NT-1);
  { float sacc=pB0[0]+pB0[1]; _Pragma("unroll") for(int r=2;r<16;++r)sacc+=pB0[r]; _Pragma("unroll") for(int r=0;r<16;++r)sacc+=pB1[r]; l_reg+=sacc;
    pw0=(u32x4){PKW(pB0,0),PKW(pB0,2),PKW(pB0,4),PKW(pB0,6)};pw1=(u32x4){PKW(pB0,8),PKW(pB0,10),PKW(pB0,12),PKW(pB0,14)};pw2=(u32x4){PKW(pB1,0),PKW(pB1,2),PKW(pB1,4),PKW(pB1,6)};pw3=(u32x4){PKW(pB1,8),PKW(pB1,10),PKW(pB1,12),PKW(pB1,14)};
    SBAR(); pv(o,vb0+sv_cur,PAF(0),PAF(1),PAF(2),PAF(3)); if(VH==2){ SBAR(); pv(o+2*(VH-1),vb0+sv_cur+8192,PAF(0),PAF(1),PAF(2),PAF(3)); } }
  #undef PKW
  #undef PAF
  #undef VFR
  #undef PIN
  #undef MF
  #undef GAPA
  #undef GAPB4
  #undef GAPB2
  #undef EX
  #undef VRD
  #undef STEP
  #undef ENDW
  #undef WAITFULL
  #undef KLD
  #undef KPRE
  {auto rr=__builtin_amdgcn_permlane32_swap(__float_as_uint(l_reg),__float_as_uint(l_reg),false,false);l_reg=__uint_as_float(rr[0])+__uint_as_float(rr[1]);}
  if(hi==0)wsf[32+r32]=l_reg;
  asm volatile("s_waitcnt lgkmcnt(0)\n\ts_barrier":::"memory");
  float rli[16];
  #pragma unroll
  for(int r=0;r<16;++r)rli[r]=__builtin_amdgcn_rcpf(wsf[32+crow(r,hi)]);
  bf16*Ow=Ob+(long)(q0+wid*QBLK)*op;
  typedef __attribute__((address_space(3))) unsigned lds_u32;
  lds_u32* park=(lds_u32*)((lds_ptr_)shm+LM::BYTES)+tid;
  if(MODE==1){
    #pragma unroll
    for(int d0=0;d0<2*VH;++d0)
      #pragma unroll
      for(int r=0;r<16;r+=2)park[(d0*8+(r>>1))*512]=cvtpk_s(o[d0][r]*rli[r],o[d0][r+1]*rli[r+1]);
  } else {
    if(MODE==2){
      #pragma unroll
      for(int d0=0;d0<2*VH;++d0)
        #pragma unroll
        for(int r=0;r<16;r+=2){ const unsigned w_=park[(d0*8+(r>>1))*512];
          o[d0][r]=__uint_as_float(w_<<16)-lam*(o[d0][r]*rli[r]); o[d0][r+1]=__uint_as_float(w_&0xffff0000u)-lam*(o[d0][r+1]*rli[r+1]); }
      float gsub[2*VH];
      #pragma unroll
      for(int d0=0;d0<2*VH;++d0)gsub[d0]=subg[d0*32+r32]*gmul;
      #pragma unroll
      for(int r=0;r<16;++r){ float ss=0.f;
        #pragma unroll
        for(int d0=0;d0<2*VH;++d0)ss+=o[d0][r]*o[d0][r];
        ss+=__shfl_xor(ss,1);ss+=__shfl_xor(ss,2);ss+=__shfl_xor(ss,4);ss+=__shfl_xor(ss,8);ss+=__shfl_xor(ss,16);
        const float rs=__builtin_amdgcn_rsqf(ss*(1.0f/(64.f*VH))+1e-6f);
        #pragma unroll
        for(int d0=0;d0<2*VH;++d0)o[d0][r]=o[d0][r]*rs*gsub[d0];
        rli[r]=1.0f; }
    }
    { bf16*stg=(bf16*)(shm)+wid*(2048*VH);
      #pragma unroll
      for(int r=0;r<16;++r){const int orow=crow(r,hi);
        #pragma unroll
        for(int d0=0;d0<2*VH;++d0)stg[orow*(64*VH)+d0*32+r32]=__float2bfloat16(o[d0][r]*rli[r]);}
      asm volatile("s_waitcnt lgkmcnt(0)":::"memory");
      #pragma unroll
      for(int i=0;i<4*VH;++i){const int row=(VH==1)?(i*8+(lane>>3)):(i*4+(lane>>4)),ch=(VH==1)?(lane&7):(lane&15); const u32x4 v=*(const u32x4*)(stg+row*(64*VH)+ch*8); ATTN_STORE16(Ow+(long)row*op+ch*8,v);} }
  }
  asm volatile("s_waitcnt lgkmcnt(0)\n\ts_barrier":::"memory");
  #undef DMA_K
  #undef DMA_V
  #undef BIASADD
  #undef CREG
  #undef RSCALE
  #undef ROT
}
#undef SBAR
#undef WAIT_BAR
}
constexpr int NWAVES = 8;
constexpr int DM = 1024, MP = 65536, MS = 16384, MT = MP + MS, NSEQ = 33, LP = 2048, LS = 16384, DFF = 2816, NMOD = 6144;
constexpr float EPS = 1e-6f;
constexpr float LAMBDA_INIT1 = 0.35550907f;
constexpr float QSCALE = 0.125f * 1.4426950408889634f;
constexpr size_t MiB = 1u << 20;
constexpr size_t WS_BAR = 0, BAR_BYTES = 16384;
constexpr size_t WS_MOD = 1 * MiB;
constexpr size_t WS_ROPE = 3 * MiB;
constexpr size_t WS_WQKVA = 4 * MiB, WS_WOA = 7 * MiB, WS_WQKVB = 9 * MiB, WS_WOB = 15 * MiB, WS_WGU = 17 * MiB  , WS_WD = 39 * MiB  ;
constexpr size_t WS_BV = 51 * MiB;
constexpr size_t WS_RSS = 54 * MiB;
constexpr int BV_GU0 = 0, BV_QKV1 = 33 * 5632, BV_GU1 = 33 * 5632 + 33 * 3072;
constexpr size_t WS_H = 64 * MiB, WS_Q = 224 * MiB, WS_K = 384 * MiB, WS_V = 544 * MiB, WS_O = 704 * MiB, WS_END = 864 * MiB;
constexpr size_t WS_XS = 864 * MiB, WS_END2 = 1024 * MiB;
constexpr size_t WS_ACT = WS_Q;
constexpr size_t WS_OC0 = WS_H, WS_OC1 = WS_O;
static_assert(WS_WD + 2 * (size_t)DM * DFF * 2 <= WS_H && WS_ACT + (size_t)MT * DFF * 2 <= WS_O, "ws map");
constexpr int RING_OFF = 0;
constexpr int LDS_BYTES = 155648;

#define GAS __attribute__((address_space(1)))
#define LAS __attribute__((address_space(3)))
typedef unsigned short bf16;
typedef unsigned v4u __attribute__((ext_vector_type(4)));
typedef float f32x4 __attribute__((ext_vector_type(4)));
#define LDS_WAIT() asm volatile("s_waitcnt lgkmcnt(0)" ::: "memory")
__device__ __forceinline__ unsigned f2bf(float f) { unsigned u = __builtin_bit_cast(unsigned, f); return (u + 0x7fffu + ((u >> 16) & 1u)) >> 16; }
__device__ __forceinline__ unsigned pk2(float lo, float hi) { return f2bf(lo) | (f2bf(hi) << 16); }
__device__ __forceinline__ float bf_lo(unsigned w) { return __builtin_bit_cast(float, w << 16); }
__device__ __forceinline__ float bf_hi(unsigned w) { return __builtin_bit_cast(float, w & 0xffff0000u); }
__device__ __forceinline__ float wave_sum(float v) {
#pragma unroll
    for (int o = 1; o < 64; o <<= 1) v += __shfl_xor(v, o);
    return v;
}
#define XB_TMO      128
#define XB_XCNT(j)  (256  + 64 * (j))
#define XB_XSUB(j)  (1280 + 64 * (j))
#define XB_XGEN(j)  (2304 + 64 * (j))
#define XB_TOP      3328
#define XB_TOPGEN   3392
#define XCD_BAR_WORDS 3456
#define XB_SPIN_CAP (1u << 18)

__device__ __forceinline__ unsigned xb_ld(unsigned* p)              { return __hip_atomic_load(p, __ATOMIC_RELAXED, __HIP_MEMORY_SCOPE_AGENT); }
__device__ __forceinline__ unsigned xb_add(unsigned* p, unsigned v) { return __hip_atomic_fetch_add(p, v, __ATOMIC_RELAXED, __HIP_MEMORY_SCOPE_AGENT); }
__device__ __forceinline__ unsigned xb_xcc_id() { return (unsigned)__builtin_amdgcn_s_getreg((3 << 11) | 20) & 0xFu; }
#define XB_SPIN(cond, bar) do { unsigned _sp = 0; while (cond) { __builtin_amdgcn_s_sleep(1); \
    if ((++_sp & 255u) == 0u) { if (xb_ld(&(bar)[XB_TMO])) break; if (_sp > XB_SPIN_CAP) { atomicAdd(&(bar)[XB_TMO], 1u); break; } } } } while (0)

struct XcdBarrier {
    unsigned* bar; unsigned x;
    volatile LAS unsigned* st;
};

__device__ __forceinline__ XcdBarrier xcd_barrier_post(unsigned* bar, volatile LAS unsigned* st) {
    XcdBarrier b; b.bar = bar; b.x = xb_xcc_id(); b.st = st;
    if (threadIdx.x == 0) (void)xb_add(&bar[XB_XCNT(b.x)], 1u);
    return b;
}
__device__ __forceinline__ void xcd_barrier_complete(unsigned* bar, unsigned x, unsigned& nloc, unsigned& nx) {
    const unsigned G = gridDim.x * gridDim.y * gridDim.z;
    unsigned sum, cnt, mine, sp = 0u;
    for (;;) {
        sum = 0u; cnt = 0u; mine = 0u;
#pragma unroll
        for (unsigned j = 0; j < 16; ++j) { const unsigned c = xb_ld(&bar[XB_XCNT(j)]); sum += c; cnt += (c > 0u) ? 1u : 0u; mine = (j == x) ? c : mine; }
        if (sum == G) break;
        __builtin_amdgcn_s_sleep(1);
        if ((++sp & 255u) == 0u) { if (xb_ld(&bar[XB_TMO])) break; if (sp > XB_SPIN_CAP) { atomicAdd(&bar[XB_TMO], 1u); break; } }
    }
    nloc = mine > 0u ? mine : 1u; nx = cnt > 0u ? cnt : 1u;
}

__device__ __forceinline__ void xcd_barrier(const XcdBarrier& b) {
    asm volatile("s_waitcnt vmcnt(0)" ::: "memory");
    __syncthreads();
    if (threadIdx.x == 0) {
        unsigned* bar = b.bar;
        __builtin_amdgcn_s_waitcnt(0);
        unsigned nloc = b.st[0], nx = b.st[1];
        if (nloc == 0u) { xcd_barrier_complete(bar, b.x, nloc, nx); b.st[0] = nloc; b.st[1] = nx; }
        const unsigned old = xb_add(&bar[XB_XSUB(b.x)], 1u);
        const unsigned gen = old / nloc;
        if (old + 1u == (gen + 1u) * nloc) {
            __builtin_amdgcn_fence(__ATOMIC_RELEASE, "agent");
            asm volatile("s_waitcnt vmcnt(0)" ::: "memory");
            const unsigned og = xb_add(&bar[XB_TOP], 1u);
            const unsigned tg = og / nx;
            if (og + 1u == (tg + 1u) * nx) xb_add(&bar[XB_TOPGEN], 1u);
            else XB_SPIN(xb_ld(&bar[XB_TOPGEN]) == tg, bar);
            __builtin_amdgcn_fence(__ATOMIC_ACQUIRE, "agent");
            xb_add(&bar[XB_XGEN(b.x)], 1u);
            asm volatile("s_waitcnt vmcnt(0)" ::: "memory");
        } else {
            XB_SPIN(xb_ld(&bar[XB_XGEN(b.x)]) == gen, bar);
            __builtin_amdgcn_fence(__ATOMIC_ACQUIRE, "agent");
            asm volatile("s_waitcnt vmcnt(0)" ::: "memory");
        }
    }
    __syncthreads();
}

__device__ __forceinline__ void p0_transpose_item(const float* W, int K, int N, bf16* WT, LAS float* scr, int k0, int n0, int drow0, int lane) {
    float tv[32];
#pragma unroll
    for (int i = 0; i < 32; ++i) { const int kk = 2 * i + (lane >> 5); tv[i] = W[(size_t)(k0 + kk) * N + n0 + (lane & 31)]; }
#pragma unroll
    for (int i = 0; i < 32; ++i) { const int kk = 2 * i + (lane >> 5); scr[kk * 33 + (lane & 31)] = tv[i]; }
    LDS_WAIT(); asm volatile("" ::: "memory");
    const int c = lane & 7;
#pragma unroll
    for (int j = 0; j < 4; ++j) { const int n = (lane >> 3) + 8 * j; const LAS float* s = scr + (8 * c) * 33 + n;
        v4u o; o.x = pk2(s[0 * 33], s[1 * 33]); o.y = pk2(s[2 * 33], s[3 * 33]); o.z = pk2(s[4 * 33], s[5 * 33]); o.w = pk2(s[6 * 33], s[7 * 33]);
        *(GAS v4u*)(WT + (size_t)(drow0 + n) * K + k0 + 8 * c) = o; }
    LDS_WAIT(); asm volatile("" ::: "memory");
}
__device__ __forceinline__ void gemv33c(int bidx, int bstride, int tid, const LAS float* vec, LAS float* red, const float* W, int N, float* outp, int ostride, const float* addb) {
    const int lane = tid & 63, wave = tid >> 6, kq = lane >> 4, nn = lane & 15, kbase = wave * 128 + 4 * kq;
    typedef float f4 __attribute__((ext_vector_type(4)));
    for (int cb = bidx; cb < N / 16; cb += bstride) {
        const float* Wn = W + 16 * cb + nn;
        float w[8][4];
#pragma unroll
        for (int u = 0; u < 8; ++u)
#pragma unroll
            for (int j = 0; j < 4; ++j) w[u][j] = Wn[(size_t)(kbase + 16 * u + j) * N];
        float acc[33];
#pragma unroll
        for (int s = 0; s < 33; ++s) acc[s] = 0.f;
#pragma unroll
        for (int s = 0; s < 33; ++s) {
#pragma unroll
            for (int u = 0; u < 8; ++u) { const f4 v = *(const LAS f4*)(vec + s * 1024 + kbase + 16 * u); acc[s] += (v.x * w[u][0] + v.y * w[u][1]) + (v.z * w[u][2] + v.w * w[u][3]); }
            asm volatile("" : "+v"(acc[s]) :: "memory"); }
#pragma unroll
        for (int s = 0; s < 33; ++s) { float a = acc[s]; a += __shfl_xor(a, 16); a += __shfl_xor(a, 32); if (kq == 0) red[(wave * 33 + s) * 16 + nn] = a; }
        __syncthreads();
        for (int o = tid; o < 528; o += 512) { const int s = o >> 4, n2 = o & 15; float a = 0.f;
#pragma unroll
            for (int ww = 0; ww < 8; ++ww) a += red[(ww * 33 + s) * 16 + n2];
            outp[(size_t)s * ostride + 16 * cb + n2] = a + (addb ? addb[16 * cb + n2] : 0.f); }
        __syncthreads();
    }
}
struct Args { const float* in[24]; float* out; unsigned char* ws; };

__device__ __forceinline__ void norm_rows(int gw, int NGW, int lane, const float* src_p, const float* src_s, const float* gain, const float* modl, int sh_off, int sc_off, bf16* H) {
    for (int m0 = gw; m0 < MT; m0 += 2 * NGW) {
        const int m1 = m0 + NGW; const bool has1 = m1 < MT; const int m1c = has1 ? m1 : m0;
        const float* s0 = (m0 < MP) ? src_p + (size_t)m0 * DM : src_s + (size_t)(m0 - MP) * DM;
        const float* s1 = (m1c < MP) ? src_p + (size_t)m1c * DM : src_s + (size_t)(m1c - MP) * DM;
        const GAS f32x4* x0 = (const GAS f32x4*)s0 + lane; const GAS f32x4* x1 = (const GAS f32x4*)s1 + lane;
        f32x4 v0[4], v1[4]; float q0 = 0.f, q1 = 0.f;
#pragma unroll
        for (int j = 0; j < 4; ++j) { v0[j] = x0[64 * j]; v1[j] = x1[64 * j]; }
#pragma unroll
        for (int j = 0; j < 4; ++j) { q0 += (v0[j].x * v0[j].x + v0[j].y * v0[j].y) + (v0[j].z * v0[j].z + v0[j].w * v0[j].w); q1 += (v1[j].x * v1[j].x + v1[j].y * v1[j].y) + (v1[j].z * v1[j].z + v1[j].w * v1[j].w); }
        const float r0 = __builtin_amdgcn_rsqf(wave_sum(q0) * (1.f / DM) + EPS), r1 = __builtin_amdgcn_rsqf(wave_sum(q1) * (1.f / DM) + EPS);
        const float* mr0 = modl + (size_t)((m0 < MP) ? (m0 >> 11) : 32) * NMOD; const float* mr1 = modl + (size_t)((m1c < MP) ? (m1c >> 11) : 32) * NMOD;
        GAS unsigned long long* o0 = (GAS unsigned long long*)(H + (size_t)m0 * DM) + lane; GAS unsigned long long* o1 = (GAS unsigned long long*)(H + (size_t)m1c * DM) + lane;
#pragma unroll
        for (int j = 0; j < 4; ++j) { const int col = 4 * lane + 256 * j; const f32x4 g = *(const f32x4*)(gain + col);
            const f32x4 y0 = (v0[j] * r0) * g * (*(const f32x4*)(mr0 + sc_off + col) + 1.0f) + *(const f32x4*)(mr0 + sh_off + col);
            o0[64 * j] = (unsigned long long)pk2(y0.x, y0.y) | ((unsigned long long)pk2(y0.z, y0.w) << 32);
            if (has1) { const f32x4 y1 = (v1[j] * r1) * g * (*(const f32x4*)(mr1 + sc_off + col) + 1.0f) + *(const f32x4*)(mr1 + sh_off + col);
                o1[64 * j] = (unsigned long long)pk2(y1.x, y1.y) | ((unsigned long long)pk2(y1.z, y1.w) << 32); } }
    }
}
__device__ __forceinline__ void qknorm_chunks(int gw, int NGW, int lane, bf16* buf, int nchunks, int row_width_log2, const float* gain, float qscale, bool rope, const float* ropetab) {
    const int d0 = 16 * (lane & 3);
    float g[16];
#pragma unroll
    for (int i = 0; i < 16; ++i) g[i] = gain[d0 + i] * qscale;
    for (int ci = gw; ci < nchunks; ci += NGW) {
        GAS v4u* p = (GAS v4u*)(buf + (size_t)ci * 1024 + 16 * lane);
        const v4u a = p[0], b = p[1];
        float x[16];
        x[0] = bf_lo(a.x); x[1] = bf_hi(a.x); x[2] = bf_lo(a.y); x[3] = bf_hi(a.y); x[4] = bf_lo(a.z); x[5] = bf_hi(a.z); x[6] = bf_lo(a.w); x[7] = bf_hi(a.w);
        x[8] = bf_lo(b.x); x[9] = bf_hi(b.x); x[10] = bf_lo(b.y); x[11] = bf_hi(b.y); x[12] = bf_lo(b.z); x[13] = bf_hi(b.z); x[14] = bf_lo(b.w); x[15] = bf_hi(b.w);
        float ss = 0.f;
#pragma unroll
        for (int i = 0; i < 16; ++i) ss += x[i] * x[i];
        ss += __shfl_xor(ss, 1); ss += __shfl_xor(ss, 2);
        const float r = __builtin_amdgcn_rsqf(ss * (1.f / 64.f) + EPS);
#pragma unroll
        for (int i = 0; i < 16; ++i) x[i] = x[i] * r * g[i];
        if (rope) {
            const int m = (int)((((size_t)ci * 1024 + 16 * lane)) >> row_width_log2);
            const int t = (m < MP) ? (m & (LP - 1)) : (m - MP);
            const int qd = lane & 3; const int pos = (qd < 2) ? (t >> 6) : (t & 63);
            const f32x4* tb = (const f32x4*)(ropetab + (size_t)(pos * 16 + 8 * (qd & 1)) * 2);
#pragma unroll
            for (int j = 0; j < 4; ++j) { const f32x4 cs = tb[j];
                const float a0 = x[4 * j], a1 = x[4 * j + 1], b0 = x[4 * j + 2], b1 = x[4 * j + 3];
                x[4 * j] = a0 * cs.x - a1 * cs.y; x[4 * j + 1] = a0 * cs.y + a1 * cs.x; x[4 * j + 2] = b0 * cs.z - b1 * cs.w; x[4 * j + 3] = b0 * cs.w + b1 * cs.z; }
        }
        v4u oa, ob;
        oa.x = pk2(x[0], x[1]); oa.y = pk2(x[2], x[3]); oa.z = pk2(x[4], x[5]); oa.w = pk2(x[6], x[7]);
        ob.x = pk2(x[8], x[9]); ob.y = pk2(x[10], x[11]); ob.z = pk2(x[12], x[13]); ob.w = pk2(x[14], x[15]);
        p[0] = oa; p[1] = ob;
    }
}
__device__ __forceinline__ void diff_combine(int gw, int NGW, int lane, const bf16* O0, bf16* O1, const float* subg, float lam) {
    const int d0 = 16 * (lane & 7);
    float g[16];
#pragma unroll
    for (int i = 0; i < 16; ++i) g[i] = subg[d0 + i] * (1.0f - LAMBDA_INIT1);
    for (int m = gw; m < MT; m += NGW) {
        const GAS v4u* p0 = (const GAS v4u*)(O0 + (size_t)m * 1024 + 16 * lane);
        GAS v4u* p1 = (GAS v4u*)(O1 + (size_t)m * 1024 + 16 * lane);
        const v4u a0 = p0[0], b0 = p0[1], a1 = p1[0], b1 = p1[1];
        float x[16];
#define DC(i, w0, w1) x[2 * (i)] = bf_lo(w0) - lam * bf_lo(w1); x[2 * (i) + 1] = bf_hi(w0) - lam * bf_hi(w1);
        DC(0, a0.x, a1.x) DC(1, a0.y, a1.y) DC(2, a0.z, a1.z) DC(3, a0.w, a1.w) DC(4, b0.x, b1.x) DC(5, b0.y, b1.y) DC(6, b0.z, b1.z) DC(7, b0.w, b1.w)
#undef DC
        float ss = 0.f;
#pragma unroll
        for (int i = 0; i < 16; ++i) ss += x[i] * x[i];
        ss += __shfl_xor(ss, 1); ss += __shfl_xor(ss, 2); ss += __shfl_xor(ss, 4);
        const float r = __builtin_amdgcn_rsqf(ss * (1.f / 128.f) + EPS);
#pragma unroll
        for (int i = 0; i < 16; ++i) x[i] = x[i] * r * g[i];
        v4u oa, ob;
        oa.x = pk2(x[0], x[1]); oa.y = pk2(x[2], x[3]); oa.z = pk2(x[4], x[5]); oa.w = pk2(x[6], x[7]);
        ob.x = pk2(x[8], x[9]); ob.y = pk2(x[10], x[11]); ob.z = pk2(x[12], x[13]); ob.w = pk2(x[14], x[15]);
        p1[0] = oa; p1[1] = ob;
    }
}

__global__ void __launch_bounds__(NWAVES * 64, 2) mega_fwd(Args args) {
    extern __shared__ __attribute__((aligned(16))) unsigned char lds[];
    cg::grid_group grid = cg::this_grid();
    LAS unsigned char* ldsl = (LAS unsigned char*)lds;
    const int tid = threadIdx.x, lane = tid & 63, wave = __builtin_amdgcn_readfirstlane(tid >> 6);
    const int G = gridDim.x, bx = blockIdx.x;
    const int vcu = (G % 8 == 0) ? (bx % 8) * (G / 8) + bx / 8 : bx;
    const int gw = vcu * NWAVES + wave, NGW = G * NWAVES;
    volatile LAS unsigned* bst = (volatile LAS unsigned*)(ldsl + 155584);
    if (tid < 16) bst[tid] = 0u;
    __syncthreads();
    const XcdBarrier xbar = xcd_barrier_post((unsigned*)(args.ws + WS_BAR), bst);
    typedef __attribute__((address_space(4))) const Args* cargs_t;
    const cargs_t ap0 = (cargs_t)__builtin_amdgcn_kernarg_segment_ptr();
#define AP() cargs_t ap = ap0; asm volatile("" : "+s"(ap))
#define WSP(T, off) ((T*)(ap->ws + (off)))
#define mod WSP(float, WS_MOD)
#define ropetab WSP(float, WS_ROPE)
#define Wqkv_a WSP(bf16, WS_WQKVA)
#define Wo_a WSP(bf16, WS_WOA)
#define Wqkv_b WSP(bf16, WS_WQKVB)
#define Wo_b WSP(bf16, WS_WOB)
#define Wgu WSP(bf16, WS_WGU)
#define Wd WSP(bf16, WS_WD)
#define H WSP(bf16, WS_H)
#define Qb WSP(bf16, WS_Q)
#define Kb WSP(bf16, WS_K)
#define Vb WSP(bf16, WS_V)
#define Ob WSP(bf16, WS_O)
#define ACT WSP(bf16, WS_ACT)
#define OC0 WSP(bf16, WS_OC0)
#define OC1 WSP(bf16, WS_OC1)
#define out (ap->out)
#define x_p (ap->in[0])
#define x_s (ap->in[1])
    {
        AP();
        LAS float* scr = (LAS float*)(ldsl + RING_OFF + wave * 16384);
        constexpr int I_QA = 16 * 48, I_OA = 16 * 32, I_QB = 16 * 96, I_OB = 16 * 32, I_GU = 16 * 176, I_D = 44 * 32;
        constexpr int NITEMS = I_QA + I_OA + I_QB + I_OB + 2 * I_GU + 2 * I_D;
        for (int it = gw; it < NITEMS; it += NGW) {
            int r = it;
            if (r < I_QA) { const int nb = r % 48, kb = r / 48; p0_transpose_item(ap->in[11], 1024, 1536, Wqkv_a, scr, 64 * kb, 32 * nb, 32 * nb, lane); continue; } r -= I_QA;
            if (r < I_OA) { const int nb = r % 32, kb = r / 32; p0_transpose_item(ap->in[12], 1024, 1024, Wo_a, scr, 64 * kb, 32 * nb, 32 * nb, lane); continue; } r -= I_OA;
            if (r < I_QB) { const int nb = r % 96, kb = r / 96; p0_transpose_item(ap->in[15], 1024, 3072, Wqkv_b, scr, 64 * kb, 32 * nb, 32 * nb, lane); continue; } r -= I_QB;
            if (r < I_OB) { const int nb = r % 32, kb = r / 32; p0_transpose_item(ap->in[16], 1024, 1024, Wo_b, scr, 64 * kb, 32 * nb, 32 * nb, lane); continue; } r -= I_OB;
            if (r < 2 * I_GU) { const int l = r / I_GU; r -= l * I_GU; const int nb = r % 176, kb = r / 176; const int n0 = 32 * nb;
                const int drow0 = (n0 < DFF) ? (n0 / 128) * 256 + (n0 % 128) : ((n0 - DFF) / 128) * 256 + 128 + ((n0 - DFF) % 128);
                p0_transpose_item(ap->in[8] + (size_t)l * 1024 * 5632, 1024, 5632, Wgu + (size_t)l * 5632 * 1024, scr, 64 * kb, n0, drow0, lane); continue; } r -= 2 * I_GU;
            { const int l = r / I_D; r -= l * I_D; const int nb = r % 32, kb = r / 32;
                p0_transpose_item(ap->in[9] + (size_t)l * DFF * 1024, DFF, 1024, Wd + (size_t)l * 1024 * DFF, scr, 64 * kb, 32 * nb, 32 * nb, lane); }
        }
        { const int gt = vcu * 512 + tid;
          if (gt < 4096) { const int pos = gt >> 4, f = gt & 15; const float inv = exp2f(-(float)f * (13.287712379549449f / 16.0f)); const float ang = (float)pos * inv;
              const float rev = ang * 0.15915494309189535f; ropetab[2 * gt] = __builtin_amdgcn_cosf(rev); ropetab[2 * gt + 1] = __builtin_amdgcn_sinf(rev); } }
        __syncthreads();
        LAS float* cact = (LAS float*)ldsl;
        for (int i = tid; i < NSEQ * 1024; i += 512) { const int s = i >> 10, k = i & 1023; const float c = (s < 32) ? ap->in[2][s * 1024 + k] : ap->in[3][k];
            cact[i] = c / (1.0f + __expf(-c)); }
        __syncthreads();
        { const int half = G / 2; const int l = (vcu >= half) ? 1 : 0;
          gemv33c(vcu - l * half, half > 0 ? half : 1, tid, cact, (LAS float*)(ldsl + 135168), ap->in[6] + (size_t)l * 1024 * NMOD, NMOD, mod + (size_t)l * NSEQ * NMOD, NMOD, ap->in[7] + l * NMOD); }
        { float* rss = WSP(float, WS_RSS); for (int i = vcu * 512 + tid; i < 3 * MT; i += G * 512) rss[i] = 0.f; }
        __syncthreads();
    }
    grid.sync();

    auto layer_body = [&](auto LC) __attribute__((always_inline)) {
        constexpr int layer = decltype(LC)::value;
        AP();
#define modl (mod + (size_t)layer * NSEQ * NMOD)
        if (layer == 0) {
            norm_rows(gw, NGW, lane, x_p, x_s, ap->in[4], modl, 0, 1024, H);
            LAS float* shv = (LAS float*)ldsl; float* bv = WSP(float, WS_BV);
#pragma unroll 1
            for (int which = 0; which < 3; ++which) {
                const float* shsrc = mod + (size_t)(which == 0 ? 0 : 1) * NSEQ * NMOD + (which == 1 ? 0 : 3072);
                for (int i = tid; i < NSEQ * 1024; i += 512) shv[i] = shsrc[(size_t)(i >> 10) * NMOD + (i & 1023)];
                __syncthreads();
                if (which == 0) gemv33c(vcu, G, tid, shv, (LAS float*)(ldsl + 135168), ap->in[8], 5632, bv + BV_GU0, 5632, nullptr);
                else if (which == 1) gemv33c(vcu, G, tid, shv, (LAS float*)(ldsl + 135168), ap->in[15], 3072, bv + BV_QKV1, 3072, nullptr);
                else gemv33c(vcu, G, tid, shv, (LAS float*)(ldsl + 135168), ap->in[8] + (size_t)1024 * 5632, 5632, bv + BV_GU1, 5632, nullptr);
                __syncthreads();
            }
            xcd_barrier(xbar);
        }
        if (layer == 0) {
            pg8::Gemm g{H, Wqkv_a, MT, 1536, 1024}; pg8::StaticOrder S; S.init(MT, 1536, G, bx);
            pg8::EpiSplit2<false, true> E{Qb, Kb, Vb, 1024, 256, 256, 4, 5, nullptr, nullptr, 0, ap->in[13], ap->in[14], QSCALE, ropetab, (LAS float*)(ldsl + 131072)};
            pg8::gemm_phase<pg8::EpiSplit2<false, true>, pg8::StaticOrder, true, PG8_SP2>(ldsl + RING_OFF, g, S, E);
        } else {
            pg8::Gemm g{H, Wqkv_b, MT, 3072, 1024}; pg8::StaticOrder S; S.init(MT, 3072, G, bx);
            pg8::EpiSplit2<true, false> E{Qb, Kb, Vb, 1024, 1024, 1024, 4, 8, WSP(float, WS_RSS) + MT, WSP(float, WS_BV) + BV_QKV1, 3072, ap->in[17], ap->in[18], QSCALE, ropetab, (LAS float*)(ldsl + 131072)};
            pg8::gemm_phase<pg8::EpiSplit2<true, false>, pg8::StaticOrder, true, PG8_SP2>(ldsl + RING_OFF, g, S, E);
        }
        xcd_barrier(xbar);
        if (layer == 0) {
            for (int idx = vcu; idx < 1024 + 4096; idx += G) {
                size_t tok0; int head, kvh, qb, NT;
                if (idx < 1024) { const int xcd = (idx >> 5) & 7, j = idx & 31, i = idx >> 8; kvh = xcd & 3; const int w = (((xcd >> 2) * 4 + i) << 5) + j; head = kvh * 4 + (w >> 6); qb = w & 63; tok0 = MP; NT = LS / 64; }
                else { const int id2 = idx - 1024; const int xcd = (id2 >> 5) & 7, j = id2 & 31, i = id2 >> 8; const int gq = xcd * 16 + i; kvh = gq & 3; head = kvh * 4 + (j >> 3); qb = j & 7; tok0 = (size_t)(gq >> 2) * LP; NT = LP / 64; }
                attn_body::attn_unit2<1, false, 0>((const attn_body::bf16*)(Qb + tok0 * 1024 + head * 64), 1024, (const attn_body::bf16*)(Kb + tok0 * 256 + kvh * 64), 256,
                    (const attn_body::bf16*)(Vb + tok0 * 256 + kvh * 64), 256, (attn_body::bf16*)(Ob + tok0 * 1024 + head * 64), 1024, qb * 256, NT, nullptr, (char*)lds + RING_OFF, 0.f, nullptr, 0.f); }
        } else {
            const float s1 = wave_sum(ap->in[19][lane] * ap->in[20][lane]), s2 = wave_sum(ap->in[21][lane] * ap->in[22][lane]);
            const float lam = expf(s1) - expf(s2) + LAMBDA_INIT1;
            for (int idx = vcu; idx < 512 + 2048; idx += G) {
                size_t tok0; int h, qb, NT;
                if (idx < 512) { const int xcd = (idx >> 5) & 7, j = idx & 31, i = idx >> 8; h = xcd; qb = (i << 5) + j; tok0 = MP; NT = LS / 64; }
                else { const int id2 = idx - 512; const int xcd = (id2 >> 5) & 7, j = id2 & 31, i = id2 >> 8; const int gq = ((xcd * 8 + i) << 2) + (j >> 3); h = gq & 7; qb = j & 7; tok0 = (size_t)(gq >> 3) * LP; NT = LP / 64; }
                attn_body::attn_unit2<2, true, 1>((const attn_body::bf16*)(Qb + tok0 * 1024 + (2 * h) * 64), 1024, (const attn_body::bf16*)(Kb + tok0 * 1024 + (2 * h) * 64), 1024,
                    (const attn_body::bf16*)(Vb + tok0 * 1024 + h * 128), 1024, (attn_body::bf16*)(Ob + tok0 * 1024 + h * 128), 1024, qb * 256, NT, ap->in[10] + h, (char*)lds + RING_OFF, lam, ap->in[23], 1.0f - LAMBDA_INIT1);
                attn_body::attn_unit2<2, true, 2>((const attn_body::bf16*)(Qb + tok0 * 1024 + (2 * h + 1) * 64), 1024, (const attn_body::bf16*)(Kb + tok0 * 1024 + (2 * h + 1) * 64), 1024,
                    (const attn_body::bf16*)(Vb + tok0 * 1024 + h * 128), 1024, (attn_body::bf16*)(Ob + tok0 * 1024 + h * 128), 1024, qb * 256, NT, ap->in[10] + h, (char*)lds + RING_OFF, lam, ap->in[23], 1.0f - LAMBDA_INIT1); }
        }
        xcd_barrier(xbar);
        {
            pg8::Gemm g{Ob, layer == 0 ? Wo_a : Wo_b, MT, 1024, 1024}; pg8::StaticOrder S; S.init(MT, 1024, G, bx);
            if (layer == 0) {
                pg8::EpiResid4<true, false, true> E{x_p, x_s - (size_t)MP * DM, nullptr, nullptr, WSP(unsigned short, WS_XS), modl + 2048, ap->in[5], modl + 4096, H, WSP(float, WS_RSS)};
                pg8::gemm_phase<pg8::EpiResid4<true, false, true>, pg8::StaticOrder, PG8_ALIGN, PG8_SP2>(ldsl + RING_OFF, g, S, E);
            } else {
                pg8::EpiResid4<true, true, true> E{nullptr, nullptr, nullptr, WSP(unsigned short, WS_XS), WSP(unsigned short, WS_XS), modl + 2048, ap->in[5] + 1024, modl + 4096, H, WSP(float, WS_RSS) + 2 * MT};
                pg8::gemm_phase<pg8::EpiResid4<true, true, true>, pg8::StaticOrder, PG8_ALIGN, PG8_SP2>(ldsl + RING_OFF, g, S, E);
            }
        }
        xcd_barrier(xbar);
        {
            pg8::Gemm g{H, Wgu + (size_t)layer * 5632 * 1024, MT, 5632, 1024}; pg8::StaticOrder S; S.init(MT, 5632, G, bx);
            pg8::EpiSwiGLU2 E{ACT, DFF, WSP(float, WS_RSS) + (layer == 0 ? 0 : 2 * MT), WSP(float, WS_BV) + (layer == 0 ? BV_GU0 : BV_GU1)};
            pg8::gemm_phase<pg8::EpiSwiGLU2, pg8::StaticOrder, PG8_ALIGN, PG8_SP2>(ldsl + RING_OFF, g, S, E);
        }
        xcd_barrier(xbar);
        {
            pg8::Gemm g{ACT, Wd + (size_t)layer * 1024 * DFF, MT, 1024, DFF}; pg8::StaticOrder S; S.init(MT, 1024, G, bx);
            if (layer == 0) {
                pg8::EpiResid4<true, true, true> E{nullptr, nullptr, nullptr, WSP(unsigned short, WS_XS), WSP(unsigned short, WS_XS), modl + 5120, ap->in[4] + 1024, mod + (size_t)NSEQ * NMOD + 1024, H, WSP(float, WS_RSS) + MT};
                pg8::gemm_phase<pg8::EpiResid4<true, true, true>, pg8::StaticOrder, PG8_ALIGN, PG8_SP2>(ldsl + RING_OFF, g, S, E);
            } else {
                pg8::EpiResid4<false, true, false> E{nullptr, nullptr, out, WSP(unsigned short, WS_XS), nullptr, modl + 5120, nullptr, nullptr, nullptr, nullptr};
                pg8::gemm_phase<pg8::EpiResid4<false, true, false>, pg8::StaticOrder, PG8_ALIGN, PG8_SP2>(ldsl + RING_OFF, g, S, E);
            }
        }
        if (layer == 0) xcd_barrier(xbar);
    };
    layer_body(std::integral_constant<int, 0>{});
    layer_body(std::integral_constant<int, 1>{});
}

#undef out
#undef H
#undef mod
#undef modl
#undef ACT
#undef Qb
#undef Kb
#undef Vb
#undef Ob
extern "C" void kernel_launch(void* const* d_in, const int* in_sizes, int n_in, void* d_out, int out_size, void* d_ws, size_t ws_size, hipStream_t stream) {
    static int grid = 0;
    if (grid == 0) {
        if (n_in != 24 || out_size != MT * DM || ws_size < WS_END2) { fprintf(stderr, "kernel_launch: unexpected shapes (n_in %d, out %d, ws %zu)\n", n_in, out_size, ws_size); grid = -1; return; }
        int dev = 0, cus = 0, per_cu = 0;
        hipGetDevice(&dev); hipDeviceGetAttribute(&cus, hipDeviceAttributeMultiprocessorCount, dev);
        if (hipFuncSetAttribute((const void*)mega_fwd, hipFuncAttributeMaxDynamicSharedMemorySize, LDS_BYTES) != hipSuccess) { fprintf(stderr, "hipFuncSetAttribute failed\n"); grid = -1; return; }
        if (hipOccupancyMaxActiveBlocksPerMultiprocessor(&per_cu, (const void*)mega_fwd, NWAVES * 64, LDS_BYTES) != hipSuccess || per_cu < 1) per_cu = 1;
        (void)hipGetLastError();
        grid = cus;
        if (grid > 256) grid = 256;
    }
    if (grid < 0) return;
    if (hipMemsetAsync((char*)d_ws + WS_BAR, 0, BAR_BYTES, stream) != hipSuccess) { fprintf(stderr, "hipMemsetAsync of the barrier words failed\n"); return; }
    Args a{};
    for (int i = 0; i < 24; ++i) a.in[i] = (const float*)d_in[i];
    a.out = (float*)d_out; a.ws = (unsigned char*)d_ws;
    void* kargs[] = {&a};
    hipError_t e = hipLaunchCooperativeKernel((const void*)mega_fwd, dim3(grid), dim3(NWAVES * 64), kargs, LDS_BYTES, stream);
    if (e != hipSuccess) fprintf(stderr, "cooperative launch failed: %s (grid %d)\n", hipGetErrorString(e), grid);
}
```
